# Optimizing an MI355X kernel written in HIP

```python
import math
import jax, jax.numpy as jnp
from jax import lax
import numpy as np

D_MODEL = 1024
BATCH = 8
SEQ = 2048
DEPTH = 1
DEC_BATCH = 32
DEC_SEQ = 8
PAST_LEN = 16384
PAGE_SIZE = 128

H_A = 4
DK_A = 64
DV_A = 128
GATE_RANK = 16
GATE_TAU = 16.0
GLA_CHUNK = 64
H_B = 4
Q_LORA = 384
KV_LORA = 256
QK_NOPE = 128
QK_ROPE = 64
V_B = 128
ROPE_BASE = 10000.0
Q_BLOCK = 128
MIX_WIDTH = H_A * DV_A + H_B * V_B
D_FF = 2816
CONV_W = 3
EPS = 1e-6
COLS = (H_A * DK_A, H_A * DK_A, H_A * DV_A, H_A * DV_A, GATE_RANK, Q_LORA, KV_LORA, QK_ROPE)
IN_COLS = sum(COLS)

kernel_name = "hymba_gla_mla_convffn_step"


def rmsnorm(x, g):
    xf = x.astype(jnp.float32)
    y = xf * lax.rsqrt(jnp.mean(xf * xf, axis=-1, keepdims=True) + EPS)
    return (y * g.astype(jnp.float32)).astype(x.dtype)


def rope(x, pos):
    r = x.shape[-1]
    inv = ROPE_BASE ** (-jnp.arange(0, r, 2, dtype=jnp.float32) / r)
    ang = pos.astype(jnp.float32)[:, None] * inv[None, :]
    cos = jnp.cos(ang)[None, :, None, :]
    sin = jnp.sin(ang)[None, :, None, :]
    xf = x.astype(jnp.float32)
    x1, x2 = xf[..., : r // 2], xf[..., r // 2:]
    out = jnp.concatenate([x1 * cos - x2 * sin, x1 * sin + x2 * cos], axis=-1)
    return out.astype(x.dtype)


def gla_chunked(q, k, v, log_a, s0):
    B, T, H, DK = q.shape
    DV = v.shape[-1]
    C = math.gcd(T, GLA_CHUNK)
    N = T // C

    def to_chunks(a):
        return a.astype(jnp.float32).reshape(B, N, C, H, a.shape[-1]).transpose(1, 0, 2, 3, 4)

    tri = jnp.tril(jnp.ones((C, C), dtype=bool))[None, :, :, None, None]

    def step(S, inp):
        qc, kc, vc, gc = inp
        b = jnp.cumsum(gc, axis=1)
        o_inter = jnp.einsum('bchk,bhkv->bchv', qc * jnp.exp(b), S)
        diff = jnp.where(tri, b[:, :, None] - b[:, None, :], -jnp.inf)
        att = jnp.einsum('bthk,bshk,btshk->bhts', qc, kc, jnp.exp(diff))
        o_intra = jnp.einsum('bhts,bshv->bthv', att, vc)
        bl = b[:, -1]
        S_new = S * jnp.exp(bl)[..., None] + jnp.einsum('bshk,bshv->bhkv', kc * jnp.exp(bl[:, None] - b), vc)
        return S_new, o_inter + o_intra

    S_fin, o = lax.scan(step, s0.astype(jnp.float32), (to_chunks(q), to_chunks(k), to_chunks(v), to_chunks(log_a)))
    o = o.transpose(1, 0, 2, 3, 4).reshape(B, T, H, DV).astype(v.dtype)
    return o, S_fin


def mla_attend(q_lat, q_rope, kv, kr, q_pos, k_pos):
    B, T, H, L = q_lat.shape
    R = q_rope.shape[-1]
    scale = (QK_NOPE + QK_ROPE) ** -0.5

    def block(args):
        ql, qr, qp = args
        s = jnp.einsum('bthl,bsl->bhts', ql, kv) + jnp.einsum('bthr,bsr->bhts', qr, kr)
        s = s.astype(jnp.float32) * scale
        s = jnp.where(k_pos[None, :] <= qp[:, None], s, -jnp.inf)
        p = jax.nn.softmax(s, axis=-1).astype(kv.dtype)
        return jnp.einsum('bhts,bsl->bthl', p, kv)

    blk = Q_BLOCK if T % Q_BLOCK == 0 else T
    nb = T // blk
    if nb == 1:
        return block((q_lat, q_rope, q_pos))
    qlb = q_lat.reshape(B, nb, blk, H, L).transpose(1, 0, 2, 3, 4)
    qrb = q_rope.reshape(B, nb, blk, H, R).transpose(1, 0, 2, 3, 4)
    qpb = q_pos.reshape(nb, blk)
    out = lax.map(block, (qlb, qrb, qpb))
    return out.transpose(1, 0, 2, 3, 4).reshape(B, T, H, L)


def trunk_layer(x, c, pos, gla_s0, conv_buf, past_lat, past_kr, lw):
    B, T, _ = x.shape
    mod = jax.nn.silu(c) @ lw['w_ada'] + lw['b_ada']
    sh1, sc1, gt1, sh2, sc2, gt2 = [m[:, None, :] for m in jnp.split(mod, 6, axis=-1)]

    h = rmsnorm(x, lw['g_pre_mix']) * (1.0 + sc1) + sh1
    z = h @ lw['w_in']
    offs = np.cumsum(COLS)[:-1].tolist()
    q_a, k_a, v_a, r_a, gr_a, cq, ckv, kr = jnp.split(z, offs, axis=-1)

    q_a = q_a.reshape(B, T, H_A, DK_A) * (DK_A ** -0.5)
    k_a = k_a.reshape(B, T, H_A, DK_A)
    v_a = v_a.reshape(B, T, H_A, DV_A)
    log_a = jax.nn.log_sigmoid((gr_a @ lw['w_gla_a2'] + lw['b_gla_a']).astype(jnp.float32)) / GATE_TAU
    log_a = log_a.reshape(B, T, H_A, DK_A)
    o_a, s_a = gla_chunked(q_a, k_a, v_a, log_a, gla_s0)
    o_a = rmsnorm(o_a, lw['g_gla_out']) * jax.nn.silu(r_a.reshape(B, T, H_A, DV_A))
    o_a = o_a.reshape(B, T, H_A * DV_A)

    cq = rmsnorm(cq, lw['g_mla_q'])
    qb = (cq @ lw['w_mla_uq']).reshape(B, T, H_B, QK_NOPE + QK_ROPE)
    q_nope, q_rope = qb[..., :QK_NOPE], rope(qb[..., QK_NOPE:], pos)
    ckv = rmsnorm(ckv, lw['g_mla_kv'])
    kr = rope(kr[:, :, None, :], pos)[:, :, 0, :]
    q_lat = jnp.einsum('bthn,lhn->bthl', q_nope, lw['w_mla_uk'])
    if past_lat is None:
        kv_all, kr_all, k_pos = ckv, kr, pos
    else:
        kv_all = jnp.concatenate([past_lat, ckv], axis=1)
        kr_all = jnp.concatenate([past_kr, kr], axis=1)
        k_pos = jnp.concatenate([jnp.arange(past_lat.shape[1], dtype=jnp.int32), pos])
    o_lat = mla_attend(q_lat, q_rope, kv_all, kr_all, pos, k_pos)
    o_b = jnp.einsum('bthl,lhv->bthv', o_lat, lw['w_mla_uv'])
    o_b = rmsnorm(o_b, lw['g_mla_out']).reshape(B, T, H_B * V_B)

    mix = jnp.concatenate([o_a, o_b], axis=-1) @ lw['w_o']
    x = x + gt1 * rmsnorm(mix, lw['g_post_mix'])

    h2 = rmsnorm(x, lw['g_pre_ffn']) * (1.0 + sc2) + sh2
    u = h2 @ lw['w_ffn_up']
    if conv_buf is None:
        conv_buf = jnp.zeros((B, CONV_W - 1, u.shape[-1]), dtype=u.dtype)
    padded = jnp.concatenate([conv_buf.astype(u.dtype), u], axis=1)
    w_c = lw['w_ffn_conv']
    uc = sum(w_c[j] * padded[:, j:j + T] for j in range(CONV_W)) + lw['b_ffn_conv']
    a_up, g_up = uc[..., :D_FF], uc[..., D_FF:]
    y = (a_up * jax.nn.gelu(g_up)) @ lw['w_ffn_down']
    x = x + gt2 * rmsnorm(y, lw['g_post_ffn'])
    new_conv = padded[:, -(CONV_W - 1):]
    return x, ckv, kr, s_a, new_conv


def setup_inputs(seed: int = 0) -> dict:
    key = jax.random.key(seed)
    ks = jax.random.split(key, 40)
    f32 = jnp.float32
    n_pages = PAST_LEN // PAGE_SIZE
    n_used = DEC_BATCH * n_pages
    n_phys = n_used + n_used // 4

    def nrm(k, shape, scale):
        return jax.random.normal(k, shape, f32) * scale

    def gain(k, shape):
        return 1.0 + 0.1 * jax.random.normal(k, shape, f32)

    page_table = jax.random.permutation(ks[0], n_phys)[:n_used].reshape(DEC_BATCH, n_pages).astype(jnp.int32)
    return {
        'x_prompt': nrm(ks[1], (BATCH, SEQ, D_MODEL), 1.0),
        'x_sample': nrm(ks[2], (DEC_BATCH, DEC_SEQ, D_MODEL), 1.0),
        'c_prompt': nrm(ks[3], (BATCH, D_MODEL), 1.0),
        'c_sample': nrm(ks[4], (DEC_BATCH, D_MODEL), 1.0),
        'cache_latent': nrm(ks[5], (DEPTH, n_phys, PAGE_SIZE, KV_LORA), 1.0),
        'cache_krope': nrm(ks[6], (DEPTH, n_phys, PAGE_SIZE, QK_ROPE), 1.0),
        'state_gla': nrm(ks[7], (DEPTH, DEC_BATCH, H_A, DK_A, DV_A), 0.5),
        'state_conv': nrm(ks[8], (DEPTH, DEC_BATCH, CONV_W - 1, 2 * D_FF), 1.0),
        'page_table': page_table,
        'w_ada': nrm(ks[9], (DEPTH, D_MODEL, 6 * D_MODEL), 0.5 * D_MODEL ** -0.5),
        'b_ada': nrm(ks[10], (DEPTH, 6 * D_MODEL), 0.01),
        'g_pre_mix': gain(ks[11], (DEPTH, D_MODEL)),
        'g_post_mix': gain(ks[12], (DEPTH, D_MODEL)),
        'g_pre_ffn': gain(ks[13], (DEPTH, D_MODEL)),
        'g_post_ffn': gain(ks[14], (DEPTH, D_MODEL)),
        'w_in': nrm(ks[15], (DEPTH, D_MODEL, IN_COLS), D_MODEL ** -0.5),
        'w_gla_a2': nrm(ks[16], (DEPTH, GATE_RANK, H_A * DK_A), GATE_RANK ** -0.5),
        'b_gla_a': nrm(ks[17], (DEPTH, H_A * DK_A), 0.01),
        'g_gla_out': gain(ks[18], (DEPTH, DV_A)),
        'g_mla_q': gain(ks[19], (DEPTH, Q_LORA)),
        'g_mla_kv': gain(ks[20], (DEPTH, KV_LORA)),
        'w_mla_uq': nrm(ks[21], (DEPTH, Q_LORA, H_B * (QK_NOPE + QK_ROPE)), Q_LORA ** -0.5),
        'w_mla_uk': nrm(ks[22], (DEPTH, KV_LORA, H_B, QK_NOPE), KV_LORA ** -0.5),
        'w_mla_uv': nrm(ks[23], (DEPTH, KV_LORA, H_B, V_B), KV_LORA ** -0.5),
        'g_mla_out': gain(ks[24], (DEPTH, V_B)),
        'w_o': nrm(ks[25], (DEPTH, MIX_WIDTH, D_MODEL), MIX_WIDTH ** -0.5),
        'w_ffn_up': nrm(ks[26], (DEPTH, D_MODEL, 2 * D_FF), D_MODEL ** -0.5),
        'w_ffn_conv': nrm(ks[27], (DEPTH, CONV_W, 2 * D_FF), CONV_W ** -0.5),
        'b_ffn_conv': nrm(ks[28], (DEPTH, 2 * D_FF), 0.01),
        'w_ffn_down': nrm(ks[29], (DEPTH, D_FF, D_MODEL), D_FF ** -0.5),
    }


def reference(x_prompt, x_sample, c_prompt, c_sample, cache_latent, cache_krope, state_gla, state_conv,
              page_table, w_ada, b_ada, g_pre_mix, g_post_mix, g_pre_ffn, g_post_ffn, w_in, w_gla_a2,
              b_gla_a, g_gla_out, g_mla_q, g_mla_kv, w_mla_uq, w_mla_uk, w_mla_uv, g_mla_out, w_o,
              w_ffn_up, w_ffn_conv, b_ffn_conv, w_ffn_down):
    B, T = x_prompt.shape[0], x_prompt.shape[1]
    Bd, Td = x_sample.shape[0], x_sample.shape[1]
    n_pages = page_table.shape[1]
    past_len = n_pages * cache_latent.shape[2]
    pos_p = jnp.arange(T, dtype=jnp.int32)
    pos_s = past_len + jnp.arange(Td, dtype=jnp.int32)

    hp, hs = x_prompt, x_sample
    lat_p, kr_p, gla_p, conv_p = [], [], [], []
    lat_s, kr_s, gla_s, conv_s = [], [], [], []
    for l in range(DEPTH):
        lw = dict(w_ada=w_ada[l], b_ada=b_ada[l], g_pre_mix=g_pre_mix[l], g_post_mix=g_post_mix[l],
                  g_pre_ffn=g_pre_ffn[l], g_post_ffn=g_post_ffn[l], w_in=w_in[l], w_gla_a2=w_gla_a2[l],
                  b_gla_a=b_gla_a[l], g_gla_out=g_gla_out[l], g_mla_q=g_mla_q[l], g_mla_kv=g_mla_kv[l],
                  w_mla_uq=w_mla_uq[l], w_mla_uk=w_mla_uk[l], w_mla_uv=w_mla_uv[l], g_mla_out=g_mla_out[l],
                  w_o=w_o[l], w_ffn_up=w_ffn_up[l], w_ffn_conv=w_ffn_conv[l], b_ffn_conv=b_ffn_conv[l],
                  w_ffn_down=w_ffn_down[l])
        s0 = jnp.zeros((B, H_A, DK_A, DV_A), dtype=jnp.float32)
        hp, a1, a2, a3, a4 = trunk_layer(hp, c_prompt, pos_p, s0, None, None, None, lw)
        lat_p.append(a1); kr_p.append(a2); gla_p.append(a3); conv_p.append(a4)
        past_lat = cache_latent[l][page_table].reshape(Bd, past_len, KV_LORA)
        past_kr = cache_krope[l][page_table].reshape(Bd, past_len, QK_ROPE)
        hs, b1, b2, b3, b4 = trunk_layer(hs, c_sample, pos_s, state_gla[l], state_conv[l], past_lat, past_kr, lw)
        lat_s.append(b1); kr_s.append(b2); gla_s.append(b3); conv_s.append(b4)

    return (hp, hs, jnp.stack(lat_p), jnp.stack(kr_p), jnp.stack(gla_p), jnp.stack(conv_p),
            jnp.stack(lat_s), jnp.stack(kr_s), jnp.stack(gla_s), jnp.stack(conv_s))
```

```cpp
#include <hip/hip_runtime.h>
#include <cstdio>
#include <cmath>
namespace nv {
constexpr int D = 1024, NB = 8, T = 2048, DB = 32, DT = 8, MP = NB * T, MS = DB * DT, MT = MP + MS;
constexpr int INC = 2256, FF = 2816, F2 = 5632, PAST = 16384, NPG = 128;
constexpr int O_QA = 0, O_KA = 256, O_VA = 512, O_RA = 1024, O_GR = 1536, O_CQ = 1552, O_CKV = 1936, O_KR = 2192;
constexpr size_t OUT_YP = 0, OUT_YS = OUT_YP + (size_t)MP * D, OUT_LATP = OUT_YS + (size_t)MS * D, OUT_KRP = OUT_LATP + (size_t)MP * 256,
                 OUT_GLAP = OUT_KRP + (size_t)MP * 64, OUT_CONVP = OUT_GLAP + (size_t)NB * 4 * 64 * 128, OUT_LATS = OUT_CONVP + (size_t)NB * 2 * F2,
                 OUT_KRS = OUT_LATS + (size_t)MS * 256, OUT_GLAS = OUT_KRS + (size_t)MS * 64, OUT_CONVS = OUT_GLAS + (size_t)DB * 4 * 64 * 128,
                 OUT_END = OUT_CONVS + (size_t)DB * 2 * F2;

struct In {
  const float *x_p, *x_s, *c_p, *c_s, *cache_lat, *cache_kr, *state_gla, *state_conv; const int* page_table;
  const float *w_ada, *b_ada, *g_pre_mix, *g_post_mix, *g_pre_ffn, *g_post_ffn, *w_in, *w_gla_a2, *b_gla_a, *g_gla_out, *g_mla_q, *g_mla_kv,
      *w_mla_uq, *w_mla_uk, *w_mla_uv, *g_mla_out, *w_o, *w_ffn_up, *w_ffn_conv, *b_ffn_conv, *w_ffn_down;
};
__host__ inline In make_in(void* const* d) {
  In i;
  i.x_p = (const float*)d[0]; i.x_s = (const float*)d[1]; i.c_p = (const float*)d[2]; i.c_s = (const float*)d[3]; i.cache_lat = (const float*)d[4];
  i.cache_kr = (const float*)d[5]; i.state_gla = (const float*)d[6]; i.state_conv = (const float*)d[7]; i.page_table = (const int*)d[8];
  i.w_ada = (const float*)d[9]; i.b_ada = (const float*)d[10]; i.g_pre_mix = (const float*)d[11]; i.g_post_mix = (const float*)d[12];
  i.g_pre_ffn = (const float*)d[13]; i.g_post_ffn = (const float*)d[14]; i.w_in = (const float*)d[15]; i.w_gla_a2 = (const float*)d[16];
  i.b_gla_a = (const float*)d[17]; i.g_gla_out = (const float*)d[18]; i.g_mla_q = (const float*)d[19]; i.g_mla_kv = (const float*)d[20];
  i.w_mla_uq = (const float*)d[21]; i.w_mla_uk = (const float*)d[22]; i.w_mla_uv = (const float*)d[23]; i.g_mla_out = (const float*)d[24];
  i.w_o = (const float*)d[25]; i.w_ffn_up = (const float*)d[26]; i.w_ffn_conv = (const float*)d[27]; i.b_ffn_conv = (const float*)d[28];
  i.w_ffn_down = (const float*)d[29];
  return i;
}
__device__ __forceinline__ int row_cond(int r) { return r < MP ? r / T : NB + (r - MP) / DT; }
__device__ __forceinline__ int row_pos(int r) { return r < MP ? r % T : PAST + (r - MP) % DT; }
__device__ __forceinline__ const float* row_x(const In& in, int r) { return r < MP ? in.x_p + (size_t)r * D : in.x_s + (size_t)(r - MP) * D; }
__device__ __forceinline__ float silu_f(float v) { return v / (1.f + expf(-v)); }
__device__ __forceinline__ float block_sum(float v, float* red) {
  for (int o = 32; o; o >>= 1) v += __shfl_xor(v, o);
  __syncthreads();
  if ((threadIdx.x & 63) == 0) red[threadIdx.x >> 6] = v;
  __syncthreads();
  float s = 0.f; for (int i = 0; i < (int)(blockDim.x >> 6); ++i) s += red[i];
  return s;
}
__global__ void k_mod(In in, float* mod) {
  const int n = blockIdx.x * 256 + threadIdx.x, r = blockIdx.y;
  const float* c = r < NB ? in.c_p + (size_t)r * D : in.c_s + (size_t)(r - NB) * D;
  float a = in.b_ada[n];
  for (int k = 0; k < D; ++k) a += silu_f(c[k]) * in.w_ada[(size_t)k * 6144 + n];
  mod[(size_t)r * 6144 + n] = a;
}
__global__ void k_norm_mod(In in, const float* src, const float* g, const float* mod, int sh_off, int sc_off, float* out) {
  __shared__ float red[16];
  const int r = blockIdx.x; const float* x = src ? src + (size_t)r * D : row_x(in, r);
  float s = 0.f; for (int k = threadIdx.x; k < D; k += blockDim.x) s += x[k] * x[k];
  s = block_sum(s, red); const float rs = rsqrtf(s / D + 1e-6f);
  const float* m = mod + (size_t)row_cond(r) * 6144;
  for (int k = threadIdx.x; k < D; k += blockDim.x) out[(size_t)r * D + k] = x[k] * rs * g[k] * (1.f + m[sc_off + k]) + m[sh_off + k];
}
struct GemmP { const float* A; const float* B; float* C; int M, N, K, sam, sbk, sbn, ldc, nb2; long sA1, sA2, sB1, sB2, sC1, sC2; };
__global__ void __launch_bounds__(256) k_sgemm(GemmP p) {
  __shared__ float As[16][65], Bs[16][65];
  const int z1 = blockIdx.z / p.nb2, z2 = blockIdx.z % p.nb2;
  const float* A = p.A + z1 * p.sA1 + z2 * p.sA2; const float* B = p.B + z1 * p.sB1 + z2 * p.sB2; float* C = p.C + z1 * p.sC1 + z2 * p.sC2;
  const int m0 = blockIdx.y * 64, n0 = blockIdx.x * 64, tx = threadIdx.x & 15, ty = threadIdx.x >> 4;
  float acc[4][4] = {};
  for (int k0 = 0; k0 < p.K; k0 += 16) {
    for (int i = threadIdx.x; i < 1024; i += 256) {
      { const int m = i >> 4, k = i & 15; As[k][m] = (m0 + m < p.M) ? A[(size_t)(m0 + m) * p.sam + k0 + k] : 0.f; }
      { int k, n; if (p.sbn == 1) { k = i >> 6; n = i & 63; } else { n = i >> 4; k = i & 15; }
        Bs[k][n] = (n0 + n < p.N) ? B[(size_t)(k0 + k) * p.sbk + (size_t)(n0 + n) * p.sbn] : 0.f; }
    }
    __syncthreads();
#pragma unroll
    for (int k = 0; k < 16; ++k) {
      float a[4], b[4];
#pragma unroll
      for (int i = 0; i < 4; ++i) { a[i] = As[k][ty * 4 + i]; b[i] = Bs[k][tx * 4 + i]; }
#pragma unroll
      for (int i = 0; i < 4; ++i)
#pragma unroll
        for (int j = 0; j < 4; ++j) acc[i][j] += a[i] * b[j];
    }
    __syncthreads();
  }
  for (int i = 0; i < 4; ++i) for (int j = 0; j < 4; ++j) { const int m = m0 + ty * 4 + i, n = n0 + tx * 4 + j; if (m < p.M && n < p.N) C[(size_t)m * p.ldc + n] = acc[i][j]; }
}
inline void sgemm(hipStream_t st, const float* A, const float* B, float* C, int M, int N, int K, int sam, int sbk, int sbn, int ldc,
                  int nb1 = 1, int nb2 = 1, long sA1 = 0, long sA2 = 0, long sB1 = 0, long sB2 = 0, long sC1 = 0, long sC2 = 0) {
  GemmP p{A, B, C, M, N, K, sam, sbk, sbn, ldc, nb2, sA1, sA2, sB1, sB2, sC1, sC2};
  hipLaunchKernelGGL(k_sgemm, dim3((N + 63) / 64, (M + 63) / 64, nb1 * nb2), dim3(256), 0, st, p);
}
__device__ __forceinline__ void rope_cs(int pos, int i, float& c, float& s) {
  const float inv = powf(10000.0f, -(float)(2 * i) / 64.0f); const float ang = (float)pos * inv; c = cosf(ang); s = sinf(ang);
}
__global__ void k_zpost(In in, const float* z, float* cqn, float* kcat, float* loga, float* out) {
  __shared__ float red[16];
  const int r = blockIdx.x, t = threadIdx.x; const float* zr = z + (size_t)r * INC;
  { float s = 0.f; for (int k = t; k < 384; k += 256) s += zr[O_CQ + k] * zr[O_CQ + k];
    s = block_sum(s, red); const float rs = rsqrtf(s / 384.f + 1e-6f);
    for (int k = t; k < 384; k += 256) cqn[(size_t)r * 384 + k] = zr[O_CQ + k] * rs * in.g_mla_q[k]; }
  { const float v = zr[O_CKV + t]; float s = block_sum(v * v, red); const float rs = rsqrtf(s / 256.f + 1e-6f);
    const float o = v * rs * in.g_mla_kv[t]; kcat[(size_t)r * 320 + t] = o;
    if (r < MP) out[OUT_LATP + (size_t)r * 256 + t] = o; else out[OUT_LATS + (size_t)(r - MP) * 256 + t] = o; }
  if (t < 32) { float c, s; rope_cs(row_pos(r), t, c, s); const float x1 = zr[O_KR + t], x2 = zr[O_KR + 32 + t];
    const float o1 = x1 * c - x2 * s, o2 = x1 * s + x2 * c; kcat[(size_t)r * 320 + 256 + t] = o1; kcat[(size_t)r * 320 + 288 + t] = o2;
    float* ko = r < MP ? out + OUT_KRP + (size_t)r * 64 : out + OUT_KRS + (size_t)(r - MP) * 64; ko[t] = o1; ko[32 + t] = o2; }
  { float a = in.b_gla_a[t]; for (int j = 0; j < 16; ++j) a += zr[O_GR + j] * in.w_gla_a2[j * 256 + t];
    const float ls = fminf(a, 0.f) - log1pf(expf(-fabsf(a)));
    loga[(size_t)r * 256 + t] = ls / 16.f; }
}
__global__ void k_qrope(const float* qb, float* qcat) {
  const int r = blockIdx.x, h = threadIdx.x >> 5, i = threadIdx.x & 31;
  float c, s; rope_cs(row_pos(r), i, c, s);
  const float x1 = qb[(size_t)r * 768 + h * 192 + 128 + i], x2 = qb[(size_t)r * 768 + h * 192 + 160 + i];
  qcat[(size_t)r * 1280 + h * 320 + 256 + i] = x1 * c - x2 * s; qcat[(size_t)r * 1280 + h * 320 + 288 + i] = x1 * s + x2 * c;
}
__global__ void k_softmax_causal(float* S, float scale) {
  __shared__ float red[16];
  const int t = blockIdx.x; float* row = S + ((size_t)blockIdx.y * T + t) * T;
  float m = -INFINITY; for (int s = threadIdx.x; s <= t; s += blockDim.x) m = fmaxf(m, row[s] * scale);
  for (int o = 32; o; o >>= 1) m = fmaxf(m, __shfl_xor(m, o));
  __syncthreads(); if ((threadIdx.x & 63) == 0) red[threadIdx.x >> 6] = m; __syncthreads();
  for (int i = 0; i < (int)(blockDim.x >> 6); ++i) m = fmaxf(m, red[i]);
  float sum = 0.f; for (int s = threadIdx.x; s < T; s += blockDim.x) { const float e = s <= t ? expf(row[s] * scale - m) : 0.f; row[s] = e; sum += e; }
  sum = block_sum(sum, red); const float inv = 1.f / sum;
  for (int s = threadIdx.x; s < T; s += blockDim.x) row[s] *= inv;
}
constexpr int NKEY = PAST + DT, NKEYP = PAST + 32;
__global__ void __launch_bounds__(256) k_dec_scores(In in, const float* qcat, const float* kcat, float* Ss) {
  __shared__ float Qs[32][320]; __shared__ float Ks[16][321];
  const int b = blockIdx.y, tile = blockIdx.x;
  for (int i = threadIdx.x; i < 32 * 320; i += 256) Qs[i / 320][i % 320] = qcat[(size_t)(MP + b * DT) * 1280 + i];
  const int nsub = tile < NPG ? 8 : 1;
  for (int sub = 0; sub < nsub; ++sub) {
    __syncthreads();
    for (int i = threadIdx.x; i < 16 * 320; i += 256) { const int k = i / 320, d = i % 320; float v;
      if (tile < NPG) { const int pg = in.page_table[b * NPG + tile], rw = sub * 16 + k;
        v = d < 256 ? in.cache_lat[((size_t)pg * 128 + rw) * 256 + d] : in.cache_kr[((size_t)pg * 128 + rw) * 64 + d - 256]; }
      else v = k < DT ? kcat[(size_t)(MP + b * DT + k) * 320 + d] : 0.f;
      Ks[k][d] = v; }
    __syncthreads();
    const int key = threadIdx.x & 15, rg = threadIdx.x >> 4; float a[2] = {0.f, 0.f};
    for (int d = 0; d < 320; ++d) { const float kv = Ks[key][d];
#pragma unroll
      for (int i = 0; i < 2; ++i) a[i] += kv * Qs[rg * 2 + i][d]; }
    const int j = tile * 128 + sub * 16 + key;
    for (int i = 0; i < 2; ++i) Ss[((size_t)b * 32 + rg * 2 + i) * NKEYP + j] = a[i];
  }
}
__global__ void k_dec_softmax(float* Ss, float scale) {
  __shared__ float red[16];
  const int rowi = blockIdx.x, tq = (rowi & 31) >> 2; float* row = Ss + (size_t)rowi * NKEYP; const int nk = PAST + tq + 1;
  float m = -INFINITY; for (int s = threadIdx.x; s < nk; s += blockDim.x) m = fmaxf(m, row[s] * scale);
  for (int o = 32; o; o >>= 1) m = fmaxf(m, __shfl_xor(m, o));
  __syncthreads(); if ((threadIdx.x & 63) == 0) red[threadIdx.x >> 6] = m; __syncthreads();
  for (int i = 0; i < (int)(blockDim.x >> 6); ++i) m = fmaxf(m, red[i]);
  float sum = 0.f; for (int s = threadIdx.x; s < NKEYP; s += blockDim.x) { const float e = s < nk ? expf(row[s] * scale - m) : 0.f; row[s] = e; sum += e; }
  sum = block_sum(sum, red); const float inv = 1.f / sum;
  for (int s = threadIdx.x; s < NKEYP; s += blockDim.x) row[s] *= inv;
}
__global__ void __launch_bounds__(256) k_dec_pv(In in, const float* Ss, const float* kcat, float* olat) {
  __shared__ float Ps[32][129];
  const int b = blockIdx.y, l = blockIdx.x * 64 + (threadIdx.x & 63), rg = threadIdx.x >> 6;
  float a[8] = {};
  for (int tile = 0; tile <= NPG; ++tile) {
    __syncthreads();
    for (int i = threadIdx.x; i < 32 * 128; i += 256) { const int r = i >> 7, k = i & 127, j = tile * 128 + k; Ps[r][k] = j < NKEYP ? Ss[((size_t)b * 32 + r) * NKEYP + j] : 0.f; }
    __syncthreads();
    const int nk = tile < NPG ? 128 : DT; const int pg = tile < NPG ? in.page_table[b * NPG + tile] : 0;
    for (int k = 0; k < nk; ++k) { const float v = tile < NPG ? in.cache_lat[((size_t)pg * 128 + k) * 256 + l] : kcat[(size_t)(MP + b * DT + k) * 320 + l];
#pragma unroll
      for (int i = 0; i < 8; ++i) a[i] += Ps[rg * 8 + i][k] * v; }
  }
  for (int i = 0; i < 8; ++i) { const int r = rg * 8 + i, t = r >> 2, h = r & 3; olat[((size_t)(MP + b * DT + t) * 4 + h) * 256 + l] = a[i]; }
}
__global__ void k_obnorm(In in, const float* ob, float* mixin) {
  const int r = blockIdx.x, h = threadIdx.x >> 6, l = threadIdx.x & 63;
  const float a = ob[(size_t)r * 512 + h * 128 + l], c = ob[(size_t)r * 512 + h * 128 + 64 + l];
  float s = a * a + c * c; for (int o = 32; o; o >>= 1) s += __shfl_xor(s, o);
  const float rs = rsqrtf(s / 128.f + 1e-6f);
  mixin[(size_t)r * D + 512 + h * 128 + l] = a * rs * in.g_mla_out[l]; mixin[(size_t)r * D + 512 + h * 128 + 64 + l] = c * rs * in.g_mla_out[64 + l];
}
__global__ void __launch_bounds__(512) k_gla(In in, const float* z, const float* loga, float* mixin, float* out) {
  __shared__ float part[4][128]; __shared__ float red[16];
  const int bh = blockIdx.x; const bool samp = bh >= NB * 4; const int b = samp ? (bh - NB * 4) >> 2 : bh >> 2, h = bh & 3;
  const int v = threadIdx.x & 127, kq = threadIdx.x >> 7; const int nt = samp ? DT : T; const int r0 = samp ? MP + b * DT : b * T;
  float S[16];
  for (int i = 0; i < 16; ++i) S[i] = samp ? in.state_gla[(((size_t)b * 4 + h) * 64 + kq * 16 + i) * 128 + v] : 0.f;
  for (int t = 0; t < nt; ++t) {
    const float* zr = z + (size_t)(r0 + t) * INC; const float* la = loga + (size_t)(r0 + t) * 256 + h * 64 + kq * 16;
    const float vv = zr[O_VA + h * 128 + v]; float o = 0.f;
    for (int i = 0; i < 16; ++i) { const int k = kq * 16 + i; S[i] = expf(la[i]) * S[i] + zr[O_KA + h * 64 + k] * vv; o += zr[O_QA + h * 64 + k] * 0.125f * S[i]; }
    part[kq][v] = o; __syncthreads();
    float ot = 0.f, sq = 0.f;
    if (kq == 0) { ot = part[0][v] + part[1][v] + part[2][v] + part[3][v]; sq = ot * ot; }
    sq = block_sum(sq, red);
    if (kq == 0) { const float rs = rsqrtf(sq / 128.f + 1e-6f); mixin[(size_t)(r0 + t) * D + h * 128 + v] = ot * rs * in.g_gla_out[v] * silu_f(zr[O_RA + h * 128 + v]); }
    __syncthreads();
  }
  float* so = samp ? out + OUT_GLAS : out + OUT_GLAP;
  for (int i = 0; i < 16; ++i) so[(((size_t)b * 4 + h) * 64 + kq * 16 + i) * 128 + v] = S[i];
}
__global__ void k_resid(In in, const float* xin, const float* y, const float* g, const float* mod, int gate_off, float* dst, float* out) {
  __shared__ float red[16];
  const int r = blockIdx.x; const float* x = xin ? xin + (size_t)r * D : row_x(in, r); const float* yr = y + (size_t)r * D;
  float s = 0.f; for (int k = threadIdx.x; k < D; k += blockDim.x) s += yr[k] * yr[k];
  s = block_sum(s, red); const float rs = rsqrtf(s / D + 1e-6f);
  const float* m = mod + (size_t)row_cond(r) * 6144 + gate_off;
  float* o = dst ? dst + (size_t)r * D : (r < MP ? out + OUT_YP + (size_t)r * D : out + OUT_YS + (size_t)(r - MP) * D);
  for (int k = threadIdx.x; k < D; k += blockDim.x) o[k] = x[k] + m[k] * yr[k] * rs * g[k];
}
__device__ __forceinline__ float gelu_tanh(float x) { return 0.5f * x * (1.f + tanhf(0.7978845608028654f * (x + 0.044715f * x * x * x))); }
__global__ void k_convgelu(In in, const float* u, float* hmid, float* out) {
  const int r = blockIdx.x; const bool samp = r >= MP; const int t = samp ? (r - MP) % DT : r % T, b = samp ? (r - MP) / DT : r / T;
  for (int f = threadIdx.x; f < FF; f += blockDim.x) {
    float uc[2];
    for (int half = 0; half < 2; ++half) { const int c = f + half * FF; float a = in.b_ffn_conv[c];
      for (int j = 0; j < 3; ++j) { const int tt = t - 2 + j; float val;
        if (tt >= 0) val = u[(size_t)(r - 2 + j) * F2 + c]; else val = samp ? in.state_conv[((size_t)b * 2 + (tt + 2)) * F2 + c] : 0.f;
        a += in.w_ffn_conv[j * F2 + c] * val; }
      uc[half] = a; }
    hmid[(size_t)r * FF + f] = uc[0] * gelu_tanh(uc[1]);
  }
  const int nt = samp ? DT : T;
  if (t >= nt - 2) { float* co = samp ? out + OUT_CONVS + ((size_t)b * 2 + (t - (nt - 2))) * F2 : out + OUT_CONVP + ((size_t)b * 2 + (t - (nt - 2))) * F2;
    for (int c = threadIdx.x; c < F2; c += blockDim.x) co[c] = u[(size_t)r * F2 + c]; }
}

struct Ws { float *mod, *h, *z, *cqn, *kcat, *loga, *qb, *qcat, *S, *olat, *ob, *mixin, *mix, *x1, *u, *hmid, *y, *Ss; size_t end_floats; };
inline Ws carve(float* base) {
  Ws w; size_t o = 0; auto take = [&](size_t n) { float* p = base + o; o += (n + 63) & ~(size_t)63; return p; };
  w.mod = take(40 * 6144); w.h = take((size_t)MT * D); w.z = take((size_t)MT * INC); w.cqn = take((size_t)MT * 384); w.kcat = take((size_t)MT * 320);
  w.loga = take((size_t)MT * 256); w.qb = take((size_t)MT * 768); w.qcat = take((size_t)MT * 1280); w.S = take((size_t)NB * 4 * T * T);
  w.olat = take((size_t)MT * 1024); w.ob = take((size_t)MT * 512); w.mixin = take((size_t)MT * D); w.mix = take((size_t)MT * D); w.x1 = take((size_t)MT * D);
  w.u = take((size_t)MT * F2); w.hmid = take((size_t)MT * FF); w.y = take((size_t)MT * D); w.Ss = take((size_t)DB * 32 * NKEYP); w.end_floats = o;
  return w;
}

inline void run(hipStream_t st, const In& in, const Ws& w, float* out) {
  const float sc = 0.07216878364870322f;
  hipLaunchKernelGGL(k_mod, dim3(24, 40), dim3(256), 0, st, in, w.mod);
  hipLaunchKernelGGL(k_norm_mod, dim3(MT), dim3(256), 0, st, in, (const float*)nullptr, in.g_pre_mix, (const float*)w.mod, 0, 1024, w.h);
  sgemm(st, w.h, in.w_in, w.z, MT, INC, D, D, INC, 1, INC);
  hipLaunchKernelGGL(k_zpost, dim3(MT), dim3(256), 0, st, in, (const float*)w.z, w.cqn, w.kcat, w.loga, out);
  sgemm(st, w.cqn, in.w_mla_uq, w.qb, MT, 768, 384, 384, 768, 1, 768);
  hipLaunchKernelGGL(k_qrope, dim3(MT), dim3(128), 0, st, (const float*)w.qb, w.qcat);
  sgemm(st, w.qb, in.w_mla_uk, w.qcat, MT, 256, 128, 768, 1, 512, 1280, 1, 4, 0, 192, 0, 128, 0, 320);
  sgemm(st, w.qcat, w.kcat, w.S, T, T, 320, 1280, 1, 320, T, NB, 4, (long)T * 1280, 320, (long)T * 320, 0, (long)4 * T * T, (long)T * T);
  hipLaunchKernelGGL(k_softmax_causal, dim3(T, NB * 4), dim3(256), 0, st, w.S, sc);
  sgemm(st, w.S, w.kcat, w.olat, T, 256, T, T, 320, 1, 1024, NB, 4, (long)4 * T * T, (long)T * T, (long)T * 320, 0, (long)T * 1024, 256);
  hipLaunchKernelGGL(k_dec_scores, dim3(NPG + 1, DB), dim3(256), 0, st, in, (const float*)w.qcat, (const float*)w.kcat, w.Ss);
  hipLaunchKernelGGL(k_dec_softmax, dim3(DB * 32), dim3(256), 0, st, w.Ss, sc);
  hipLaunchKernelGGL(k_dec_pv, dim3(4, DB), dim3(256), 0, st, in, (const float*)w.Ss, (const float*)w.kcat, w.olat);
  sgemm(st, w.olat, in.w_mla_uv, w.ob, MT, 128, 256, 1024, 512, 1, 512, 1, 4, 0, 256, 0, 128, 0, 128);
  hipLaunchKernelGGL(k_obnorm, dim3(MT), dim3(256), 0, st, in, (const float*)w.ob, w.mixin);
  hipLaunchKernelGGL(k_gla, dim3(NB * 4 + DB * 4), dim3(512), 0, st, in, (const float*)w.z, (const float*)w.loga, w.mixin, out);
  sgemm(st, w.mixin, in.w_o, w.mix, MT, D, D, D, D, 1, D);
  hipLaunchKernelGGL(k_resid, dim3(MT), dim3(256), 0, st, in, (const float*)nullptr, (const float*)w.mix, in.g_post_mix, (const float*)w.mod, 2048, w.x1, out);
  hipLaunchKernelGGL(k_norm_mod, dim3(MT), dim3(256), 0, st, in, (const float*)w.x1, in.g_pre_ffn, (const float*)w.mod, 3072, 4096, w.h);
  sgemm(st, w.h, in.w_ffn_up, w.u, MT, F2, D, D, F2, 1, F2);
  hipLaunchKernelGGL(k_convgelu, dim3(MT), dim3(256), 0, st, in, (const float*)w.u, w.hmid, out);
  sgemm(st, w.hmid, in.w_ffn_down, w.y, MT, D, FF, FF, D, 1, D);
  hipLaunchKernelGGL(k_resid, dim3(MT), dim3(256), 0, st, in, (const float*)w.x1, (const float*)w.y, in.g_post_ffn, (const float*)w.mod, 5120, (float*)nullptr, out);
}
}
extern "C" void kernel_launch(void* const* d_in, const int* in_sizes, int n_in,
                              void* d_out, int out_size, void* d_ws, size_t ws_size,
                              hipStream_t stream) {
  nv::In in = nv::make_in(d_in);
  nv::Ws w = nv::carve((float*)d_ws);
  if (w.end_floats * 4 > ws_size || (size_t)out_size != nv::OUT_END) { fprintf(stderr, "bad sizes: ws %zu need %zu, out %d need %zu\n", ws_size, w.end_floats * 4, out_size, nv::OUT_END); return; }
  nv::run(stream, in, w, (float*)d_out);
}
```

```cpp
#include <hip/hip_runtime.h>
#include <cstdio>
#include <cmath>
#include <cstdint>
#define DIAG 0
#define DIAG_PH 13
namespace nv {
constexpr int D = 1024, NB = 8, T = 2048, DB = 32, DT = 8, MP = NB * T, MS = DB * DT, MT = MP + MS;
constexpr int INC = 2256, FF = 2816, F2 = 5632, PAST = 16384, NPG = 128;
constexpr int O_QA = 0, O_KA = 256, O_VA = 512, O_RA = 1024, O_GR = 1536, O_CQ = 1552, O_CKV = 1936, O_KR = 2192;
constexpr size_t OUT_YP = 0, OUT_YS = OUT_YP + (size_t)MP * D, OUT_LATP = OUT_YS + (size_t)MS * D, OUT_KRP = OUT_LATP + (size_t)MP * 256,
                 OUT_GLAP = OUT_KRP + (size_t)MP * 64, OUT_CONVP = OUT_GLAP + (size_t)NB * 4 * 64 * 128, OUT_LATS = OUT_CONVP + (size_t)NB * 2 * F2,
                 OUT_KRS = OUT_LATS + (size_t)MS * 256, OUT_GLAS = OUT_KRS + (size_t)MS * 64, OUT_CONVS = OUT_GLAS + (size_t)DB * 4 * 64 * 128,
                 OUT_END = OUT_CONVS + (size_t)DB * 2 * F2;

struct In {
  const float *x_p, *x_s, *c_p, *c_s, *cache_lat, *cache_kr, *state_gla, *state_conv; const int* page_table;
  const float *w_ada, *b_ada, *g_pre_mix, *g_post_mix, *g_pre_ffn, *g_post_ffn, *w_in, *w_gla_a2, *b_gla_a, *g_gla_out, *g_mla_q, *g_mla_kv,
      *w_mla_uq, *w_mla_uk, *w_mla_uv, *g_mla_out, *w_o, *w_ffn_up, *w_ffn_conv, *b_ffn_conv, *w_ffn_down;
};
__host__ inline In make_in(void* const* d) {
  In i;
  i.x_p = (const float*)d[0]; i.x_s = (const float*)d[1]; i.c_p = (const float*)d[2]; i.c_s = (const float*)d[3]; i.cache_lat = (const float*)d[4];
  i.cache_kr = (const float*)d[5]; i.state_gla = (const float*)d[6]; i.state_conv = (const float*)d[7]; i.page_table = (const int*)d[8];
  i.w_ada = (const float*)d[9]; i.b_ada = (const float*)d[10]; i.g_pre_mix = (const float*)d[11]; i.g_post_mix = (const float*)d[12];
  i.g_pre_ffn = (const float*)d[13]; i.g_post_ffn = (const float*)d[14]; i.w_in = (const float*)d[15]; i.w_gla_a2 = (const float*)d[16];
  i.b_gla_a = (const float*)d[17]; i.g_gla_out = (const float*)d[18]; i.g_mla_q = (const float*)d[19]; i.g_mla_kv = (const float*)d[20];
  i.w_mla_uq = (const float*)d[21]; i.w_mla_uk = (const float*)d[22]; i.w_mla_uv = (const float*)d[23]; i.g_mla_out = (const float*)d[24];
  i.w_o = (const float*)d[25]; i.w_ffn_up = (const float*)d[26]; i.w_ffn_conv = (const float*)d[27]; i.b_ffn_conv = (const float*)d[28];
  i.w_ffn_down = (const float*)d[29];
  return i;
}
__device__ __forceinline__ int row_cond(int r) { return r < MP ? r / T : NB + (r - MP) / DT; }
__device__ __forceinline__ int row_pos(int r) { return r < MP ? r % T : PAST + (r - MP) % DT; }
__device__ __forceinline__ const float* row_x(const In& in, int r) { return r < MP ? in.x_p + (size_t)r * D : in.x_s + (size_t)(r - MP) * D; }
__device__ __forceinline__ float silu_f(float v) { return v / (1.f + expf(-v)); }
__device__ __forceinline__ float block_sum(float v, float* red) {
  for (int o = 32; o; o >>= 1) v += __shfl_xor(v, o);
  __syncthreads();
  if ((threadIdx.x & 63) == 0) red[threadIdx.x >> 6] = v;
  __syncthreads();
  float s = 0.f; for (int i = 0; i < (int)(blockDim.x >> 6); ++i) s += red[i];
  return s;
}
__global__ void k_mod(In in, float* mod) {
  const int n = blockIdx.x * 256 + threadIdx.x, r = blockIdx.y;
  const float* c = r < NB ? in.c_p + (size_t)r * D : in.c_s + (size_t)(r - NB) * D;
  float a = in.b_ada[n];
  for (int k = 0; k < D; ++k) a += silu_f(c[k]) * in.w_ada[(size_t)k * 6144 + n];
  mod[(size_t)r * 6144 + n] = a;
}
__global__ void k_norm_mod(In in, const float* src, const float* g, const float* mod, int sh_off, int sc_off, float* out) {
  __shared__ float red[16];
  const int r = blockIdx.x; const float* x = src ? src + (size_t)r * D : row_x(in, r);
  float s = 0.f; for (int k = threadIdx.x; k < D; k += blockDim.x) s += x[k] * x[k];
  s = block_sum(s, red); const float rs = rsqrtf(s / D + 1e-6f);
  const float* m = mod + (size_t)row_cond(r) * 6144;
  for (int k = threadIdx.x; k < D; k += blockDim.x) out[(size_t)r * D + k] = x[k] * rs * g[k] * (1.f + m[sc_off + k]) + m[sh_off + k];
}
struct GemmP { const float* A; const float* B; float* C; int M, N, K, sam, sbk, sbn, ldc, nb2; long sA1, sA2, sB1, sB2, sC1, sC2; };
__global__ void __launch_bounds__(256) k_sgemm(GemmP p) {
  __shared__ float As[16][65], Bs[16][65];
  const int z1 = blockIdx.z / p.nb2, z2 = blockIdx.z % p.nb2;
  const float* A = p.A + z1 * p.sA1 + z2 * p.sA2; const float* B = p.B + z1 * p.sB1 + z2 * p.sB2; float* C = p.C + z1 * p.sC1 + z2 * p.sC2;
  const int m0 = blockIdx.y * 64, n0 = blockIdx.x * 64, tx = threadIdx.x & 15, ty = threadIdx.x >> 4;
  float acc[4][4] = {};
  for (int k0 = 0; k0 < p.K; k0 += 16) {
    for (int i = threadIdx.x; i < 1024; i += 256) {
      { const int m = i >> 4, k = i & 15; As[k][m] = (m0 + m < p.M) ? A[(size_t)(m0 + m) * p.sam + k0 + k] : 0.f; }
      { int k, n; if (p.sbn == 1) { k = i >> 6; n = i & 63; } else { n = i >> 4; k = i & 15; }
        Bs[k][n] = (n0 + n < p.N) ? B[(size_t)(k0 + k) * p.sbk + (size_t)(n0 + n) * p.sbn] : 0.f; }
    }
    __syncthreads();
#pragma unroll
    for (int k = 0; k < 16; ++k) {
      float a[4], b[4];
#pragma unroll
      for (int i = 0; i < 4; ++i) { a[i] = As[k][ty * 4 + i]; b[i] = Bs[k][tx * 4 + i]; }
#pragma unroll
      for (int i = 0; i < 4; ++i)
#pragma unroll
        for (int j = 0; j < 4; ++j) acc[i][j] += a[i] * b[j];
    }
    __syncthreads();
  }
  for (int i = 0; i < 4; ++i) for (int j = 0; j < 4; ++j) { const int m = m0 + ty * 4 + i, n = n0 + tx * 4 + j; if (m < p.M && n < p.N) C[(size_t)m * p.ldc + n] = acc[i][j]; }
}
inline void sgemm(hipStream_t st, const float* A, const float* B, float* C, int M, int N, int K, int sam, int sbk, int sbn, int ldc,
                  int nb1 = 1, int nb2 = 1, long sA1 = 0, long sA2 = 0, long sB1 = 0, long sB2 = 0, long sC1 = 0, long sC2 = 0) {
  GemmP p{A, B, C, M, N, K, sam, sbk, sbn, ldc, nb2, sA1, sA2, sB1, sB2, sC1, sC2};
  hipLaunchKernelGGL(k_sgemm, dim3((N + 63) / 64, (M + 63) / 64, nb1 * nb2), dim3(256), 0, st, p);
}
__device__ __forceinline__ void rope_cs(int pos, int i, float& c, float& s) {
  const float inv = powf(10000.0f, -(float)(2 * i) / 64.0f); const float ang = (float)pos * inv; c = cosf(ang); s = sinf(ang);
}
__global__ void k_zpost(In in, const float* z, float* cqn, float* kcat, float* loga, float* out) {
  __shared__ float red[16];
  const int r = blockIdx.x, t = threadIdx.x; const float* zr = z + (size_t)r * INC;
  { float s = 0.f; for (int k = t; k < 384; k += 256) s += zr[O_CQ + k] * zr[O_CQ + k];
    s = block_sum(s, red); const float rs = rsqrtf(s / 384.f + 1e-6f);
    for (int k = t; k < 384; k += 256) cqn[(size_t)r * 384 + k] = zr[O_CQ + k] * rs * in.g_mla_q[k]; }
  { const float v = zr[O_CKV + t]; float s = block_sum(v * v, red); const float rs = rsqrtf(s / 256.f + 1e-6f);
    const float o = v * rs * in.g_mla_kv[t]; kcat[(size_t)r * 320 + t] = o;
    if (r < MP) out[OUT_LATP + (size_t)r * 256 + t] = o; else out[OUT_LATS + (size_t)(r - MP) * 256 + t] = o; }
  if (t < 32) { float c, s; rope_cs(row_pos(r), t, c, s); const float x1 = zr[O_KR + t], x2 = zr[O_KR + 32 + t];
    const float o1 = x1 * c - x2 * s, o2 = x1 * s + x2 * c; kcat[(size_t)r * 320 + 256 + t] = o1; kcat[(size_t)r * 320 + 288 + t] = o2;
    float* ko = r < MP ? out + OUT_KRP + (size_t)r * 64 : out + OUT_KRS + (size_t)(r - MP) * 64; ko[t] = o1; ko[32 + t] = o2; }
  { float a = in.b_gla_a[t]; for (int j = 0; j < 16; ++j) a += zr[O_GR + j] * in.w_gla_a2[j * 256 + t];
    const float ls = fminf(a, 0.f) - log1pf(expf(-fabsf(a)));
    loga[(size_t)r * 256 + t] = ls / 16.f; }
}
__global__ void k_qrope(const float* qb, float* qcat) {
  const int r = blockIdx.x, h = threadIdx.x >> 5, i = threadIdx.x & 31;
  float c, s; rope_cs(row_pos(r), i, c, s);
  const float x1 = qb[(size_t)r * 768 + h * 192 + 128 + i], x2 = qb[(size_t)r * 768 + h * 192 + 160 + i];
  qcat[(size_t)r * 1280 + h * 320 + 256 + i] = x1 * c - x2 * s; qcat[(size_t)r * 1280 + h * 320 + 288 + i] = x1 * s + x2 * c;
}
__global__ void k_softmax_causal(float* S, float scale) {
  __shared__ float red[16];
  const int t = blockIdx.x; float* row = S + ((size_t)blockIdx.y * T + t) * T;
  float m = -INFINITY; for (int s = threadIdx.x; s <= t; s += blockDim.x) m = fmaxf(m, row[s] * scale);
  for (int o = 32; o; o >>= 1) m = fmaxf(m, __shfl_xor(m, o));
  __syncthreads(); if ((threadIdx.x & 63) == 0) red[threadIdx.x >> 6] = m; __syncthreads();
  for (int i = 0; i < (int)(blockDim.x >> 6); ++i) m = fmaxf(m, red[i]);
  float sum = 0.f; for (int s = threadIdx.x; s < T; s += blockDim.x) { const float e = s <= t ? expf(row[s] * scale - m) : 0.f; row[s] = e; sum += e; }
  sum = block_sum(sum, red); const float inv = 1.f / sum;
  for (int s = threadIdx.x; s < T; s += blockDim.x) row[s] *= inv;
}
constexpr int NKEY = PAST + DT, NKEYP = PAST + 32;
__global__ void __launch_bounds__(256) k_dec_scores(In in, const float* qcat, const float* kcat, float* Ss) {
  __shared__ float Qs[32][320]; __shared__ float Ks[16][321];
  const int b = blockIdx.y, tile = blockIdx.x;
  for (int i = threadIdx.x; i < 32 * 320; i += 256) Qs[i / 320][i % 320] = qcat[(size_t)(MP + b * DT) * 1280 + i];
  const int nsub = tile < NPG ? 8 : 1;
  for (int sub = 0; sub < nsub; ++sub) {
    __syncthreads();
    for (int i = threadIdx.x; i < 16 * 320; i += 256) { const int k = i / 320, d = i % 320; float v;
      if (tile < NPG) { const int pg = in.page_table[b * NPG + tile], rw = sub * 16 + k;
        v = d < 256 ? in.cache_lat[((size_t)pg * 128 + rw) * 256 + d] : in.cache_kr[((size_t)pg * 128 + rw) * 64 + d - 256]; }
      else v = k < DT ? kcat[(size_t)(MP + b * DT + k) * 320 + d] : 0.f;
      Ks[k][d] = v; }
    __syncthreads();
    const int key = threadIdx.x & 15, rg = threadIdx.x >> 4; float a[2] = {0.f, 0.f};
    for (int d = 0; d < 320; ++d) { const float kv = Ks[key][d];
#pragma unroll
      for (int i = 0; i < 2; ++i) a[i] += kv * Qs[rg * 2 + i][d]; }
    const int j = tile * 128 + sub * 16 + key;
    for (int i = 0; i < 2; ++i) Ss[((size_t)b * 32 + rg * 2 + i) * NKEYP + j] = a[i];
  }
}
__global__ void k_dec_softmax(float* Ss, float scale) {
  __shared__ float red[16];
  const int rowi = blockIdx.x, tq = (rowi & 31) >> 2; float* row = Ss + (size_t)rowi * NKEYP; const int nk = PAST + tq + 1;
  float m = -INFINITY; for (int s = threadIdx.x; s < nk; s += blockDim.x) m = fmaxf(m, row[s] * scale);
  for (int o = 32; o; o >>= 1) m = fmaxf(m, __shfl_xor(m, o));
  __syncthreads(); if ((threadIdx.x & 63) == 0) red[threadIdx.x >> 6] = m; __syncthreads();
  for (int i = 0; i < (int)(blockDim.x >> 6); ++i) m = fmaxf(m, red[i]);
  float sum = 0.f; for (int s = threadIdx.x; s < NKEYP; s += blockDim.x) { const float e = s < nk ? expf(row[s] * scale - m) : 0.f; row[s] = e; sum += e; }
  sum = block_sum(sum, red); const float inv = 1.f / sum;
  for (int s = threadIdx.x; s < NKEYP; s += blockDim.x) row[s] *= inv;
}
__global__ void __launch_bounds__(256) k_dec_pv(In in, const float* Ss, const float* kcat, float* olat) {
  __shared__ float Ps[32][129];
  const int b = blockIdx.y, l = blockIdx.x * 64 + (threadIdx.x & 63), rg = threadIdx.x >> 6;
  float a[8] = {};
  for (int tile = 0; tile <= NPG; ++tile) {
    __syncthreads();
    for (int i = threadIdx.x; i < 32 * 128; i += 256) { const int r = i >> 7, k = i & 127, j = tile * 128 + k; Ps[r][k] = j < NKEYP ? Ss[((size_t)b * 32 + r) * NKEYP + j] : 0.f; }
    __syncthreads();
    const int nk = tile < NPG ? 128 : DT; const int pg = tile < NPG ? in.page_table[b * NPG + tile] : 0;
    for (int k = 0; k < nk; ++k) { const float v = tile < NPG ? in.cache_lat[((size_t)pg * 128 + k) * 256 + l] : kcat[(size_t)(MP + b * DT + k) * 320 + l];
#pragma unroll
      for (int i = 0; i < 8; ++i) a[i] += Ps[rg * 8 + i][k] * v; }
  }
  for (int i = 0; i < 8; ++i) { const int r = rg * 8 + i, t = r >> 2, h = r & 3; olat[((size_t)(MP + b * DT + t) * 4 + h) * 256 + l] = a[i]; }
}
__global__ void k_obnorm(In in, const float* ob, float* mixin) {
  const int r = blockIdx.x, h = threadIdx.x >> 6, l = threadIdx.x & 63;
  const float a = ob[(size_t)r * 512 + h * 128 + l], c = ob[(size_t)r * 512 + h * 128 + 64 + l];
  float s = a * a + c * c; for (int o = 32; o; o >>= 1) s += __shfl_xor(s, o);
  const float rs = rsqrtf(s / 128.f + 1e-6f);
  mixin[(size_t)r * D + 512 + h * 128 + l] = a * rs * in.g_mla_out[l]; mixin[(size_t)r * D + 512 + h * 128 + 64 + l] = c * rs * in.g_mla_out[64 + l];
}
__global__ void __launch_bounds__(512) k_gla(In in, const float* z, const float* loga, float* mixin, float* out) {
  __shared__ float part[4][128]; __shared__ float red[16];
  const int bh = blockIdx.x; const bool samp = bh >= NB * 4; const int b = samp ? (bh - NB * 4) >> 2 : bh >> 2, h = bh & 3;
  const int v = threadIdx.x & 127, kq = threadIdx.x >> 7; const int nt = samp ? DT : T; const int r0 = samp ? MP + b * DT : b * T;
  float S[16];
  for (int i = 0; i < 16; ++i) S[i] = samp ? in.state_gla[(((size_t)b * 4 + h) * 64 + kq * 16 + i) * 128 + v] : 0.f;
  for (int t = 0; t < nt; ++t) {
    const float* zr = z + (size_t)(r0 + t) * INC; const float* la = loga + (size_t)(r0 + t) * 256 + h * 64 + kq * 16;
    const float vv = zr[O_VA + h * 128 + v]; float o = 0.f;
    for (int i = 0; i < 16; ++i) { const int k = kq * 16 + i; S[i] = expf(la[i]) * S[i] + zr[O_KA + h * 64 + k] * vv; o += zr[O_QA + h * 64 + k] * 0.125f * S[i]; }
    part[kq][v] = o; __syncthreads();
    float ot = 0.f, sq = 0.f;
    if (kq == 0) { ot = part[0][v] + part[1][v] + part[2][v] + part[3][v]; sq = ot * ot; }
    sq = block_sum(sq, red);
    if (kq == 0) { const float rs = rsqrtf(sq / 128.f + 1e-6f); mixin[(size_t)(r0 + t) * D + h * 128 + v] = ot * rs * in.g_gla_out[v] * silu_f(zr[O_RA + h * 128 + v]); }
    __syncthreads();
  }
  float* so = samp ? out + OUT_GLAS : out + OUT_GLAP;
  for (int i = 0; i < 16; ++i) so[(((size_t)b * 4 + h) * 64 + kq * 16 + i) * 128 + v] = S[i];
}
__global__ void k_resid(In in, const float* xin, const float* y, const float* g, const float* mod, int gate_off, float* dst, float* out) {
  __shared__ float red[16];
  const int r = blockIdx.x; const float* x = xin ? xin + (size_t)r * D : row_x(in, r); const float* yr = y + (size_t)r * D;
  float s = 0.f; for (int k = threadIdx.x; k < D; k += blockDim.x) s += yr[k] * yr[k];
  s = block_sum(s, red); const float rs = rsqrtf(s / D + 1e-6f);
  const float* m = mod + (size_t)row_cond(r) * 6144 + gate_off;
  float* o = dst ? dst + (size_t)r * D : (r < MP ? out + OUT_YP + (size_t)r * D : out + OUT_YS + (size_t)(r - MP) * D);
  for (int k = threadIdx.x; k < D; k += blockDim.x) o[k] = x[k] + m[k] * yr[k] * rs * g[k];
}
__device__ __forceinline__ float gelu_tanh(float x) { return 0.5f * x * (1.f + tanhf(0.7978845608028654f * (x + 0.044715f * x * x * x))); }
__global__ void k_convgelu(In in, const float* u, float* hmid, float* out) {
  const int r = blockIdx.x; const bool samp = r >= MP; const int t = samp ? (r - MP) % DT : r % T, b = samp ? (r - MP) / DT : r / T;
  for (int f = threadIdx.x; f < FF; f += blockDim.x) {
    float uc[2];
    for (int half = 0; half < 2; ++half) { const int c = f + half * FF; float a = in.b_ffn_conv[c];
      for (int j = 0; j < 3; ++j) { const int tt = t - 2 + j; float val;
        if (tt >= 0) val = u[(size_t)(r - 2 + j) * F2 + c]; else val = samp ? in.state_conv[((size_t)b * 2 + (tt + 2)) * F2 + c] : 0.f;
        a += in.w_ffn_conv[j * F2 + c] * val; }
      uc[half] = a; }
    hmid[(size_t)r * FF + f] = uc[0] * gelu_tanh(uc[1]);
  }
  const int nt = samp ? DT : T;
  if (t >= nt - 2) { float* co = samp ? out + OUT_CONVS + ((size_t)b * 2 + (t - (nt - 2))) * F2 : out + OUT_CONVP + ((size_t)b * 2 + (t - (nt - 2))) * F2;
    for (int c = threadIdx.x; c < F2; c += blockDim.x) co[c] = u[(size_t)r * F2 + c]; }
}

struct Ws { float *mod, *h, *h2, *z, *cqn, *kcat, *loga, *qb, *qcat, *S, *olat, *ob, *mixin, *mix, *x1, *u, *hmid, *y, *Ss; size_t end_floats; };
inline Ws carve(float* base) {
  Ws w; size_t o = 0; auto take = [&](size_t n) { float* p = base + o; o += (n + 63) & ~(size_t)63; return p; };
  w.mod = take(40 * 6144); w.h = take((size_t)MT * D); w.h2 = take((size_t)MT * D); w.z = take((size_t)MT * INC); w.cqn = take((size_t)MT * 384); w.kcat = take((size_t)MT * 320);
  w.loga = take((size_t)MT * 256); w.qb = take((size_t)MT * 768); w.qcat = take((size_t)MT * 1280); w.S = take((size_t)4 * T * T);
  w.olat = take((size_t)MT * 1024); w.ob = take((size_t)MT * 512); w.mixin = take((size_t)MT * D); w.mix = take((size_t)MT * D); w.x1 = take((size_t)MT * D);
  w.u = take((size_t)MT * F2); w.hmid = take((size_t)MT * FF); w.y = take((size_t)MT * D); w.Ss = take((size_t)DB * 32 * NKEYP); w.end_floats = o;
  return w;
}

inline void run(hipStream_t st, const In& in, const Ws& w, float* out) {
  const float sc = 0.07216878364870322f;
  hipLaunchKernelGGL(k_mod, dim3(24, 40), dim3(256), 0, st, in, w.mod);
  hipLaunchKernelGGL(k_norm_mod, dim3(MT), dim3(256), 0, st, in, (const float*)nullptr, in.g_pre_mix, (const float*)w.mod, 0, 1024, w.h);
  sgemm(st, w.h, in.w_in, w.z, MT, INC, D, D, INC, 1, INC);
  hipLaunchKernelGGL(k_zpost, dim3(MT), dim3(256), 0, st, in, (const float*)w.z, w.cqn, w.kcat, w.loga, out);
  sgemm(st, w.cqn, in.w_mla_uq, w.qb, MT, 768, 384, 384, 768, 1, 768);
  hipLaunchKernelGGL(k_qrope, dim3(MT), dim3(128), 0, st, (const float*)w.qb, w.qcat);
  sgemm(st, w.qb, in.w_mla_uk, w.qcat, MT, 256, 128, 768, 1, 512, 1280, 1, 4, 0, 192, 0, 128, 0, 320);
  for (int b = 0; b < NB; ++b) {
    sgemm(st, w.qcat + (size_t)b * T * 1280, w.kcat + (size_t)b * T * 320, w.S, T, T, 320, 1280, 1, 320, T, 1, 4, 0, 320, 0, 0, 0, (long)T * T);
    hipLaunchKernelGGL(k_softmax_causal, dim3(T, 4), dim3(256), 0, st, w.S, sc);
    sgemm(st, w.S, w.kcat + (size_t)b * T * 320, w.olat + (size_t)b * T * 1024, T, 256, T, T, 320, 1, 1024, 1, 4, 0, (long)T * T, 0, 0, 0, 256);
  }
  hipLaunchKernelGGL(k_dec_scores, dim3(NPG + 1, DB), dim3(256), 0, st, in, (const float*)w.qcat, (const float*)w.kcat, w.Ss);
  hipLaunchKernelGGL(k_dec_softmax, dim3(DB * 32), dim3(256), 0, st, w.Ss, sc);
  hipLaunchKernelGGL(k_dec_pv, dim3(4, DB), dim3(256), 0, st, in, (const float*)w.Ss, (const float*)w.kcat, w.olat);
  sgemm(st, w.olat, in.w_mla_uv, w.ob, MT, 128, 256, 1024, 512, 1, 512, 1, 4, 0, 256, 0, 128, 0, 128);
  hipLaunchKernelGGL(k_obnorm, dim3(MT), dim3(256), 0, st, in, (const float*)w.ob, w.mixin);
  hipLaunchKernelGGL(k_gla, dim3(NB * 4 + DB * 4), dim3(512), 0, st, in, (const float*)w.z, (const float*)w.loga, w.mixin, out);
  sgemm(st, w.mixin, in.w_o, w.mix, MT, D, D, D, D, 1, D);
  hipLaunchKernelGGL(k_resid, dim3(MT), dim3(256), 0, st, in, (const float*)nullptr, (const float*)w.mix, in.g_post_mix, (const float*)w.mod, 2048, w.x1, out);
  hipLaunchKernelGGL(k_norm_mod, dim3(MT), dim3(256), 0, st, in, (const float*)w.x1, in.g_pre_ffn, (const float*)w.mod, 3072, 4096, w.h2);
  sgemm(st, w.h2, in.w_ffn_up, w.u, MT, F2, D, D, F2, 1, F2);
  hipLaunchKernelGGL(k_convgelu, dim3(MT), dim3(256), 0, st, in, (const float*)w.u, w.hmid, out);
  sgemm(st, w.hmid, in.w_ffn_down, w.y, MT, D, FF, FF, D, 1, D);
  hipLaunchKernelGGL(k_resid, dim3(MT), dim3(256), 0, st, in, (const float*)w.x1, (const float*)w.y, in.g_post_ffn, (const float*)w.mod, 5120, (float*)nullptr, out);
}
}
namespace pg8 {
#define PG8_LAS __attribute__((address_space(3)))
typedef unsigned short bf16_t;
typedef short bf16x8 __attribute__((ext_vector_type(8)));
typedef float f32x4 __attribute__((ext_vector_type(4)));
typedef unsigned u32x4 __attribute__((ext_vector_type(4)));
constexpr int BM = 256, BK = 64, HALF = 128, HTB = HALF * BK * 2  , STAGE_BYTES = 8 * HTB, NXCD = 8, WGM = 8;

__host__ __device__ __forceinline__ int lds_byte(int r, int c) { const int st = (r >> 4) * 2 + (c >> 5), rr = r & 15, cc = c & 31, ob = rr * 64 + cc * 2; return st * 1024 + (ob ^ (((ob >> 9) & 1) << 5)); }
__host__ __device__ __forceinline__ void stage_rc(int b, int& R, int& C) { const int st = b / 1024, sb = b % 1024, swz = sb ^ (((sb >> 9) & 1) << 5); R = (st >> 1) * 16 + swz / 64; C = (st & 1) * 32 + (swz % 64) / 2; }
__host__ __device__ __forceinline__ int perm32(int rho) { const int n = rho >> 4, i = rho & 15; return 8 * (i >> 2) + 4 * n + (i & 3); }

struct Unit { int pm, pn, kk; };
struct Gemm { const bf16_t* A; const bf16_t* Bt; int lda, ldb, K; };
__device__ __forceinline__ unsigned cvt_pk_bf16(float lo, float hi) { unsigned r; asm volatile("v_cvt_pk_bf16_f32 %0, %1, %2" : "=v"(r) : "v"(lo), "v"(hi)); return r; }
typedef float f32x2 __attribute__((ext_vector_type(2)));
template <class Epi, class Sched, bool ALIGN_EPI = false, bool SP2 = false>
__device__ __forceinline__ void gemm_phase(PG8_LAS unsigned char* lds, const Gemm g, const Sched& S, const Epi& E) {
    const int tid = threadIdx.x, wid = __builtin_amdgcn_readfirstlane(tid >> 6), lane = tid & 63, wr = wid >> 2, wc = wid & 3, fr = lane & 15, fq = lane >> 4;
    int K = g.K; asm volatile("" : "+s"(K)); const int nt = K / BK;
    unsigned voffA[2], voffB[2];
#pragma unroll
    for (int i = 0; i < 2; ++i) { int R, C; stage_rc(tid * 16 + i * 8192, R, C); const int Rb = Epi::PERM ? ((R & ~31) + perm32(R & 31)) : R;
        voffA[i] = (unsigned)(R * g.lda + C) * 2u; voffB[i] = (unsigned)(Rb * g.ldb + C) * 2u; }
    const size_t kstep = (size_t)(BK * 2);
    const size_t hstepA = (size_t)HALF * g.lda * 2, hstepB = (size_t)HALF * g.ldb * 2;
    const size_t tstepA = 2 * hstepA, tstepB = 2 * hstepB;
    const unsigned ldsw = (unsigned)wid * 1024u;
    const int aoff = lds_byte(wr * 64 + fr, fq * 8), boff = lds_byte(wc * 32 + fr, fq * 8);
#define PG8_SA(b, h) (((b) * 2 + (h)) * HTB)
#define PG8_SB(b, h) ((4 + (b) * 2 + (h)) * HTB)
#define PG8_STAGE(bufoff, gbase, voff) do { _Pragma("unroll") for (int _i = 0; _i < 2; ++_i) \
        __builtin_amdgcn_global_load_lds((const unsigned*)((const char*)(gbase) + (voff)[_i]), (PG8_LAS unsigned*)(lds + (bufoff) + ldsw + _i * 8192), 16, 0, 0); } while (0)
#define PG8_LDA(dst, b, h) do { _Pragma("unroll") for (int m = 0; m < 4; ++m) _Pragma("unroll") for (int k = 0; k < 2; ++k) dst[m][k] = *(const PG8_LAS bf16x8*)(lds + PG8_SA(b, h) + aoff + m * 2048 + k * 1024); } while (0)
#define PG8_LDB(dst, b, h) do { _Pragma("unroll") for (int n = 0; n < 2; ++n) _Pragma("unroll") for (int k = 0; k < 2; ++k) dst[n][k] = *(const PG8_LAS bf16x8*)(lds + PG8_SB(b, h) + boff + n * 2048 + k * 1024); } while (0)
#define PG8_MMA(ai, bj, At, Bt) do { __builtin_amdgcn_s_setprio(1); _Pragma("unroll") for (int m = 0; m < 4; ++m) _Pragma("unroll") for (int n = 0; n < 2; ++n) _Pragma("unroll") for (int k = 0; k < 2; ++k) \
        acc[ai][bj][m][n] = __builtin_amdgcn_mfma_f32_16x16x32_bf16(Bt[n][k], At[m][k], acc[ai][bj][m][n], 0, 0, 0); __builtin_amdgcn_s_setprio(0); } while (0)
#define PG8_WAIT_V(n) asm volatile("s_waitcnt vmcnt(" #n ")" ::: "memory")
#define PG8_WAIT_L(n) asm volatile("s_waitcnt lgkmcnt(" #n ")" ::: "memory")
#define PG8_BAR __builtin_amdgcn_s_barrier()
#define PG8_SCHED __builtin_amdgcn_sched_barrier(0)
    Unit cur, nxt; int ui = 0;
    if (!S.next(0, cur)) return;
    f32x4 acc[2][2][4][2];
#pragma unroll
    for (int a = 0; a < 2; ++a)
#pragma unroll
        for (int b = 0; b < 2; ++b)
#pragma unroll
            for (int m = 0; m < 4; ++m)
#pragma unroll
                for (int n = 0; n < 2; ++n) acc[a][b][m][n] = (f32x4){0.f, 0.f, 0.f, 0.f};
    bf16x8 At[4][2], B0[2][2], B1[2][2];
    const char* cA = (const char*)g.A + (size_t)cur.pm * tstepA + (size_t)cur.kk * K * 2; const char* cB = (const char*)g.Bt + (size_t)cur.pn * tstepB + (size_t)cur.kk * K * 2;
    S.a_ready(cur);
    if constexpr (SP2) {
        PG8_STAGE(PG8_SB(0, 0), cB, voffB); PG8_STAGE(PG8_SB(0, 1), cB + hstepB, voffB); PG8_STAGE(PG8_SA(0, 0), cA, voffA); PG8_STAGE(PG8_SA(0, 1), cA + hstepA, voffA);
        if (wr == 1) PG8_BAR;
        PG8_WAIT_V(2); PG8_BAR;
        PG8_STAGE(PG8_SB(1, 0), cB + kstep, voffB); PG8_STAGE(PG8_SA(1, 0), cA + kstep, voffA); PG8_STAGE(PG8_SB(1, 1), cB + hstepB + kstep, voffB);
        PG8_WAIT_V(6); PG8_BAR;
    } else {
        PG8_STAGE(PG8_SB(0, 0), cB, voffB); PG8_STAGE(PG8_SA(0, 0), cA, voffA); PG8_STAGE(PG8_SB(0, 1), cB + hstepB, voffB); PG8_STAGE(PG8_SA(0, 1), cA + hstepA, voffA);
        if (wr == 1) PG8_BAR;
        PG8_WAIT_V(4); PG8_BAR;
        PG8_STAGE(PG8_SB(1, 0), cB + kstep, voffB); PG8_STAGE(PG8_SA(1, 0), cA + kstep, voffA); PG8_STAGE(PG8_SB(1, 1), cB + hstepB + kstep, voffB);
        PG8_WAIT_V(6); PG8_BAR;
    }
    for (;;) {
        const bool has_next = S.next(ui + 1, nxt);
        const char* nA = has_next ? (const char*)g.A + (size_t)nxt.pm * tstepA + (size_t)nxt.kk * K * 2 : cA; const char* nB = has_next ? (const char*)g.Bt + (size_t)nxt.pn * tstepB + (size_t)nxt.kk * K * 2 : cB;
        for (int t = 0; t < nt; t += 2) {
            const bool last = (t == nt - 2);
            const char* a1 = cA + (size_t)(t + 1) * kstep;
            const char* a2 = last ? nA : cA + (size_t)(t + 2) * kstep; const char* b2 = last ? nB : cB + (size_t)(t + 2) * kstep;
            const char* a3 = a2 + kstep; const char* b3 = b2 + kstep;
            if (last && has_next) S.a_ready(nxt);
            if constexpr (SP2) {
            PG8_LDB(B0, 0, 0); PG8_LDB(B1, 0, 1); PG8_SCHED; PG8_LDA(At, 0, 0); PG8_STAGE(PG8_SA(1, 1), a1 + hstepA, voffA);
            PG8_WAIT_V(8); PG8_WAIT_L(0); PG8_BAR; PG8_MMA(0, 0, At, B0); PG8_MMA(0, 1, At, B1); PG8_BAR; PG8_SCHED;
            PG8_LDA(At, 0, 1); PG8_STAGE(PG8_SB(0, 0), b2, voffB); PG8_STAGE(PG8_SB(0, 1), b2 + hstepB, voffB); PG8_STAGE(PG8_SA(0, 0), a2, voffA);
            PG8_WAIT_V(8); PG8_WAIT_L(0); PG8_BAR; PG8_MMA(1, 0, At, B0); PG8_MMA(1, 1, At, B1); PG8_BAR; PG8_SCHED;
            PG8_LDB(B0, 1, 0); PG8_LDB(B1, 1, 1); PG8_SCHED; PG8_LDA(At, 1, 0); PG8_STAGE(PG8_SA(0, 1), a2 + hstepA, voffA);
            PG8_WAIT_V(8); PG8_WAIT_L(0); PG8_BAR; PG8_MMA(0, 0, At, B0); PG8_MMA(0, 1, At, B1); PG8_BAR; PG8_SCHED;
            PG8_LDA(At, 1, 1); PG8_STAGE(PG8_SB(1, 0), b3, voffB); PG8_STAGE(PG8_SB(1, 1), b3 + hstepB, voffB); PG8_STAGE(PG8_SA(1, 0), a3, voffA);
            PG8_WAIT_V(8); PG8_WAIT_L(0); PG8_BAR; PG8_MMA(1, 0, At, B0); PG8_MMA(1, 1, At, B1); PG8_BAR; PG8_SCHED;
            } else {
            PG8_LDB(B0, 0, 0); PG8_SCHED; PG8_LDA(At, 0, 0); PG8_STAGE(PG8_SA(1, 1), a1 + hstepA, voffA);
            PG8_WAIT_L(8); PG8_BAR; PG8_WAIT_L(0); PG8_MMA(0, 0, At, B0); PG8_BAR; PG8_SCHED;
            PG8_LDB(B1, 0, 1); PG8_STAGE(PG8_SB(0, 0), b2, voffB);
            PG8_BAR; PG8_WAIT_L(0); PG8_MMA(0, 1, At, B1); PG8_BAR;
            PG8_LDA(At, 0, 1); PG8_STAGE(PG8_SA(0, 0), a2, voffA);
            PG8_BAR; PG8_WAIT_L(0); PG8_MMA(1, 0, At, B0); PG8_BAR; PG8_SCHED;
            PG8_STAGE(PG8_SB(0, 1), b2 + hstepB, voffB);
            PG8_WAIT_V(6); PG8_BAR; PG8_MMA(1, 1, At, B1); PG8_BAR;
            PG8_LDB(B0, 1, 0); PG8_SCHED; PG8_LDA(At, 1, 0); PG8_STAGE(PG8_SA(0, 1), a2 + hstepA, voffA);
            PG8_WAIT_L(8); PG8_BAR; PG8_WAIT_L(0); PG8_MMA(0, 0, At, B0); PG8_BAR; PG8_SCHED;
            PG8_LDB(B1, 1, 1); PG8_STAGE(PG8_SB(1, 0), b3, voffB);
            PG8_BAR; PG8_WAIT_L(0); PG8_MMA(0, 1, At, B1); PG8_BAR;
            PG8_LDA(At, 1, 1); PG8_STAGE(PG8_SA(1, 0), a3, voffA);
            PG8_BAR; PG8_WAIT_L(0); PG8_MMA(1, 0, At, B0); PG8_BAR; PG8_SCHED;
            PG8_STAGE(PG8_SB(1, 1), b3 + hstepB, voffB);
            PG8_WAIT_V(6); PG8_BAR; PG8_MMA(1, 1, At, B1); PG8_BAR;
            }
        }
        if constexpr (ALIGN_EPI) { if (wr == 0) PG8_BAR; }
        if constexpr (!Epi::AFTER_DRAIN) { E(acc, cur, wr, wc, fr, fq); S.done(cur); }
        if (!has_next) break;
#pragma unroll
        for (int a = 0; a < 2; ++a)
#pragma unroll
            for (int b = 0; b < 2; ++b)
#pragma unroll
                for (int m = 0; m < 4; ++m)
#pragma unroll
                    for (int n = 0; n < 2; ++n) acc[a][b][m][n] = (f32x4){0.f, 0.f, 0.f, 0.f};
        cur = nxt; cA = nA; cB = nB; ++ui;
        if constexpr (ALIGN_EPI) { if (wr == 1) PG8_BAR; }
    }
    PG8_WAIT_V(0);
    if constexpr (!ALIGN_EPI) { if (wr == 0) PG8_BAR; }
    PG8_BAR;
    if constexpr (Epi::AFTER_DRAIN) { E.fused(acc, cur, wr, wc, fr, fq, lds, wid, lane); S.done(cur); }
#undef PG8_SA
#undef PG8_SB
#undef PG8_STAGE
#undef PG8_LDA
#undef PG8_LDB
#undef PG8_MMA
#undef PG8_WAIT_V
#undef PG8_WAIT_L
#undef PG8_BAR
#undef PG8_SCHED
}
}
namespace fz {
using nv::In;
using nv::D; using nv::NB; using nv::T; using nv::DB; using nv::DT; using nv::MP; using nv::MS; using nv::MT; using nv::FF; using nv::F2; using nv::PAST; using nv::NPG;
#define GAS __attribute__((address_space(1)))
#define LAS __attribute__((address_space(3)))
typedef unsigned short bf16;
typedef unsigned v4u __attribute__((ext_vector_type(4)));
typedef unsigned v2u __attribute__((ext_vector_type(2)));
typedef float f32x4 __attribute__((ext_vector_type(4)));
typedef float f32x2 __attribute__((ext_vector_type(2)));
typedef float f32x16 __attribute__((ext_vector_type(16)));
typedef short bf16x8 __attribute__((ext_vector_type(8)));
typedef short s16x4 __attribute__((ext_vector_type(4)));
typedef GAS unsigned gu32;
#define RLX_AGENT __ATOMIC_RELAXED, __HIP_MEMORY_SCOPE_AGENT
#define LDS_WAIT() asm volatile("s_waitcnt lgkmcnt(0)" ::: "memory")

constexpr int NWAVES = 8, NTHR = 512;
constexpr int ZW = 2304;
constexpr int ZC_QA = 0, ZC_KA = 256, ZC_VA = 512, ZC_RA = 1024, ZC_CKV = 1536, ZC_CQ = 1792, ZC_KR = 2176, ZC_GR = 2240;
constexpr int QW = 1792;
constexpr int NSPLIT = 6;
constexpr float C2 = 0.07216878364870322f * 1.4426950408889634f;

constexpr size_t al256(size_t x) { return (x + 255) & ~(size_t)255; }
constexpr size_t W_CTL = 0, CTL_BYTES = 1u << 20;
constexpr size_t W_MOD = W_CTL + CTL_BYTES;
constexpr size_t W_ROPE = W_MOD + al256((size_t)40 * 6144 * 4);
constexpr size_t W_WIN = W_ROPE + al256((size_t)2056 * 32 * 8);
constexpr size_t W_WQ = W_WIN + al256((size_t)ZW * 1024 * 2);
constexpr size_t W_WKV = W_WQ + al256((size_t)QW * 384 * 2);
constexpr size_t W_WO = W_WKV + al256((size_t)1024 * 256 * 2);
constexpr size_t W_WUP = W_WO + al256((size_t)1024 * 1024 * 2);
constexpr size_t W_WDN = W_WUP + al256((size_t)F2 * 1024 * 2);
constexpr size_t W_XN = W_WDN + al256((size_t)1024 * FF * 2);
constexpr size_t W_Z = W_XN + al256((size_t)MT * 1024 * 2);
constexpr size_t W_CQN = W_Z + al256((size_t)MT * ZW * 2);
constexpr size_t W_LATB = W_CQN + al256((size_t)MT * 384 * 2);
constexpr size_t W_KRB = W_LATB + al256((size_t)MT * 256 * 2);
constexpr size_t W_QD = W_KRB + al256((size_t)MT * 64 * 2);
constexpr size_t W_KD = W_QD + al256((size_t)MP * 256 * 2);
constexpr size_t W_KLT = W_KD + al256((size_t)MP * 256 * 2);
constexpr size_t W_VT = W_KLT + al256((size_t)MP * 256 * 2);
constexpr size_t W_DCH = W_VT + al256((size_t)MP * 512 * 2);
constexpr size_t W_UT = W_DCH + al256((size_t)NB * 32 * 256 * 4);
constexpr size_t W_ST = W_UT + al256((size_t)NB * 4 * 32 * 8192 * 4);
constexpr size_t W_QBUF = W_ST + al256((size_t)NB * 4 * 32 * 8192 * 2);
constexpr size_t W_KCOMB = W_QBUF + al256((size_t)MT * QW * 2);
constexpr size_t W_VB = W_KCOMB + al256((size_t)NB * 4 * T * 200 * 2);
constexpr size_t W_DPO = W_VB + al256((size_t)MP * 512 * 2);
constexpr size_t W_DPML = W_DPO + al256((size_t)DB * NSPLIT * 32 * 256 * 4);
constexpr size_t W_MIXIN = W_DPML + al256((size_t)DB * NSPLIT * 2 * 32 * 4);
constexpr size_t W_MIX = W_MIXIN + al256((size_t)MT * 1024 * 2);
constexpr size_t W_X1 = W_MIX + al256((size_t)MT * 1024 * 4);
constexpr size_t W_U = W_X1 + al256((size_t)MT * 1024 * 4);
constexpr size_t W_HMID = W_U + al256((size_t)MT * F2 * 2);
constexpr size_t W_END = W_HMID + al256((size_t)MT * FF * 2);

constexpr int CW_BAR = 4096;

constexpr int RING_BYTES = 131072, LDSCTL_OFF = RING_BYTES, MISC_OFF = LDSCTL_OFF + 320, LDS_BYTES = 147456;

__device__ __forceinline__ unsigned f2bf(float f) { unsigned u = __builtin_bit_cast(unsigned, f); return (u + 0x7fffu + ((u >> 16) & 1u)) >> 16; }
__device__ __forceinline__ unsigned pk2(float lo, float hi) { return f2bf(lo) | (f2bf(hi) << 16); }
__device__ __forceinline__ float bf2f(unsigned b) { return __builtin_bit_cast(float, b << 16); }
__device__ __forceinline__ float bflo(unsigned w) { return __builtin_bit_cast(float, w << 16); }
__device__ __forceinline__ float bfhi(unsigned w) { return __builtin_bit_cast(float, w & 0xffff0000u); }
__device__ __forceinline__ float wave_sum(float v) {
#pragma unroll
  for (int o = 1; o < 64; o <<= 1) v += __shfl_xor(v, o);
  return v;
}
__device__ __forceinline__ float silu_f(float v) { return v / (1.f + __expf(-v)); }

#define XB_TMO      128
#define XB_XCNT(j)  (256  + 64 * (j))
#define XB_XSUB(j)  (1280 + 64 * (j))
#define XB_XGEN(j)  (2304 + 64 * (j))
#define XB_TOP      3328
#define XB_TOPGEN   3392
#define XCD_BAR_WORDS 3456
#define XB_SPIN_CAP (1u << 22)
__device__ __forceinline__ unsigned xb_ld(unsigned* p)              { return __hip_atomic_load(p, __ATOMIC_RELAXED, __HIP_MEMORY_SCOPE_AGENT); }
__device__ __forceinline__ unsigned xb_add(unsigned* p, unsigned v) { return __hip_atomic_fetch_add(p, v, __ATOMIC_RELAXED, __HIP_MEMORY_SCOPE_AGENT); }
__device__ __forceinline__ unsigned xb_xcc_id() { return (unsigned)__builtin_amdgcn_s_getreg((3 << 11) | 20) & 0xFu; }
#define XB_SPIN(cond, bar) do { unsigned _sp = 0; while (cond) { __builtin_amdgcn_s_sleep(1); \
    if ((++_sp & 255u) == 0u) { if (xb_ld(&(bar)[XB_TMO])) break; if (_sp > XB_SPIN_CAP) { atomicAdd(&(bar)[XB_TMO], 1u); break; } } } } while (0)
struct XcdBarrier { unsigned* bar; unsigned x; volatile LAS unsigned* st; };
__device__ __forceinline__ XcdBarrier xcd_barrier_post(unsigned* bar, volatile LAS unsigned* st) {
    XcdBarrier b; b.bar = bar; b.x = xb_xcc_id(); b.st = st;
    if (threadIdx.x == 0) (void)xb_add(&bar[XB_XCNT(b.x)], 1u);
    return b;
}
__device__ __forceinline__ void xcd_barrier_complete(unsigned* bar, unsigned x, unsigned& nloc, unsigned& nx) {
    const unsigned G = gridDim.x * gridDim.y * gridDim.z;
    unsigned sum, cnt, mine, sp = 0u;
    for (;;) {
        sum = 0u; cnt = 0u; mine = 0u;
#pragma unroll
        for (unsigned j = 0; j < 16; ++j) { const unsigned c = xb_ld(&bar[XB_XCNT(j)]); sum += c; cnt += (c > 0u) ? 1u : 0u; mine = (j == x) ? c : mine; }
        if (sum == G) break;
        __builtin_amdgcn_s_sleep(1);
        if ((++sp & 255u) == 0u) { if (xb_ld(&bar[XB_TMO])) break; if (sp > XB_SPIN_CAP) { atomicAdd(&bar[XB_TMO], 1u); break; } }
    }
    nloc = mine > 0u ? mine : 1u; nx = cnt > 0u ? cnt : 1u;
}
__device__ __forceinline__ void xcd_barrier(const XcdBarrier& b) {
    asm volatile("s_waitcnt vmcnt(0)" ::: "memory");
    __syncthreads();
    if (threadIdx.x == 0) {
        unsigned* bar = b.bar;
        __builtin_amdgcn_s_waitcnt(0);
        unsigned nloc = b.st[0], nx = b.st[1];
        if (nloc == 0u) { xcd_barrier_complete(bar, b.x, nloc, nx); b.st[0] = nloc; b.st[1] = nx; }
        const unsigned old = xb_add(&bar[XB_XSUB(b.x)], 1u);
        const unsigned gen = old / nloc;
        if (old + 1u == (gen + 1u) * nloc) {
            __builtin_amdgcn_fence(__ATOMIC_RELEASE, "agent");
            asm volatile("s_waitcnt vmcnt(0)" ::: "memory");
            const unsigned og = xb_add(&bar[XB_TOP], 1u);
            const unsigned tg = og / nx;
            if (og + 1u == (tg + 1u) * nx) xb_add(&bar[XB_TOPGEN], 1u);
            else XB_SPIN(xb_ld(&bar[XB_TOPGEN]) == tg, bar);
            __builtin_amdgcn_fence(__ATOMIC_ACQUIRE, "agent");
            xb_add(&bar[XB_XGEN(b.x)], 1u);
            asm volatile("s_waitcnt vmcnt(0)" ::: "memory");
        } else {
            XB_SPIN(xb_ld(&bar[XB_XGEN(b.x)]) == gen, bar);
            __builtin_amdgcn_fence(__ATOMIC_ACQUIRE, "agent");
            asm volatile("s_waitcnt vmcnt(0)" ::: "memory");
        }
    }
    __syncthreads();
}

struct Params { In in; float* out; unsigned char* ws; int ph_lo, ph_hi; };
struct Frame {
  LAS unsigned char* lds;
  int tid, lane, wave, G, bid;
  const Params* P;
#define FZ_ACC(T_, name, off) __device__ __forceinline__ T_* name() const { return (T_*)(P->ws + (off)); }
  FZ_ACC(float, mod, W_MOD) FZ_ACC(f32x2, rope, W_ROPE) FZ_ACC(bf16, win_t, W_WIN) FZ_ACC(bf16, wq_t, W_WQ) FZ_ACC(bf16, wkv_t, W_WKV) FZ_ACC(bf16, wo_t, W_WO)
  FZ_ACC(bf16, wup_t, W_WUP) FZ_ACC(bf16, wdn_t, W_WDN) FZ_ACC(bf16, xn, W_XN) FZ_ACC(bf16, z, W_Z) FZ_ACC(bf16, cqn, W_CQN) FZ_ACC(bf16, latb, W_LATB) FZ_ACC(bf16, krb, W_KRB)
  FZ_ACC(bf16, qd, W_QD) FZ_ACC(bf16, kd, W_KD) FZ_ACC(bf16, klt, W_KLT) FZ_ACC(bf16, vt, W_VT) FZ_ACC(float, dch, W_DCH) FZ_ACC(float, ut, W_UT) FZ_ACC(bf16, st, W_ST)
  FZ_ACC(bf16, qbuf, W_QBUF) FZ_ACC(bf16, kcomb, W_KCOMB) FZ_ACC(bf16, vb, W_VB) FZ_ACC(float, dpo, W_DPO) FZ_ACC(float, dpml, W_DPML) FZ_ACC(bf16, mixin, W_MIXIN)
  FZ_ACC(float, mix, W_MIX) FZ_ACC(float, x1, W_X1) FZ_ACC(bf16, u, W_U) FZ_ACC(bf16, hmid, W_HMID)
#undef FZ_ACC
};
__device__ __forceinline__ int cond_row(int r) { return r < MP ? (r >> 11) : NB + ((r - MP) >> 3); }
__device__ __forceinline__ int pos_idx(int r) { return r < MP ? (r & 2047) : 2048 + ((r - MP) & 7); }
__device__ __forceinline__ const float* x_row(const In& in, int r) { return r < MP ? in.x_p + (size_t)r * D : in.x_s + (size_t)(r - MP) * D; }
__device__ __forceinline__ float* y_row(float* out, int r) { return r < MP ? out + nv::OUT_YP + (size_t)r * D : out + nv::OUT_YS + (size_t)(r - MP) * D; }

__device__ __forceinline__ void p0_mod_unit(const Frame& F, int u) {
  LAS float* sc = (LAS float*)F.lds; LAS float* red = sc + 20 * 1024;
  const int tid = F.tid, cc = u >> 1, rh = u & 1, n0 = cc * 32;
  __syncthreads();
  for (int i = tid; i < 20 * 1024; i += NTHR) { const int cr = rh * 20 + (i >> 10), k = i & 1023;
    const float v = cr < NB ? F.P->in.c_p[cr * D + k] : F.P->in.c_s[(cr - NB) * D + k]; sc[i] = v / (1.f + expf(-v)); }
  __syncthreads();
  const int kg = tid >> 5, c = tid & 31;
  float acc[20];
#pragma unroll
  for (int r = 0; r < 20; ++r) acc[r] = 0.f;
  for (int k = kg; k < 1024; k += 16) { const float w = F.P->in.w_ada[(size_t)k * 6144 + n0 + c];
#pragma unroll
    for (int r = 0; r < 20; ++r) acc[r] += sc[r * 1024 + k] * w; }
#pragma unroll
  for (int r = 0; r < 20; ++r) red[(kg * 20 + r) * 32 + c] = acc[r];
  __syncthreads();
  for (int i = tid; i < 640; i += NTHR) { const int r = i >> 5, c2 = i & 31; float s = F.P->in.b_ada[n0 + c2];
    for (int g = 0; g < 16; ++g) s += red[(g * 20 + r) * 32 + c2];
    F.mod()[(size_t)(rh * 20 + r) * 6144 + n0 + c2] = s; }
}
template <class Map>
__device__ __forceinline__ void transpose_item(const float* W, int Nsrc, bf16* WT, int ldt, const Map map, LAS float* scr, int item, int nblk, int lane) {
  const int kb = item / nblk, nb = item % nblk, k0 = 64 * kb, n0 = 32 * nb;
  const int ncol = n0 + (lane & 31);
#pragma unroll 8
  for (int i = 0; i < 32; ++i) { const int kk = 2 * i + (lane >> 5); scr[kk * 33 + (lane & 31)] = ncol < Nsrc ? W[(size_t)(k0 + kk) * Nsrc + ncol] : 0.f; }
  LDS_WAIT();
  const int c = lane & 7;
#pragma unroll
  for (int j = 0; j < 4; ++j) { const int n = (lane >> 3) + 8 * j; const LAS float* s = scr + (8 * c) * 33 + n;
    v4u o; o.x = pk2(s[0 * 33], s[1 * 33]); o.y = pk2(s[2 * 33], s[3 * 33]); o.z = pk2(s[4 * 33], s[5 * 33]); o.w = pk2(s[6 * 33], s[7 * 33]);
    const int row = map(n0 + n);
    *(GAS v4u*)(WT + (size_t)row * ldt + k0 + 8 * c) = o; }
  LDS_WAIT();
}
struct MapId { int off; __device__ __forceinline__ int operator()(int n) const { return n + off; } };
struct MapWin { __device__ __forceinline__ int operator()(int n) const {
  if (n < 1536) return n; if (n < 1552) return ZC_GR + (n - 1536); if (n < 1936) return ZC_CQ + (n - 1552); if (n < 2192) return ZC_CKV + (n - 1936); if (n < 2256) return ZC_KR + (n - 2192); return n; } };

__device__ __forceinline__ void p0_prologue(const Frame& F) {
  for (int u = F.bid; u < 384; u += F.G) p0_mod_unit(F, u);
  __syncthreads();
  LAS float* scr = (LAS float*)(F.lds + F.wave * 16384);
  const int gw = F.bid * NWAVES + F.wave, NGW = F.G * NWAVES;
  constexpr int I_IN = 16 * 72, I_UQ = 6 * 24, I_UK = 4 * 16, I_UV = 4 * 16, I_O = 16 * 32, I_UP = 16 * 176, I_DN = 44 * 32;
  constexpr int NITEMS = I_IN + I_UQ + I_UK + I_UV + I_O + I_UP + I_DN;
  for (int it = gw; it < NITEMS; it += NGW) {
    int r = it;
    if (r < I_IN) { transpose_item(F.P->in.w_in, 2256, F.win_t(), 1024, MapWin{}, scr, r, 72, F.lane); continue; } r -= I_IN;
    if (r < I_UQ) { transpose_item(F.P->in.w_mla_uq, 768, F.wq_t(), 384, MapId{0}, scr, r, 24, F.lane); continue; } r -= I_UQ;
    if (r < I_UK) { transpose_item(F.P->in.w_mla_uk, 512, F.wkv_t(), 256, MapId{0}, scr, r, 16, F.lane); continue; } r -= I_UK;
    if (r < I_UV) { transpose_item(F.P->in.w_mla_uv, 512, F.wkv_t(), 256, MapId{512}, scr, r, 16, F.lane); continue; } r -= I_UV;
    if (r < I_O) { transpose_item(F.P->in.w_o, 1024, F.wo_t(), 1024, MapId{0}, scr, r, 32, F.lane); continue; } r -= I_O;
    if (r < I_UP) { transpose_item(F.P->in.w_ffn_up, F2, F.wup_t(), 1024, MapId{0}, scr, r, 176, F.lane); continue; } r -= I_UP;
    transpose_item(F.P->in.w_ffn_down, 1024, F.wdn_t(), FF, MapId{0}, scr, r, 32, F.lane);
  }
  const int gt = F.bid * NTHR + F.tid, NGT = F.G * NTHR;
  for (int i = gt; i < 2056 * 32; i += NGT) { const int p = i >> 5, j = i & 31; const int pos = p < 2048 ? p : PAST + (p - 2048);
    const float inv = powf(10000.0f, -(float)(2 * j) / 64.0f); const float ang = (float)pos * inv; F.rope()[i] = (f32x2){cosf(ang), sinf(ang)}; }
  for (int i = gt; i < 1024 * 384; i += NGT) { const int c = i % 384, hl = i / 384, h = hl >> 8, l = hl & 255;
    const f32x4* a = (const f32x4*)(F.P->in.w_mla_uq + (size_t)c * 768 + h * 192); const f32x4* b = (const f32x4*)(F.P->in.w_mla_uk + (size_t)l * 512 + h * 128);
    float s = 0.f;
#pragma unroll 8
    for (int n = 0; n < 32; ++n) { const f32x4 x = a[n], y = b[n]; s += x.x * y.x + x.y * y.y + x.z * y.z + x.w * y.w; }
    F.wq_t()[(size_t)(768 + hl) * 384 + c] = (bf16)f2bf(s); }
}

__device__ __forceinline__ void norm_mod_row(const float* xrow, const float* g, const float* modrow, int sh_off, int sc_off, bf16* orow, int lane) {
  const f32x4* xr = (const f32x4*)xrow + lane;
  f32x4 v[4]; float s = 0.f;
#pragma unroll
  for (int j = 0; j < 4; ++j) { v[j] = xr[64 * j]; s += (v[j].x * v[j].x + v[j].y * v[j].y) + (v[j].z * v[j].z + v[j].w * v[j].w); }
  const float rs = rsqrtf(wave_sum(s) * (1.f / D) + 1e-6f);
#pragma unroll
  for (int j = 0; j < 4; ++j) { const int col = 4 * (lane + 64 * j);
    const f32x4 gv = *(const f32x4*)(g + col), scv = *(const f32x4*)(modrow + sc_off + col), shv = *(const f32x4*)(modrow + sh_off + col);
    const f32x4 o = v[j] * rs * gv * (1.f + scv) + shv;
    v2u w; w.x = pk2(o.x, o.y); w.y = pk2(o.z, o.w); *(v2u*)(orow + col) = w; }
}
__device__ __forceinline__ void p1_xn(const Frame& F) {
  const int gw = F.bid * NWAVES + F.wave, NGW = F.G * NWAVES;
  for (int r = gw; r < MT; r += NGW) norm_mod_row(x_row(F.P->in, r), F.P->in.g_pre_mix, F.mod() + (size_t)cond_row(r) * 6144, 0, 1024, F.xn() + (size_t)r * D, F.lane);
}
__device__ __forceinline__ void p8_row(const Frame& F, int r) {
  const int lane = F.lane; const float* modrow = F.mod() + (size_t)cond_row(r) * 6144;
  const f32x4* mr = (const f32x4*)(F.mix() + (size_t)r * D) + lane; const f32x4* xr = (const f32x4*)x_row(F.P->in, r) + lane;
  f32x4 v[4]; float s = 0.f;
#pragma unroll
  for (int j = 0; j < 4; ++j) { v[j] = mr[64 * j]; s += (v[j].x * v[j].x + v[j].y * v[j].y) + (v[j].z * v[j].z + v[j].w * v[j].w); }
  const float rs = rsqrtf(wave_sum(s) * (1.f / D) + 1e-6f);
  float s2 = 0.f;
#pragma unroll
  for (int j = 0; j < 4; ++j) { const int col = 4 * (lane + 64 * j);
    const f32x4 gv = *(const f32x4*)(F.P->in.g_post_mix + col), gt = *(const f32x4*)(modrow + 2048 + col);
    v[j] = xr[64 * j] + gt * (v[j] * rs * gv);
    *(f32x4*)(F.x1() + (size_t)r * D + col) = v[j];
    s2 += (v[j].x * v[j].x + v[j].y * v[j].y) + (v[j].z * v[j].z + v[j].w * v[j].w); }
  const float rs2 = rsqrtf(wave_sum(s2) * (1.f / D) + 1e-6f);
#pragma unroll
  for (int j = 0; j < 4; ++j) { const int col = 4 * (lane + 64 * j);
    const f32x4 gv = *(const f32x4*)(F.P->in.g_pre_ffn + col), scv = *(const f32x4*)(modrow + 4096 + col), shv = *(const f32x4*)(modrow + 3072 + col);
    const f32x4 o = v[j] * rs2 * gv * (1.f + scv) + shv;
    v2u w; w.x = pk2(o.x, o.y); w.y = pk2(o.z, o.w); *(v2u*)(F.xn() + (size_t)r * D + col) = w; }
}
__device__ __forceinline__ void p12_row(const Frame& F, int r) {
  const int lane = F.lane; const float* modrow = F.mod() + (size_t)cond_row(r) * 6144;
  const f32x4* yr = (const f32x4*)(F.mix() + (size_t)r * D) + lane; const f32x4* xr = (const f32x4*)(F.x1() + (size_t)r * D) + lane;
  f32x4 v[4]; float s = 0.f;
#pragma unroll
  for (int j = 0; j < 4; ++j) { v[j] = yr[64 * j]; s += (v[j].x * v[j].x + v[j].y * v[j].y) + (v[j].z * v[j].z + v[j].w * v[j].w); }
  const float rs = rsqrtf(wave_sum(s) * (1.f / D) + 1e-6f);
  float* orow = y_row(F.P->out, r);
#pragma unroll
  for (int j = 0; j < 4; ++j) { const int col = 4 * (lane + 64 * j);
    const f32x4 gv = *(const f32x4*)(F.P->in.g_post_ffn + col), gt = *(const f32x4*)(modrow + 5120 + col);
    *(f32x4*)(orow + col) = xr[64 * j] + gt * (v[j] * rs * gv); }
}
__device__ __forceinline__ void p3_row(const Frame& F, int r) {
  const int lane = F.lane; const bf16* zr = F.z() + (size_t)r * ZW;
  { unsigned w[3]; float s = 0.f;
#pragma unroll
    for (int j = 0; j < 3; ++j) { w[j] = *(const unsigned*)(zr + ZC_CQ + 2 * lane + 128 * j); const float a = bflo(w[j]), b = bfhi(w[j]); s += a * a + b * b; }
    const float rs = rsqrtf(wave_sum(s) * (1.f / 384.f) + 1e-6f);
#pragma unroll
    for (int j = 0; j < 3; ++j) { const int col = 2 * lane + 128 * j; const f32x2 g = *(const f32x2*)(F.P->in.g_mla_q + col);
      *(unsigned*)(F.cqn() + (size_t)r * 384 + col) = pk2(bflo(w[j]) * rs * g.x, bfhi(w[j]) * rs * g.y); } }
  { const v2u w = *(const v2u*)(zr + ZC_CKV + 4 * lane); const f32x4 v = {bflo(w.x), bfhi(w.x), bflo(w.y), bfhi(w.y)};
    const float s = (v.x * v.x + v.y * v.y) + (v.z * v.z + v.w * v.w); const float rs = rsqrtf(wave_sum(s) * (1.f / 256.f) + 1e-6f);
    const f32x4 o = v * rs * *(const f32x4*)(F.P->in.g_mla_kv + 4 * lane);
    float* lo = r < MP ? F.P->out + nv::OUT_LATP + (size_t)r * 256 : F.P->out + nv::OUT_LATS + (size_t)(r - MP) * 256;
    *(f32x4*)(lo + 4 * lane) = o; v2u ob; ob.x = pk2(o.x, o.y); ob.y = pk2(o.z, o.w); *(v2u*)(F.latb() + (size_t)r * 256 + 4 * lane) = ob; }
  { const int i = lane & 31; const float x1 = bf2f(zr[ZC_KR + i]), x2 = bf2f(zr[ZC_KR + 32 + i]); const f32x2 cs = F.rope()[pos_idx(r) * 32 + i];
    const float o1 = x1 * cs.x - x2 * cs.y, o2 = x1 * cs.y + x2 * cs.x;
    float* ko = r < MP ? F.P->out + nv::OUT_KRP + (size_t)r * 64 : F.P->out + nv::OUT_KRS + (size_t)(r - MP) * 64;
    if (lane < 32) { const bf16 b1 = (bf16)f2bf(o1), b2 = (bf16)f2bf(o2); ko[i] = o1; ko[32 + i] = o2; F.krb()[(size_t)r * 64 + i] = b1; F.krb()[(size_t)r * 64 + 32 + i] = b2;
      if (r < MP) {
#pragma unroll
        for (int h = 0; h < 4; ++h) { bf16* kc = F.kcomb() + ((size_t)((r >> 11) * 4 + h) * T + (r & 2047)) * 200; kc[128 + i] = b1; kc[160 + i] = b2; } } } }
}
__device__ __forceinline__ float log_sigmoid_f(float a) { return fminf(a, 0.f) - log1pf(expf(-fabsf(a))); }
__device__ __forceinline__ f32x16 mfma32(bf16x8 a, bf16x8 b, f32x16 c) { return __builtin_amdgcn_mfma_f32_32x32x16_bf16(a, b, c, 0, 0, 0); }
__device__ __forceinline__ int crow(int rho, int hh) { return (rho & 3) + 8 * (rho >> 2) + 4 * hh; }

__device__ __forceinline__ void gla_prep_unit(const Frame& F, int b, int c) {
  LAS float* grs = (LAS float*)F.lds; LAS float* tot = grs + 1024;
  const int tid = F.tid, col = tid & 255, th = tid >> 8; const int r0 = b * T + c * 64;
  __syncthreads();
  for (int i = tid; i < 1024; i += NTHR) grs[i] = bf2f(F.z()[(size_t)(r0 + (i >> 4)) * ZW + ZC_GR + (i & 15)]);
  __syncthreads();
  float w2[16];
#pragma unroll
  for (int j = 0; j < 16; ++j) w2[j] = F.P->in.w_gla_a2[j * 256 + col];
  const float bias = F.P->in.b_gla_a[col];
  float bl[32]; float run = 0.f;
#pragma unroll
  for (int tt = 0; tt < 32; ++tt) { const int t = th * 32 + tt; float x = bias;
#pragma unroll
    for (int j = 0; j < 16; ++j) x += grs[t * 16 + j] * w2[j];
    run += log_sigmoid_f(x) * (1.f / 16.f); bl[tt] = run; }
  tot[th * 256 + col] = run;
  __syncthreads();
  const float base = th ? tot[col] : 0.f, blast = tot[col] + tot[256 + col];
  unsigned kl[16];
#pragma unroll
  for (int tt = 0; tt < 32; ++tt) { const float bt = bl[tt] + base; const size_t r = (size_t)(r0 + th * 32 + tt);
    const float q = bf2f(F.z()[r * ZW + ZC_QA + col]), k = bf2f(F.z()[r * ZW + ZC_KA + col]);
    F.qd()[r * 256 + col] = (bf16)f2bf(q * 0.125f * expf(bt)); F.kd()[r * 256 + col] = (bf16)f2bf(k * expf(-bt));
    const unsigned kv = f2bf(k * expf(blast - bt));
    if (tt & 1) kl[tt >> 1] |= kv << 16; else kl[tt >> 1] = kv; }
  { v4u* dst = (v4u*)(F.klt() + ((size_t)b * 256 + col) * T + c * 64 + th * 32);
#pragma unroll
    for (int i = 0; i < 4; ++i) dst[i] = (v4u){kl[4 * i], kl[4 * i + 1], kl[4 * i + 2], kl[4 * i + 3]}; }
  if (th == 0) F.dch()[((size_t)b * 32 + c) * 256 + col] = expf(blast);
  { const bf16* src = F.z() + (size_t)r0 * ZW + ZC_VA + tid; v4u* dst = (v4u*)(F.vt() + ((size_t)b * 512 + tid) * T + c * 64);
#pragma unroll
    for (int g = 0; g < 8; ++g) { unsigned w[4];
#pragma unroll
      for (int i = 0; i < 4; ++i) w[i] = (unsigned)src[(size_t)(8 * g + 2 * i) * ZW] | ((unsigned)src[(size_t)(8 * g + 2 * i + 1) * ZW] << 16);
      dst[g] = (v4u){w[0], w[1], w[2], w[3]}; } }
}

__device__ __forceinline__ void gla_sample_unit(const Frame& F, int b, int h) {
  LAS float* L = (LAS float*)F.lds;
  LAS float* bc = L;
  LAS float* qd = L + 512;
  LAS float* kd = L + 1024;
  LAS float* kl = L + 1536;
  LAS float* dk = L + 2048;
  LAS float* att = L + 2112;
  LAS float* vv = L + 2176;
  LAS float* part = L + 3200;
  const int tid = F.tid, r0 = MP + b * DT;
  __syncthreads();
  { const int t = tid >> 6, k = tid & 63; const bf16* zr = F.z() + (size_t)(r0 + t) * ZW; float x = F.P->in.b_gla_a[h * 64 + k];
#pragma unroll
    for (int j = 0; j < 16; ++j) x += bf2f(zr[ZC_GR + j]) * F.P->in.w_gla_a2[j * 256 + h * 64 + k];
    bc[t * 64 + k] = log_sigmoid_f(x) * (1.f / 16.f); }
  for (int i = tid; i < 1024; i += NTHR) vv[i] = bf2f(F.z()[(size_t)(r0 + (i >> 7)) * ZW + ZC_VA + h * 128 + (i & 127)]);
  __syncthreads();
  if (tid < 64) { float run = 0.f; for (int t = 0; t < 8; ++t) { run += bc[t * 64 + tid]; bc[t * 64 + tid] = run; } dk[tid] = expf(run); }
  __syncthreads();
  { const int t = tid >> 6, k = tid & 63; const bf16* zr = F.z() + (size_t)(r0 + t) * ZW; const float bt = bc[t * 64 + k], blast = bc[7 * 64 + k];
    const float q = bf2f(zr[ZC_QA + h * 64 + k]) * 0.125f, kk = bf2f(zr[ZC_KA + h * 64 + k]);
    qd[t * 64 + k] = q * expf(bt); kd[t * 64 + k] = kk * expf(-bt); kl[t * 64 + k] = kk * expf(blast - bt); }
  __syncthreads();
  if (tid < 64) { const int t = tid >> 3, s = tid & 7; float a = 0.f; for (int k = 0; k < 64; ++k) a += qd[t * 64 + k] * kd[s * 64 + k]; att[tid] = s <= t ? a : 0.f; }
  { const int v = tid & 127, kq = tid >> 7; float S0[16];
#pragma unroll
    for (int i = 0; i < 16; ++i) S0[i] = F.P->in.state_gla[(((size_t)b * 4 + h) * 64 + kq * 16 + i) * 128 + v];
#pragma unroll
    for (int t = 0; t < 8; ++t) { float o = 0.f;
#pragma unroll
      for (int i = 0; i < 16; ++i) o += qd[t * 64 + kq * 16 + i] * S0[i];
      part[(kq * 8 + t) * 128 + v] = o; }
#pragma unroll
    for (int i = 0; i < 16; ++i) { float sn = dk[kq * 16 + i] * S0[i];
#pragma unroll
      for (int s = 0; s < 8; ++s) sn += kl[s * 64 + kq * 16 + i] * vv[s * 128 + v];
      F.P->out[nv::OUT_GLAS + (((size_t)b * 4 + h) * 64 + kq * 16 + i) * 128 + v] = sn; } }
  __syncthreads();
  { const int t = F.wave, lane = F.lane; float o[2]; float ss = 0.f;
#pragma unroll
    for (int e = 0; e < 2; ++e) { const int v = lane + 64 * e; float a = part[(0 * 8 + t) * 128 + v] + part[(1 * 8 + t) * 128 + v] + part[(2 * 8 + t) * 128 + v] + part[(3 * 8 + t) * 128 + v];
      for (int s = 0; s <= t; ++s) a += att[t * 8 + s] * vv[s * 128 + v];
      o[e] = a; ss += a * a; }
    const float rs = rsqrtf(wave_sum(ss) * (1.f / 128.f) + 1e-6f);
#pragma unroll
    for (int e = 0; e < 2; ++e) { const int v = lane + 64 * e; const float ra = bf2f(F.z()[(size_t)(r0 + t) * ZW + ZC_RA + h * 128 + v]);
      F.mixin()[(size_t)(r0 + t) * D + h * 128 + v] = (bf16)f2bf(o[e] * rs * F.P->in.g_gla_out[v] * silu_f(ra)); } }
}

__device__ __forceinline__ void gla_passA_item(const Frame& F, int item) {
  const int vh = item & 1, c = (item >> 1) & 31, h = (item >> 6) & 3, b = item >> 8;
  const int lane = F.lane, r = lane & 31, hh = lane >> 5;
  f32x16 acc[2][2];
#pragma unroll
  for (int i = 0; i < 2; ++i)
#pragma unroll
    for (int j = 0; j < 2; ++j)
#pragma unroll
      for (int e = 0; e < 16; ++e) acc[i][j][e] = 0.f;
  const bf16* va = F.vt() + ((size_t)b * 512 + h * 128 + vh * 64 + r) * T + c * 64 + 8 * hh;
  const bf16* ka = F.klt() + ((size_t)b * 256 + h * 64 + r) * T + c * 64 + 8 * hh;
#pragma unroll
  for (int ks = 0; ks < 4; ++ks) { bf16x8 A[2], B[2];
#pragma unroll
    for (int i = 0; i < 2; ++i) { A[i] = *(const bf16x8*)(va + (size_t)i * 32 * T + 16 * ks); B[i] = *(const bf16x8*)(ka + (size_t)i * 32 * T + 16 * ks); }
#pragma unroll
    for (int i = 0; i < 2; ++i)
#pragma unroll
      for (int j = 0; j < 2; ++j) acc[i][j] = mfma32(A[i], B[j], acc[i][j]); }
  float* ub = F.ut() + (((size_t)b * 4 + h) * 32 + c) * 8192;
#pragma unroll
  for (int i = 0; i < 2; ++i)
#pragma unroll
    for (int j = 0; j < 2; ++j)
#pragma unroll
      for (int e = 0; e < 16; ++e) ub[(size_t)(vh * 64 + i * 32 + crow(e, hh)) * 64 + j * 32 + r] = acc[i][j][e];
}
__device__ __forceinline__ void gla_passB(const Frame& F) {
  const int gt = F.bid * NTHR + F.tid;
  if (gt >= 32 * 4096) return;
  const int bh = gt >> 12, pr = gt & 4095, v = pr >> 5, k2 = (pr & 31) * 2, b = bh >> 2, h = bh & 3;
  float s0 = 0.f, s1 = 0.f;
  for (int c = 0; c < 32; ++c) { const size_t e = (((size_t)bh * 32 + c) * 128 + v) * 64 + k2;
    *(unsigned*)(F.st() + e) = pk2(s0, s1);
    const f32x2 d = *(const f32x2*)(F.dch() + ((size_t)b * 32 + c) * 256 + h * 64 + k2), u = *(const f32x2*)(F.ut() + e);
    s0 = d.x * s0 + u.x; s1 = d.y * s1 + u.y; }
  F.P->out[nv::OUT_GLAP + ((size_t)bh * 64 + k2) * 128 + v] = s0; F.P->out[nv::OUT_GLAP + ((size_t)bh * 64 + k2 + 1) * 128 + v] = s1;
}
__device__ __forceinline__ void gla_passC_item(const Frame& F, int item) {
  const int th = item & 1, c = (item >> 1) & 31, h = (item >> 6) & 3, b = item >> 8;
  const int lane = F.lane, r = lane & 31, hh = lane >> 5;
  const size_t row0 = (size_t)b * T + c * 64;
  bf16x8 Bq[4];
  { const bf16* qa = F.qd() + (row0 + th * 32 + r) * 256 + h * 64 + 8 * hh;
#pragma unroll
    for (int ks = 0; ks < 4; ++ks) Bq[ks] = *(const bf16x8*)(qa + 16 * ks); }
  f32x16 p[2];
#pragma unroll
  for (int st = 0; st < 2; ++st) {
#pragma unroll
    for (int e = 0; e < 16; ++e) p[st][e] = 0.f;
    const bf16* ka = F.kd() + (row0 + st * 32 + r) * 256 + h * 64 + 8 * hh;
#pragma unroll
    for (int ks = 0; ks < 4; ++ks) p[st] = mfma32(*(const bf16x8*)(ka + 16 * ks), Bq[ks], p[st]);
#pragma unroll
    for (int e = 0; e < 16; ++e) { const int s = st * 32 + crow(e, hh); if (s > th * 32 + r) p[st][e] = 0.f; } }
  f32x16 o[4];
#pragma unroll
  for (int vt = 0; vt < 4; ++vt)
#pragma unroll
    for (int e = 0; e < 16; ++e) o[vt][e] = 0.f;
  { const bf16* sa = F.st() + ((((size_t)b * 4 + h) * 32 + c) * 128 + r) * 64 + 8 * hh;
#pragma unroll
    for (int vt = 0; vt < 4; ++vt)
#pragma unroll
      for (int ks = 0; ks < 4; ++ks) o[vt] = mfma32(*(const bf16x8*)(sa + (size_t)vt * 32 * 64 + 16 * ks), Bq[ks], o[vt]); }
  { const bf16* va = F.vt() + ((size_t)b * 512 + h * 128 + r) * T + c * 64 + 4 * hh;
#pragma unroll
    for (int st = 0; st < 2; ++st)
#pragma unroll
      for (int ks = 0; ks < 2; ++ks) { v4u pb;
        pb.x = pk2(p[st][8 * ks + 0], p[st][8 * ks + 1]); pb.y = pk2(p[st][8 * ks + 2], p[st][8 * ks + 3]); pb.z = pk2(p[st][8 * ks + 4], p[st][8 * ks + 5]); pb.w = pk2(p[st][8 * ks + 6], p[st][8 * ks + 7]);
        const bf16x8 Bp = __builtin_bit_cast(bf16x8, pb);
#pragma unroll
        for (int vt = 0; vt < 4; ++vt) { const bf16* ap = va + (size_t)vt * 32 * T + st * 32 + 16 * ks;
          const v2u lo = *(const v2u*)ap, hi = *(const v2u*)(ap + 8); const v4u av = {lo.x, lo.y, hi.x, hi.y};
          o[vt] = mfma32(__builtin_bit_cast(bf16x8, av), Bp, o[vt]); } } }
  float ss = 0.f;
#pragma unroll
  for (int vt = 0; vt < 4; ++vt)
#pragma unroll
    for (int e = 0; e < 16; ++e) ss += o[vt][e] * o[vt][e];
  ss += __shfl_xor(ss, 32);
  const float rs = rsqrtf(ss * (1.f / 128.f) + 1e-6f);
  const size_t row = row0 + th * 32 + r;
#pragma unroll
  for (int vt = 0; vt < 4; ++vt)
#pragma unroll
    for (int g = 0; g < 4; ++g) { const int v = vt * 32 + 8 * g + 4 * hh;
      const v2u ra = *(const v2u*)(F.z() + row * ZW + ZC_RA + h * 128 + v); const f32x4 gg = *(const f32x4*)(F.P->in.g_gla_out + v);
      v2u w; w.x = pk2(o[vt][4 * g + 0] * rs * gg.x * silu_f(bflo(ra.x)), o[vt][4 * g + 1] * rs * gg.y * silu_f(bfhi(ra.x)));
      w.y = pk2(o[vt][4 * g + 2] * rs * gg.z * silu_f(bflo(ra.y)), o[vt][4 * g + 3] * rs * gg.w * silu_f(bfhi(ra.y)));
      *(v2u*)(F.mixin() + row * D + h * 128 + v) = w; }
}
typedef short v4i16_t __attribute__((ext_vector_type(4)));
__device__ __forceinline__ s16x4 lds_tr(LAS const unsigned char* p) { return __builtin_bit_cast(s16x4, __builtin_amdgcn_ds_read_tr16_b64_v4i16((LAS v4i16_t*)p)); }
__device__ __forceinline__ bf16x8 mk8(s16x4 lo, s16x4 hi) { return (bf16x8){lo[0], lo[1], lo[2], lo[3], hi[0], hi[1], hi[2], hi[3]}; }
__device__ __forceinline__ bf16x8 pack8(const f32x16& p, int o) { v4u w; w.x = pk2(p[o], p[o + 1]); w.y = pk2(p[o + 2], p[o + 3]); w.z = pk2(p[o + 4], p[o + 5]); w.w = pk2(p[o + 6], p[o + 7]); return __builtin_bit_cast(bf16x8, w); }
__device__ __forceinline__ float max16(const f32x16& p) { float a = fmaxf(fmaxf(p[0], p[1]), fmaxf(p[2], p[3])), b = fmaxf(fmaxf(p[4], p[5]), fmaxf(p[6], p[7])), c = fmaxf(fmaxf(p[8], p[9]), fmaxf(p[10], p[11])), d = fmaxf(fmaxf(p[12], p[13]), fmaxf(p[14], p[15])); return fmaxf(fmaxf(a, b), fmaxf(c, d)); }

constexpr int PA_KROW = 400;
constexpr int PA_KB = 64 * PA_KROW, PA_VB = 16384, PA_BUF = PA_KB + PA_VB;
__device__ __forceinline__ void pattn_unit(const Frame& F, int b, int h, int qb) {
  const int tid = F.tid, lane = F.lane, r = lane & 31, hh = lane >> 5, w = F.wave;
  const size_t row0 = (size_t)b * T; const int q = qb * 256 + w * 32 + r;
  bf16x8 qf[12];
  { const bf16* qp = F.qbuf() + (row0 + q) * QW + h * 192;
#pragma unroll
    for (int s = 0; s < 8; ++s) { const v4u x = *(const v4u*)(qp + 16 * s + 8 * hh); v4u y;
      y.x = pk2(bflo(x.x) * C2, bfhi(x.x) * C2); y.y = pk2(bflo(x.y) * C2, bfhi(x.y) * C2); y.z = pk2(bflo(x.z) * C2, bfhi(x.z) * C2); y.w = pk2(bflo(x.w) * C2, bfhi(x.w) * C2);
      qf[s] = __builtin_bit_cast(bf16x8, y); }
#pragma unroll
    for (int e = 0; e < 2; ++e) { const int i0 = 16 * e + 8 * hh; const v4u a = *(const v4u*)(qp + 128 + i0), c = *(const v4u*)(qp + 160 + i0);
      const f32x2* cs = F.rope() + (size_t)q * 32 + i0; unsigned o1[4], o2[4];
#pragma unroll
      for (int j = 0; j < 4; ++j) { const unsigned aw = a[j], cw = c[j]; const f32x2 c0 = cs[2 * j], c1 = cs[2 * j + 1];
        const float x1a = bflo(aw), x1b = bfhi(aw), x2a = bflo(cw), x2b = bfhi(cw);
        o1[j] = pk2((x1a * c0.x - x2a * c0.y) * C2, (x1b * c1.x - x2b * c1.y) * C2); o2[j] = pk2((x1a * c0.y + x2a * c0.x) * C2, (x1b * c1.y + x2b * c1.x) * C2); }
      qf[8 + e] = __builtin_bit_cast(bf16x8, ((v4u){o1[0], o1[1], o1[2], o1[3]})); qf[10 + e] = __builtin_bit_cast(bf16x8, ((v4u){o2[0], o2[1], o2[2], o2[3]})); } }
  f32x16 o[4];
#pragma unroll
  for (int dt = 0; dt < 4; ++dt)
#pragma unroll
    for (int e = 0; e < 16; ++e) o[dt][e] = 0.f;
  float m = -INFINITY, lsum = 0.f;
  const int nt = 4 * qb + 4, jdiag = 4 * qb + (w >> 1);
  const unsigned char* ksrc = (const unsigned char*)(F.kcomb() + ((size_t)(b * 4 + h) * T) * 200) + lane * 16;
  const unsigned char* vsrc = (const unsigned char*)(F.vb() + row0 * 512 + h * 128) + (lane >> 2) * 1024 + (lane & 3) * 16;
#define PA_ISSUE(j_, buf_) do { LAS unsigned char* kb_ = F.lds + (buf_) * PA_BUF; \
    for (int c_ = w; c_ < 25; c_ += 8) __builtin_amdgcn_global_load_lds((const unsigned*)(ksrc + (size_t)(j_) * PA_KB + c_ * 1024), (LAS unsigned*)(kb_ + c_ * 1024), 16, 0, 0); \
    _Pragma("unroll") for (int i_ = 0; i_ < 2; ++i_) { const int c_ = w + 8 * i_; \
      __builtin_amdgcn_global_load_lds((const unsigned*)(vsrc + (size_t)(j_) * 65536 + (c_ & 3) * 16384 + (c_ >> 2) * 64), (LAS unsigned*)(kb_ + PA_KB + c_ * 1024), 16, 0, 0); } } while (0)
  __syncthreads();
  PA_ISSUE(0, 0);
  const int trbase = ((lane >> 4) & 1) * 32 + (lane & 3) * 8 + (4 * hh + ((lane & 15) >> 2)) * 64;
  for (int j = 0; j < nt; ++j) {
    __syncthreads();
    if (j + 1 < nt) PA_ISSUE(j + 1, (j + 1) & 1);
    if (j <= jdiag) {
      LAS const unsigned char* kb = F.lds + (j & 1) * PA_BUF; LAS const unsigned char* vbp = kb + PA_KB;
      f32x16 p0, p1;
#pragma unroll
      for (int e = 0; e < 16; ++e) { p0[e] = 0.f; p1[e] = 0.f; }
      LAS const unsigned char* ka = kb + r * PA_KROW + 16 * hh;
#pragma unroll
      for (int sg = 0; sg < 3; ++sg) {
#pragma unroll
        for (int s = 4 * sg; s < 4 * sg + 4; ++s) { const bf16x8 a0 = *(LAS const bf16x8*)(ka + 32 * s), a1 = *(LAS const bf16x8*)(ka + 32 * PA_KROW + 32 * s);
          p0 = mfma32(a0, qf[s], p0); p1 = mfma32(a1, qf[s], p1); }
        __builtin_amdgcn_sched_barrier(0); }
      if (j == jdiag) {
#pragma unroll
        for (int e = 0; e < 16; ++e) { const int kv = 64 * j + crow(e, hh); if (kv > q) p0[e] = -INFINITY; if (kv + 32 > q) p1[e] = -INFINITY; } }
      float tmax = fmaxf(max16(p0), max16(p1)); tmax = fmaxf(tmax, __shfl_xor(tmax, 32));
      const float mn = fmaxf(m, tmax), alpha = __builtin_amdgcn_exp2f(m - mn); m = mn;
      float ps = 0.f;
#pragma unroll
      for (int e = 0; e < 16; ++e) { p0[e] = __builtin_amdgcn_exp2f(p0[e] - mn); p1[e] = __builtin_amdgcn_exp2f(p1[e] - mn); ps += p0[e] + p1[e]; }
      lsum = lsum * alpha + ps;
#pragma unroll
      for (int dt = 0; dt < 4; ++dt)
#pragma unroll
        for (int e = 0; e < 16; ++e) o[dt][e] *= alpha;
#pragma unroll
      for (int u = 0; u < 2; ++u)
#pragma unroll
        for (int ks = 0; ks < 2; ++ks) { const bf16x8 pb = pack8(u ? p1 : p0, 8 * ks);
#pragma unroll
          for (int dt = 0; dt < 4; ++dt) { LAS const unsigned char* vp = vbp + dt * 4096 + (32 * u + 16 * ks) * 64 + trbase;
            o[dt] = mfma32(mk8(lds_tr(vp), lds_tr(vp + 512)), pb, o[dt]); }
          __builtin_amdgcn_sched_barrier(0); }
    }
  }
#undef PA_ISSUE
  const float lt = lsum + __shfl_xor(lsum, 32); const float inv = 1.f / lt;
  float ss = 0.f;
#pragma unroll
  for (int dt = 0; dt < 4; ++dt)
#pragma unroll
    for (int e = 0; e < 16; ++e) { o[dt][e] *= inv; ss += o[dt][e] * o[dt][e]; }
  ss += __shfl_xor(ss, 32);
  const float rs = rsqrtf(ss * (1.f / 128.f) + 1e-6f);
  bf16* op = F.mixin() + (row0 + q) * D + 512 + h * 128;
#pragma unroll
  for (int dt = 0; dt < 4; ++dt)
#pragma unroll
    for (int g = 0; g < 4; ++g) { const int d = dt * 32 + 8 * g + 4 * hh; const f32x4 gg = *(const f32x4*)(F.P->in.g_mla_out + d);
      v2u wv; wv.x = pk2(o[dt][4 * g] * rs * gg.x, o[dt][4 * g + 1] * rs * gg.y); wv.y = pk2(o[dt][4 * g + 2] * rs * gg.z, o[dt][4 * g + 3] * rs * gg.w);
      *(v2u*)(op + d) = wv; }
}

constexpr int DA_KROW = 656;
constexpr int DA_Q = 32 * DA_KROW, DA_KB = 32 * DA_KROW, DA_VB = 16384, DA_BUF = DA_KB + DA_VB;
__device__ __forceinline__ int split_tile0(int s) { return (512 * s) / NSPLIT; }
__device__ __forceinline__ void dattn_unit(const Frame& F, int b, int sp) {
  const int tid = F.tid, lane = F.lane, r = lane & 31, hh = lane >> 5, w = F.wave;
  LAS unsigned char* qs = F.lds; LAS unsigned char* bufs = F.lds + DA_Q;
  __syncthreads();
  { const int rr = tid >> 4, cg = tid & 15, t = rr >> 2, h = rr & 3; const bf16* qrow = F.qbuf() + (size_t)(MP + b * DT + t) * QW;
    const v4u* src = (const v4u*)(qrow + 768 + h * 256 + cg * 16); LAS v4u* dst = (LAS v4u*)(qs + rr * DA_KROW + cg * 32);
#pragma unroll
    for (int e = 0; e < 2; ++e) { const v4u x = src[e]; v4u y;
      y.x = pk2(bflo(x.x) * C2, bfhi(x.x) * C2); y.y = pk2(bflo(x.y) * C2, bfhi(x.y) * C2); y.z = pk2(bflo(x.z) * C2, bfhi(x.z) * C2); y.w = pk2(bflo(x.w) * C2, bfhi(x.w) * C2); dst[e] = y; }
    LAS bf16* qd = (LAS bf16*)(qs + rr * DA_KROW);
#pragma unroll
    for (int e = 0; e < 2; ++e) { const int i = 2 * cg + e; const float x1 = bf2f(qrow[h * 192 + 128 + i]), x2 = bf2f(qrow[h * 192 + 160 + i]); const f32x2 cs = F.rope()[(2048 + t) * 32 + i];
      qd[256 + i] = (bf16)f2bf((x1 * cs.x - x2 * cs.y) * C2); qd[288 + i] = (bf16)f2bf((x1 * cs.y + x2 * cs.x) * C2); } }
  const int t0 = split_tile0(sp), t1 = split_tile0(sp + 1); const bool has_new = (sp == NSPLIT - 1); const int nt = (t1 - t0) + (has_new ? 1 : 0);
  f32x4 lreg[4], rreg;
  auto load_tile = [&](int ti) {
    const int tile = t0 + ti; const int page = F.P->in.page_table[b * NPG + (tile >> 2)]; const size_t prow = (size_t)page * 128 + (tile & 3) * 32;
#pragma unroll
    for (int i = 0; i < 4; ++i) { const int f = tid + NTHR * i; lreg[i] = *(const f32x4*)(F.P->in.cache_lat + (prow + (f >> 6)) * 256 + (f & 63) * 4); }
    rreg = *(const f32x4*)(F.P->in.cache_kr + (prow + (tid >> 4)) * 64 + (tid & 15) * 4);
  };
  auto store_tile = [&](int buf) {
    LAS unsigned char* kb = bufs + buf * DA_BUF; LAS unsigned char* vbp = kb + DA_KB;
#pragma unroll
    for (int i = 0; i < 4; ++i) { const int f = tid + NTHR * i, row = f >> 6, c4 = f & 63; v2u wv; wv.x = pk2(lreg[i].x, lreg[i].y); wv.y = pk2(lreg[i].z, lreg[i].w);
      *(LAS v2u*)(kb + row * DA_KROW + c4 * 8) = wv; *(LAS v2u*)(vbp + (c4 >> 3) * 2048 + row * 64 + (c4 & 7) * 8) = wv; }
    { const int row = tid >> 4, c4 = tid & 15; v2u wv; wv.x = pk2(rreg.x, rreg.y); wv.y = pk2(rreg.z, rreg.w); *(LAS v2u*)(kb + row * DA_KROW + 512 + c4 * 8) = wv; }
  };
  auto store_new = [&](int buf) {
    LAS unsigned char* kb = bufs + buf * DA_BUF; LAS unsigned char* vbp = kb + DA_KB;
#pragma unroll
    for (int i = 0; i < 4; ++i) { const int f = tid + NTHR * i, row = f >> 6, c4 = f & 63; v2u wv = {0u, 0u};
      if (row < DT) wv = *(const v2u*)(F.latb() + (size_t)(MP + b * DT + row) * 256 + c4 * 4);
      *(LAS v2u*)(kb + row * DA_KROW + c4 * 8) = wv; *(LAS v2u*)(vbp + (c4 >> 3) * 2048 + row * 64 + (c4 & 7) * 8) = wv; }
    { const int row = tid >> 4, c4 = tid & 15; v2u wv = {0u, 0u}; if (row < DT) wv = *(const v2u*)(F.krb() + (size_t)(MP + b * DT + row) * 64 + c4 * 4);
      *(LAS v2u*)(kb + row * DA_KROW + 512 + c4 * 8) = wv; }
  };
  const int npast = t1 - t0;
  load_tile(0); store_tile(0);
  f32x16 o;
#pragma unroll
  for (int e = 0; e < 16; ++e) o[e] = 0.f;
  float m = -INFINITY, lsum = 0.f;
  const int trbase = ((lane >> 4) & 1) * 32 + (lane & 3) * 8 + (4 * hh + ((lane & 15) >> 2)) * 64;
  for (int j = 0; j < nt; ++j) {
    __syncthreads();
    if (j + 1 < npast) load_tile(j + 1);
    {
      LAS const unsigned char* kb = bufs + (j & 1) * DA_BUF; LAS const unsigned char* vbp = kb + DA_KB;
      f32x16 p;
#pragma unroll
      for (int e = 0; e < 16; ++e) p[e] = 0.f;
      LAS const unsigned char* ka = kb + r * DA_KROW + 16 * hh; LAS const unsigned char* qa = qs + r * DA_KROW + 16 * hh;
#pragma unroll
      for (int s = 0; s < 20; ++s) p = mfma32(*(LAS const bf16x8*)(ka + 32 * s), *(LAS const bf16x8*)(qa + 32 * s), p);
      if (j >= npast) {
#pragma unroll
        for (int e = 0; e < 16; ++e) { const int kv = crow(e, hh); if (kv > (r >> 2)) p[e] = -INFINITY; } }
      float tmax = max16(p); tmax = fmaxf(tmax, __shfl_xor(tmax, 32));
      const float mn = fmaxf(m, tmax), alpha = __builtin_amdgcn_exp2f(m - mn); m = mn;
      float ps = 0.f;
#pragma unroll
      for (int e = 0; e < 16; ++e) { p[e] = __builtin_amdgcn_exp2f(p[e] - mn); ps += p[e]; }
      lsum = lsum * alpha + ps;
#pragma unroll
      for (int e = 0; e < 16; ++e) o[e] *= alpha;
#pragma unroll
      for (int ks = 0; ks < 2; ++ks) { LAS const unsigned char* vp = vbp + w * 2048 + (16 * ks) * 64 + trbase;
        o = mfma32(mk8(lds_tr(vp), lds_tr(vp + 512)), pack8(p, 8 * ks), o); }
    }
    if (j + 1 < npast) store_tile((j + 1) & 1); else if (j + 1 < nt) store_new((j + 1) & 1);
  }
  float* po = F.dpo() + (((size_t)b * NSPLIT + sp) * 32 + r) * 256 + 32 * w;
#pragma unroll
  for (int g = 0; g < 4; ++g) *(f32x4*)(po + 8 * g + 4 * hh) = (f32x4){o[4 * g], o[4 * g + 1], o[4 * g + 2], o[4 * g + 3]};
  const float lt = lsum + __shfl_xor(lsum, 32);
  if (w == 0 && lane < 32) { float* pm = F.dpml() + ((size_t)b * NSPLIT + sp) * 64; pm[r] = m; pm[32 + r] = lt; }
}
__device__ __forceinline__ void dcombine_unit(const Frame& F, int b) {
  LAS float* ol = (LAS float*)F.lds;
  const int tid = F.tid;
  __syncthreads();
  { const int q = tid >> 4, c0 = (tid & 15) * 16; float mm[NSPLIT], M = -INFINITY;
#pragma unroll
    for (int s = 0; s < NSPLIT; ++s) { mm[s] = F.dpml()[((size_t)b * NSPLIT + s) * 64 + q]; M = fmaxf(M, mm[s]); }
    float Lt = 0.f; f32x4 a[4];
#pragma unroll
    for (int i = 0; i < 4; ++i) a[i] = (f32x4){0.f, 0.f, 0.f, 0.f};
#pragma unroll
    for (int s = 0; s < NSPLIT; ++s) { const float ws = __builtin_amdgcn_exp2f(mm[s] - M); Lt += ws * F.dpml()[((size_t)b * NSPLIT + s) * 64 + 32 + q];
      const f32x4* src = (const f32x4*)(F.dpo() + (((size_t)b * NSPLIT + s) * 32 + q) * 256 + c0);
#pragma unroll
      for (int i = 0; i < 4; ++i) a[i] += ws * src[i]; }
    const float inv = 1.f / Lt;
#pragma unroll
    for (int i = 0; i < 4; ++i) *(LAS f32x4*)(ol + q * 256 + c0 + 4 * i) = a[i] * inv; }
  __syncthreads();
  { const int q = tid >> 4, vg = tid & 15, h = q & 3, t = q >> 2; float acc[8];
#pragma unroll
    for (int i = 0; i < 8; ++i) acc[i] = 0.f;
    const float* wv = F.P->in.w_mla_uv + h * 128 + vg * 8;
    for (int l = 0; l < 256; ++l) { const float x = ol[q * 256 + l]; const f32x4 w0 = *(const f32x4*)(wv + (size_t)l * 512), w1 = *(const f32x4*)(wv + (size_t)l * 512 + 4);
      acc[0] += x * w0.x; acc[1] += x * w0.y; acc[2] += x * w0.z; acc[3] += x * w0.w; acc[4] += x * w1.x; acc[5] += x * w1.y; acc[6] += x * w1.z; acc[7] += x * w1.w; }
    float ss = 0.f;
#pragma unroll
    for (int i = 0; i < 8; ++i) ss += acc[i] * acc[i];
#pragma unroll
    for (int o = 1; o < 16; o <<= 1) ss += __shfl_xor(ss, o);
    const float rs = rsqrtf(ss * (1.f / 128.f) + 1e-6f); const float* g = F.P->in.g_mla_out + vg * 8;
    v4u wo; wo.x = pk2(acc[0] * rs * g[0], acc[1] * rs * g[1]); wo.y = pk2(acc[2] * rs * g[2], acc[3] * rs * g[3]); wo.z = pk2(acc[4] * rs * g[4], acc[5] * rs * g[5]); wo.w = pk2(acc[6] * rs * g[6], acc[7] * rs * g[7]);
    *(v4u*)(F.mixin() + (size_t)(MP + b * DT + t) * D + 512 + h * 128 + vg * 8) = wo; }
}
struct StaticOrder {
  int nM, nN, nwg, G, c;
  __device__ void init(int nM_, int nN_, int G_, int c_) { nM = nM_; nN = nN_; nwg = nM * nN; G = G_; c = c_; }
  __device__ bool next(int i, pg8::Unit& u) const {
    const long L = (long)i * G + c; if (L >= nwg) return false;
    int wgid = (int)L; { const int q = nwg / 8, r = nwg % 8, xcd = wgid % 8, off = wgid / 8; wgid = (xcd < r ? xcd * (q + 1) : r * (q + 1) + (xcd - r) * q) + off; }
    const int nig = 8 * nN, gid = wgid / nig, fm = gid * 8, gsz = (nM - fm) < 8 ? (nM - fm) : 8;
    u.pm = fm + ((wgid % nig) % gsz); u.pn = (wgid % nig) / gsz; u.kk = 0; return true;
  }
  __device__ __forceinline__ void a_ready(const pg8::Unit&) const {}
  __device__ __forceinline__ void done(const pg8::Unit&) const {}
};
struct SchedQ {
  int G, c;
  __device__ bool next(int i, pg8::Unit& u) const {
    const int L = i * G + c; if (L >= 199) return false;
    if (L < 192) { u.pm = L / 3; u.pn = L % 3; } else { u.pm = 64; u.pn = L - 192; }
    u.kk = 0; return true;
  }
  __device__ __forceinline__ void a_ready(const pg8::Unit&) const {}
  __device__ __forceinline__ void done(const pg8::Unit&) const {}
};
struct EpiBf16 {
  static constexpr bool PERM = true, AFTER_DRAIN = false;
  bf16* O; int ldc; int split_cols; size_t split_stride;
  __device__ __forceinline__ void operator()(const pg8::f32x4 (&acc)[2][2][4][2], const pg8::Unit& u, int wr, int wc, int fr, int fq) const {
    const int row0 = u.pm * 256 + wr * 64 + fr; int colt = u.pn * 256; bf16* base = O;
    if (split_cols) { const int t = colt / split_cols; base += (size_t)t * split_stride; colt -= t * split_cols; }
    const int col0 = colt + wc * 32 + 8 * fq;
#pragma unroll
    for (int ai = 0; ai < 2; ++ai)
#pragma unroll
      for (int m = 0; m < 4; ++m) { bf16* rowp = base + (size_t)(row0 + ai * 128 + m * 16) * ldc + col0;
#pragma unroll
        for (int bj = 0; bj < 2; ++bj) { const pg8::f32x4 v0 = acc[ai][bj][m][0], v1 = acc[ai][bj][m][1];
          v4u w; w.x = pg8::cvt_pk_bf16(v0[0], v0[1]); w.y = pg8::cvt_pk_bf16(v0[2], v0[3]); w.z = pg8::cvt_pk_bf16(v1[0], v1[1]); w.w = pg8::cvt_pk_bf16(v1[2], v1[3]);
          *(v4u*)(rowp + bj * 128) = w; } }
  }
};
struct EpiKV {
  static constexpr bool PERM = true, AFTER_DRAIN = false;
  bf16* KC; bf16* VB;
  __device__ __forceinline__ void operator()(const pg8::f32x4 (&acc)[2][2][4][2], const pg8::Unit& u, int wr, int wc, int fr, int fq) const {
    const int row0 = u.pm * 256 + wr * 64 + fr; const int cin = wc * 32 + 8 * fq;
#pragma unroll
    for (int ai = 0; ai < 2; ++ai)
#pragma unroll
      for (int m = 0; m < 4; ++m) { const int row = row0 + ai * 128 + m * 16;
#pragma unroll
        for (int bj = 0; bj < 2; ++bj) { const pg8::f32x4 v0 = acc[ai][bj][m][0], v1 = acc[ai][bj][m][1];
          v4u w; w.x = pg8::cvt_pk_bf16(v0[0], v0[1]); w.y = pg8::cvt_pk_bf16(v0[2], v0[3]); w.z = pg8::cvt_pk_bf16(v1[0], v1[1]); w.w = pg8::cvt_pk_bf16(v1[2], v1[3]);
          if (u.pn < 2) *(v4u*)(KC + ((size_t)((row >> 11) * 4 + 2 * u.pn + bj) * T + (row & 2047)) * 200 + cin) = w;
          else *(v4u*)(VB + (size_t)row * 512 + (u.pn - 2) * 256 + bj * 128 + cin) = w; } }
  }
};
struct EpiUp {
  static constexpr bool PERM = true, AFTER_DRAIN = false;
  bf16* O; float* out;
  __device__ __forceinline__ void operator()(const pg8::f32x4 (&acc)[2][2][4][2], const pg8::Unit& u, int wr, int wc, int fr, int fq) const {
    const int row0 = u.pm * 256 + wr * 64 + fr; const int col0 = u.pn * 256 + wc * 32 + 8 * fq;
#pragma unroll
    for (int ai = 0; ai < 2; ++ai)
#pragma unroll
      for (int m = 0; m < 4; ++m) { const int row = row0 + ai * 128 + m * 16; bf16* rowp = O + (size_t)row * F2 + col0;
        float* cv = nullptr;
        if (row < MP) { const int t = row & 2047; if (t >= T - 2) cv = out + nv::OUT_CONVP + ((size_t)(row >> 11) * 2 + (t - (T - 2))) * F2 + col0; }
        else { const int t = (row - MP) & 7; if (t >= DT - 2) cv = out + nv::OUT_CONVS + ((size_t)((row - MP) >> 3) * 2 + (t - (DT - 2))) * F2 + col0; }
#pragma unroll
        for (int bj = 0; bj < 2; ++bj) { const pg8::f32x4 v0 = acc[ai][bj][m][0], v1 = acc[ai][bj][m][1];
          v4u w; w.x = pg8::cvt_pk_bf16(v0[0], v0[1]); w.y = pg8::cvt_pk_bf16(v0[2], v0[3]); w.z = pg8::cvt_pk_bf16(v1[0], v1[1]); w.w = pg8::cvt_pk_bf16(v1[2], v1[3]);
          *(v4u*)(rowp + bj * 128) = w;
          if (cv) { *(pg8::f32x4*)(cv + bj * 128) = v0; *(pg8::f32x4*)(cv + bj * 128 + 4) = v1; } } }
  }
};
struct EpiF32 {
  static constexpr bool PERM = false, AFTER_DRAIN = false;
  float* C; int ldc;
  __device__ __forceinline__ void operator()(const pg8::f32x4 (&acc)[2][2][4][2], const pg8::Unit& u, int wr, int wc, int fr, int fq) const {
    const int row0 = u.pm * 256 + wr * 64 + fr, col0 = u.pn * 256 + wc * 32 + 4 * fq;
#pragma unroll
    for (int ai = 0; ai < 2; ++ai)
#pragma unroll
      for (int m = 0; m < 4; ++m) { float* rowp = C + (size_t)(row0 + ai * 128 + m * 16) * ldc + col0;
#pragma unroll
        for (int bj = 0; bj < 2; ++bj)
#pragma unroll
          for (int n = 0; n < 2; ++n) *(pg8::f32x4*)(rowp + bj * 128 + n * 16) = acc[ai][bj][m][n]; }
  }
};

__device__ __forceinline__ float gelu_tanh_f(float x) { const float y = 0.7978845608028654f * (x + 0.044715f * x * x * x); const float th = 1.f - 2.f / (1.f + __expf(2.f * y)); return 0.5f * x * (1.f + th); }
__device__ __forceinline__ void p10_convgelu(const Frame& F) {
  const int gt = F.bid * NTHR + F.tid, NGT = F.G * NTHR;
  for (int it = gt; it < MT * 352; it += NGT) {
    const int r = it / 352, f = (it % 352) * 8; const bool samp = r >= MP; const int t = samp ? (r - MP) & 7 : r & 2047; const int b = samp ? (r - MP) >> 3 : 0;
    float uc[2][8];
#pragma unroll
    for (int half = 0; half < 2; ++half) { const int col = f + half * FF;
      { const f32x4 b0 = *(const f32x4*)(F.P->in.b_ffn_conv + col), b1 = *(const f32x4*)(F.P->in.b_ffn_conv + col + 4);
        uc[half][0] = b0.x; uc[half][1] = b0.y; uc[half][2] = b0.z; uc[half][3] = b0.w; uc[half][4] = b1.x; uc[half][5] = b1.y; uc[half][6] = b1.z; uc[half][7] = b1.w; }
#pragma unroll
      for (int j = 0; j < 3; ++j) { const int tt = t - 2 + j; float v[8];
        if (tt >= 0) { const v4u x = *(const v4u*)(F.u() + (size_t)(r - 2 + j) * F2 + col);
          v[0] = bflo(x.x); v[1] = bfhi(x.x); v[2] = bflo(x.y); v[3] = bfhi(x.y); v[4] = bflo(x.z); v[5] = bfhi(x.z); v[6] = bflo(x.w); v[7] = bfhi(x.w); }
        else if (samp) { const float* sc = F.P->in.state_conv + ((size_t)b * 2 + (tt + 2)) * F2 + col; const f32x4 s0 = *(const f32x4*)sc, s1 = *(const f32x4*)(sc + 4);
          v[0] = s0.x; v[1] = s0.y; v[2] = s0.z; v[3] = s0.w; v[4] = s1.x; v[5] = s1.y; v[6] = s1.z; v[7] = s1.w; }
        else {
#pragma unroll
          for (int e = 0; e < 8; ++e) v[e] = 0.f; }
        const float* wc = F.P->in.w_ffn_conv + (size_t)j * F2 + col; const f32x4 w0 = *(const f32x4*)wc, w1 = *(const f32x4*)(wc + 4);
        uc[half][0] += w0.x * v[0]; uc[half][1] += w0.y * v[1]; uc[half][2] += w0.z * v[2]; uc[half][3] += w0.w * v[3];
        uc[half][4] += w1.x * v[4]; uc[half][5] += w1.y * v[5]; uc[half][6] += w1.z * v[6]; uc[half][7] += w1.w * v[7]; } }
    v4u o;
    o.x = pk2(uc[0][0] * gelu_tanh_f(uc[1][0]), uc[0][1] * gelu_tanh_f(uc[1][1])); o.y = pk2(uc[0][2] * gelu_tanh_f(uc[1][2]), uc[0][3] * gelu_tanh_f(uc[1][3]));
    o.z = pk2(uc[0][4] * gelu_tanh_f(uc[1][4]), uc[0][5] * gelu_tanh_f(uc[1][5])); o.w = pk2(uc[0][6] * gelu_tanh_f(uc[1][6]), uc[0][7] * gelu_tanh_f(uc[1][7]));
    *(v4u*)(F.hmid() + (size_t)r * FF + f) = o;
  }
}

constexpr int N_PHASES = 13;
__global__ void __launch_bounds__(NTHR, 2) mega(Params prm) {
  extern __shared__ __attribute__((aligned(16))) unsigned char lds_raw[];
  Frame F;
  F.lds = (LAS unsigned char*)lds_raw;
  F.tid = threadIdx.x; F.lane = F.tid & 63; F.wave = __builtin_amdgcn_readfirstlane(F.tid >> 6); F.G = gridDim.x; F.bid = blockIdx.x;
  F.P = &prm;
  unsigned char* ws = prm.ws;
  volatile LAS unsigned* MISC = (volatile LAS unsigned*)(F.lds + MISC_OFF);
  for (int i = F.tid; i < (LDS_BYTES - LDSCTL_OFF) / 4; i += NTHR) ((LAS unsigned*)(F.lds + LDSCTL_OFF))[i] = 0u;
  __syncthreads();
  const int lo = prm.ph_lo, hi = prm.ph_hi;
  XcdBarrier bar; bar.bar = (unsigned*)(ws + W_CTL) + CW_BAR; bar.x = 0; bar.st = nullptr;
  if (hi - lo > 1) bar = xcd_barrier_post((unsigned*)(ws + W_CTL) + CW_BAR, MISC + 8);
#ifndef PHMASK
#define PHMASK 0x1fff
#endif
#define IN(k) ((((PHMASK) >> (k)) & 1) && lo <= (k) && (k) < hi)
#define SEAM(k) do { if (IN(k) && IN((k) + 1)) xcd_barrier(bar); } while (0)
  const int gw = F.bid * NWAVES + F.wave, NGW = F.G * NWAVES;
  LAS unsigned char* ring = F.lds;

  if (IN(0)) { p0_prologue(F); } SEAM(0);
  if (IN(1)) { p1_xn(F); } SEAM(1);
  if (IN(2)) {
    pg8::Gemm g{F.xn(), F.win_t(), 1024, 1024, 1024}; StaticOrder S; S.init(65, 9, F.G, F.bid);
    EpiBf16 E{F.z(), ZW, 0, 0};
    pg8::gemm_phase<EpiBf16, StaticOrder, true, true>(ring, g, S, E);
  } SEAM(2);
  if (IN(3)) {
    for (int u = F.bid; u < 384; u += F.G) { if (u < 256) gla_prep_unit(F, u >> 5, u & 31); else gla_sample_unit(F, (u - 256) >> 2, (u - 256) & 3); }
    for (int r = gw; r < MT; r += NGW) p3_row(F, r);
  } SEAM(3);
  if (IN(4)) {
#if !defined(SUB) || SUB == 1
    { pg8::Gemm g{F.cqn(), F.wq_t(), 384, 384, 384}; SchedQ S{F.G, F.bid}; EpiBf16 E{F.qbuf(), QW, 0, 0};
      pg8::gemm_phase<EpiBf16, SchedQ, true, true>(ring, g, S, E); }
#endif
#if !defined(SUB) || SUB == 2
    { pg8::Gemm g{F.latb(), F.wkv_t(), 256, 256, 256}; StaticOrder S; S.init(64, 4, F.G, F.bid); EpiKV E{F.kcomb(), F.vb()};
      pg8::gemm_phase<EpiKV, StaticOrder, true, true>(ring, g, S, E); }
#endif
#if !defined(SUB) || SUB == 3
    for (int it = gw; it < 2048; it += NGW) gla_passA_item(F, it);
#endif
  } SEAM(4);
  if (IN(5)) {
#if !defined(SUB) || SUB == 4
    gla_passB(F);
#endif
    const int nd = (F.G * 3) / 4;
#if !defined(SUB) || SUB == 5
    if (F.bid < nd) { for (int u = F.bid; u < DB * NSPLIT; u += nd) dattn_unit(F, u / NSPLIT, u % NSPLIT); }
#endif
#if !defined(SUB) || SUB == 6
    if (F.bid >= nd) { for (int i = F.bid - nd; i < 64; i += F.G - nd) { const int bh = i >> 1;
        for (int k = 0; k < 4; ++k) { const int qb = (i & 1) ? (k == 0 ? 5 : k == 1 ? 2 : k == 2 ? 4 : 3) : (k == 0 ? 7 : k == 1 ? 0 : k == 2 ? 6 : 1); pattn_unit(F, bh >> 2, bh & 3, qb); } } }
#endif
  } SEAM(5);
  if (IN(6)) {
    for (int b = F.bid; b < DB; b += F.G) dcombine_unit(F, b);
    for (int it = gw; it < 2048; it += NGW) gla_passC_item(F, it);
  } SEAM(6);
  if (IN(7)) {
    pg8::Gemm g{F.mixin(), F.wo_t(), 1024, 1024, 1024}; StaticOrder S; S.init(65, 4, F.G, F.bid); EpiF32 E{F.mix(), 1024};
    pg8::gemm_phase<EpiF32, StaticOrder, true, true>(ring, g, S, E);
  } SEAM(7);
  if (IN(8)) { for (int r = gw; r < MT; r += NGW) p8_row(F, r); } SEAM(8);
  if (IN(9)) {
    pg8::Gemm g{F.xn(), F.wup_t(), 1024, 1024, 1024}; StaticOrder S; S.init(65, 22, F.G, F.bid); EpiUp E{F.u(), F.P->out};
    pg8::gemm_phase<EpiUp, StaticOrder, true, true>(ring, g, S, E);
  } SEAM(9);
  if (IN(10)) { p10_convgelu(F); } SEAM(10);
  if (IN(11)) {
    pg8::Gemm g{F.hmid(), F.wdn_t(), FF, FF, FF}; StaticOrder S; S.init(65, 4, F.G, F.bid); EpiF32 E{F.mix(), 1024};
    pg8::gemm_phase<EpiF32, StaticOrder, true, true>(ring, g, S, E);
  } SEAM(11);
  if (IN(12)) { for (int r = gw; r < MT; r += NGW) p12_row(F, r); }
#undef IN
#undef SEAM
}
}
#ifndef DIAG
#define DIAG 1
#endif
#ifndef DIAG_PH
#define DIAG_PH 13
#endif
namespace dg {
constexpr int NCHK = 32;
struct Tol { float t[NCHK]; };
__global__ void k_cmp(const float* ref, long ref_ld, const void* tst, int tst_bf16, long tst_ld, int rows, int cols, float* acc) {
  __shared__ float red[16];
  float num = 0.f, den = 0.f; const long n = (long)rows * cols;
  for (long i = (long)blockIdx.x * blockDim.x + threadIdx.x; i < n; i += (long)gridDim.x * blockDim.x) { const long r = i / cols, c = i % cols;
    const float a = ref[r * ref_ld + c]; const float b = tst_bf16 ? fz::bf2f(((const unsigned short*)tst)[r * tst_ld + c]) : ((const float*)tst)[r * tst_ld + c];
    num += (a - b) * (a - b); den += a * a; }
  num = nv::block_sum(num, red); den = nv::block_sum(den, red);
  if (threadIdx.x == 0) { atomicAdd(acc, num); atomicAdd(acc + 1, den); }
}
__global__ void k_report(const float* acc, float* out, Tol tol, float* code) {
  __shared__ int sidx; __shared__ float serr;
  if (threadIdx.x == 0) { int idx = 0; float err = 0.f;
    for (int i = 1; i < NCHK; ++i) { const float num = acc[2 * i], den = acc[2 * i + 1]; if (den == 0.f && num == 0.f) continue; const float e = sqrtf(num / den); if (!(e <= tol.t[i])) { idx = i; err = e; break; } }
    sidx = idx; serr = err; }
  __syncthreads();
  const int idx = sidx; if (idx == 0) return;
  float e = serr; if (!(e >= 0.1f)) e = 0.1f; if (!(e <= 2.f)) e = 2.f; if (serr != serr) e = 2.f;
  for (long i = (long)blockIdx.x * blockDim.x + threadIdx.x; i < (long)nv::MP * nv::D; i += (long)gridDim.x * blockDim.x) { float v = out[i] * (1.f + e); if (i == 0) v += 8.f * idx; out[i] = v; }
  if (blockIdx.x == 0 && threadIdx.x == 0) { code[0] = (float)idx; code[1] = serr; }
}
}

extern "C" void kernel_launch(void* const* d_in, const int* in_sizes, int n_in, void* d_out, int out_size, void* d_ws, size_t ws_size, hipStream_t stream) {
  static int grid = 0;
  if (grid == 0) {
    int dev = 0, cus = 0;
    if (hipGetDevice(&dev) != hipSuccess || hipDeviceGetAttribute(&cus, hipDeviceAttributeMultiprocessorCount, dev) != hipSuccess) { grid = -1; return; }
    if (hipFuncSetAttribute((const void*)fz::mega, hipFuncAttributeMaxDynamicSharedMemorySize, fz::LDS_BYTES) != hipSuccess) { fprintf(stderr, "hipFuncSetAttribute failed\n"); grid = -1; return; }
    int per_cu = 0; (void)hipOccupancyMaxActiveBlocksPerMultiprocessor(&per_cu, (const void*)fz::mega, fz::NTHR, fz::LDS_BYTES); (void)hipGetLastError();
    grid = cus;
    if (per_cu < 1) fprintf(stderr, "occupancy query reports %d\n", per_cu);
  }
  if (grid < 0) return;
  nv::In in = nv::make_in(d_in);
  if ((size_t)out_size != nv::OUT_END) { fprintf(stderr, "bad out size\n"); return; }
#if DIAG
  nv::Ws w = nv::carve((float*)d_ws);
  unsigned char* fws = (unsigned char*)d_ws + ((w.end_floats * 4 + 255) & ~(size_t)255);
  float* out2 = (float*)(fws + fz::W_END); float* acc = out2 + ((nv::OUT_END + 63) & ~(size_t)63);
  const size_t need = (size_t)((unsigned char*)(acc + 256) - (unsigned char*)d_ws);
  if (need > ws_size) { fprintf(stderr, "ws too small: need %zu have %zu\n", need, ws_size); return; }
  (void)hipMemsetAsync(fws + fz::W_CTL, 0, fz::CTL_BYTES, stream);
  (void)hipMemsetAsync(acc, 0, 256 * 4, stream);
  nv::run(stream, in, w, (float*)d_out);
  fz::Params p{}; p.in = in; p.out = out2; p.ws = fws; p.ph_lo = 0; p.ph_hi = DIAG_PH;
  void* args[] = {&p};
  hipError_t e = hipLaunchCooperativeKernel((const void*)fz::mega, dim3(grid), dim3(fz::NTHR), args, fz::LDS_BYTES, stream);
  if (e != hipSuccess) { fprintf(stderr, "coop launch failed: %s\n", hipGetErrorString(e)); return; }
  using namespace fz; using namespace nv;
  auto cmp = [&](int idx, int ph, const float* ref, long ref_ld, const void* tst, int isbf, long tst_ld, int rows, int cols) {
    if (DIAG_PH <= ph) return;
    hipLaunchKernelGGL(dg::k_cmp, dim3(512), dim3(256), 0, stream, ref, ref_ld, tst, isbf, tst_ld, rows, cols, acc + 2 * idx); };
  const float* dout = (const float*)d_out;
  bf16* Z = (bf16*)(fws + W_Z); bf16* XN = (bf16*)(fws + W_XN); bf16* MIXIN = (bf16*)(fws + W_MIXIN); bf16* QB = (bf16*)(fws + W_QBUF);
  cmp(1, 0, w.mod, 6144, fws + W_MOD, 0, 6144, 40, 6144);
  if (DIAG_PH <= 8) cmp(2, 1, w.h, 1024, XN, 1, 1024, MT, 1024);
  cmp(3, 2, w.z, INC, Z, 1, ZW, MT, 1536);
  cmp(3, 2, w.z + O_GR, INC, Z + ZC_GR, 1, ZW, MT, 16);
  cmp(3, 2, w.z + O_CQ, INC, Z + ZC_CQ, 1, ZW, MT, 384);
  cmp(3, 2, w.z + O_CKV, INC, Z + ZC_CKV, 1, ZW, MT, 256);
  cmp(3, 2, w.z + O_KR, INC, Z + ZC_KR, 1, ZW, MT, 64);
  cmp(4, 3, w.cqn, 384, fws + W_CQN, 1, 384, MT, 384);
  cmp(5, 3, w.kcat, 320, fws + W_LATB, 1, 256, MT, 256);
  cmp(6, 3, w.kcat + 256, 320, fws + W_KRB, 1, 64, MT, 64);
  cmp(7, 3, dout + OUT_LATP, 256, out2 + OUT_LATP, 0, 256, MP, 256);
  cmp(8, 3, dout + OUT_KRP, 64, out2 + OUT_KRP, 0, 64, MP, 64);
  cmp(9, 3, dout + OUT_LATS, 256, out2 + OUT_LATS, 0, 256, MS, 256);
  cmp(10, 3, dout + OUT_KRS, 64, out2 + OUT_KRS, 0, 64, MS, 64);
  cmp(11, 3, w.mixin + (size_t)MP * 1024, 1024, MIXIN + (size_t)MP * 1024, 1, 1024, MS, 512);
  cmp(12, 3, dout + OUT_GLAS, 128, out2 + OUT_GLAS, 0, 128, DB * 4 * 64, 128);
  cmp(13, 4, w.qb, 768, QB, 1, QW, MT, 768);
  for (int h = 0; h < 4; ++h) cmp(14, 4, w.qcat + (size_t)MP * 1280 + h * 320, 1280, QB + (size_t)MP * QW + 768 + h * 256, 1, QW, MS, 256);
  cmp(15, 5, dout + OUT_GLAP, 128, out2 + OUT_GLAP, 0, 128, NB * 4 * 64, 128);
  cmp(16, 5, w.mixin + 512, 1024, MIXIN + 512, 1, 1024, MP, 512);
  cmp(17, 6, w.mixin + (size_t)MP * 1024 + 512, 1024, MIXIN + (size_t)MP * 1024 + 512, 1, 1024, MS, 512);
  cmp(18, 6, w.mixin, 1024, MIXIN, 1, 1024, MP, 512);
  if (DIAG_PH <= 11) cmp(19, 7, w.mix, 1024, fws + W_MIX, 0, 1024, MT, 1024);
  cmp(20, 8, w.x1, 1024, fws + W_X1, 0, 1024, MT, 1024);
  cmp(21, 8, w.h2, 1024, XN, 1, 1024, MT, 1024);
  cmp(22, 9, w.u, F2, fws + W_U, 1, F2, MT, F2);
  cmp(23, 9, dout + OUT_CONVP, F2, out2 + OUT_CONVP, 0, F2, NB * 2, F2);
  cmp(24, 9, dout + OUT_CONVS, F2, out2 + OUT_CONVS, 0, F2, DB * 2, F2);
  cmp(25, 10, w.hmid, FF, fws + W_HMID, 1, FF, MT, FF);
  cmp(26, 11, w.y, 1024, fws + W_MIX, 0, 1024, MT, 1024);
  cmp(27, 12, dout + OUT_YP, 1024, out2 + OUT_YP, 0, 1024, MP, 1024);
  cmp(28, 12, dout + OUT_YS, 1024, out2 + OUT_YS, 0, 1024, MS, 1024);
  dg::Tol tol; for (int i = 0; i < dg::NCHK; ++i) tol.t[i] = 0.02f; tol.t[1] = 1e-3f; tol.t[27] = 0.01f; tol.t[28] = 0.01f;
  hipLaunchKernelGGL(dg::k_report, dim3(512), dim3(256), 0, stream, (const float*)acc, (float*)d_out, tol, acc + 128);
#else
  (void)hipMemsetAsync((unsigned char*)d_ws + fz::W_CTL, 0, fz::CTL_BYTES, stream);
  fz::Params p{}; p.in = in; p.out = (float*)d_out; p.ws = (unsigned char*)d_ws; p.ph_lo = 0; p.ph_hi = fz::N_PHASES;
  void* args[] = {&p};
  hipError_t e = hipLaunchCooperativeKernel((const void*)fz::mega, dim3(grid), dim3(fz::NTHR), args, fz::LDS_BYTES, stream);
  if (e != hipSuccess) fprintf(stderr, "coop launch failed: %s\n", hipGetErrorString(e));
#endif
}
```

```cpp
#include <hip/hip_runtime.h>
#include <cstdio>
#include <cmath>
#include <cstdint>
#define DIAG 0
#define DIAG_PH 13
namespace nv {
constexpr int D = 1024, NB = 8, T = 2048, DB = 32, DT = 8, MP = NB * T, MS = DB * DT, MT = MP + MS;
constexpr int INC = 2256, FF = 2816, F2 = 5632, PAST = 16384, NPG = 128;
constexpr int O_QA = 0, O_KA = 256, O_VA = 512, O_RA = 1024, O_GR = 1536, O_CQ = 1552, O_CKV = 1936, O_KR = 2192;
constexpr size_t OUT_YP = 0, OUT_YS = OUT_YP + (size_t)MP * D, OUT_LATP = OUT_YS + (size_t)MS * D, OUT_KRP = OUT_LATP + (size_t)MP * 256,
                 OUT_GLAP = OUT_KRP + (size_t)MP * 64, OUT_CONVP = OUT_GLAP + (size_t)NB * 4 * 64 * 128, OUT_LATS = OUT_CONVP + (size_t)NB * 2 * F2,
                 OUT_KRS = OUT_LATS + (size_t)MS * 256, OUT_GLAS = OUT_KRS + (size_t)MS * 64, OUT_CONVS = OUT_GLAS + (size_t)DB * 4 * 64 * 128,
                 OUT_END = OUT_CONVS + (size_t)DB * 2 * F2;

struct In {
  const float *x_p, *x_s, *c_p, *c_s, *cache_lat, *cache_kr, *state_gla, *state_conv; const int* page_table;
  const float *w_ada, *b_ada, *g_pre_mix, *g_post_mix, *g_pre_ffn, *g_post_ffn, *w_in, *w_gla_a2, *b_gla_a, *g_gla_out, *g_mla_q, *g_mla_kv,
      *w_mla_uq, *w_mla_uk, *w_mla_uv, *g_mla_out, *w_o, *w_ffn_up, *w_ffn_conv, *b_ffn_conv, *w_ffn_down;
};
__host__ inline In make_in(void* const* d) {
  In i;
  i.x_p = (const float*)d[0]; i.x_s = (const float*)d[1]; i.c_p = (const float*)d[2]; i.c_s = (const float*)d[3]; i.cache_lat = (const float*)d[4];
  i.cache_kr = (const float*)d[5]; i.state_gla = (const float*)d[6]; i.state_conv = (const float*)d[7]; i.page_table = (const int*)d[8];
  i.w_ada = (const float*)d[9]; i.b_ada = (const float*)d[10]; i.g_pre_mix = (const float*)d[11]; i.g_post_mix = (const float*)d[12];
  i.g_pre_ffn = (const float*)d[13]; i.g_post_ffn = (const float*)d[14]; i.w_in = (const float*)d[15]; i.w_gla_a2 = (const float*)d[16];
  i.b_gla_a = (const float*)d[17]; i.g_gla_out = (const float*)d[18]; i.g_mla_q = (const float*)d[19]; i.g_mla_kv = (const float*)d[20];
  i.w_mla_uq = (const float*)d[21]; i.w_mla_uk = (const float*)d[22]; i.w_mla_uv = (const float*)d[23]; i.g_mla_out = (const float*)d[24];
  i.w_o = (const float*)d[25]; i.w_ffn_up = (const float*)d[26]; i.w_ffn_conv = (const float*)d[27]; i.b_ffn_conv = (const float*)d[28];
  i.w_ffn_down = (const float*)d[29];
  return i;
}
__device__ __forceinline__ int row_cond(int r) { return r < MP ? r / T : NB + (r - MP) / DT; }
__device__ __forceinline__ int row_pos(int r) { return r < MP ? r % T : PAST + (r - MP) % DT; }
__device__ __forceinline__ const float* row_x(const In& in, int r) { return r < MP ? in.x_p + (size_t)r * D : in.x_s + (size_t)(r - MP) * D; }
__device__ __forceinline__ float silu_f(float v) { return v / (1.f + expf(-v)); }
__device__ __forceinline__ float block_sum(float v, float* red) {
  for (int o = 32; o; o >>= 1) v += __shfl_xor(v, o);
  __syncthreads();
  if ((threadIdx.x & 63) == 0) red[threadIdx.x >> 6] = v;
  __syncthreads();
  float s = 0.f; for (int i = 0; i < (int)(blockDim.x >> 6); ++i) s += red[i];
  return s;
}
__global__ void k_mod(In in, float* mod) {
  const int n = blockIdx.x * 256 + threadIdx.x, r = blockIdx.y;
  const float* c = r < NB ? in.c_p + (size_t)r * D : in.c_s + (size_t)(r - NB) * D;
  float a = in.b_ada[n];
  for (int k = 0; k < D; ++k) a += silu_f(c[k]) * in.w_ada[(size_t)k * 6144 + n];
  mod[(size_t)r * 6144 + n] = a;
}
__global__ void k_norm_mod(In in, const float* src, const float* g, const float* mod, int sh_off, int sc_off, float* out) {
  __shared__ float red[16];
  const int r = blockIdx.x; const float* x = src ? src + (size_t)r * D : row_x(in, r);
  float s = 0.f; for (int k = threadIdx.x; k < D; k += blockDim.x) s += x[k] * x[k];
  s = block_sum(s, red); const float rs = rsqrtf(s / D + 1e-6f);
  const float* m = mod + (size_t)row_cond(r) * 6144;
  for (int k = threadIdx.x; k < D; k += blockDim.x) out[(size_t)r * D + k] = x[k] * rs * g[k] * (1.f + m[sc_off + k]) + m[sh_off + k];
}
struct GemmP { const float* A; const float* B; float* C; int M, N, K, sam, sbk, sbn, ldc, nb2; long sA1, sA2, sB1, sB2, sC1, sC2; };
__global__ void __launch_bounds__(256) k_sgemm(GemmP p) {
  __shared__ float As[16][65], Bs[16][65];
  const int z1 = blockIdx.z / p.nb2, z2 = blockIdx.z % p.nb2;
  const float* A = p.A + z1 * p.sA1 + z2 * p.sA2; const float* B = p.B + z1 * p.sB1 + z2 * p.sB2; float* C = p.C + z1 * p.sC1 + z2 * p.sC2;
  const int m0 = blockIdx.y * 64, n0 = blockIdx.x * 64, tx = threadIdx.x & 15, ty = threadIdx.x >> 4;
  float acc[4][4] = {};
  for (int k0 = 0; k0 < p.K; k0 += 16) {
    for (int i = threadIdx.x; i < 1024; i += 256) {
      { const int m = i >> 4, k = i & 15; As[k][m] = (m0 + m < p.M) ? A[(size_t)(m0 + m) * p.sam + k0 + k] : 0.f; }
      { int k, n; if (p.sbn == 1) { k = i >> 6; n = i & 63; } else { n = i >> 4; k = i & 15; }
        Bs[k][n] = (n0 + n < p.N) ? B[(size_t)(k0 + k) * p.sbk + (size_t)(n0 + n) * p.sbn] : 0.f; }
    }
    __syncthreads();
#pragma unroll
    for (int k = 0; k < 16; ++k) {
      float a[4], b[4];
#pragma unroll
      for (int i = 0; i < 4; ++i) { a[i] = As[k][ty * 4 + i]; b[i] = Bs[k][tx * 4 + i]; }
#pragma unroll
      for (int i = 0; i < 4; ++i)
#pragma unroll
        for (int j = 0; j < 4; ++j) acc[i][j] += a[i] * b[j];
    }
    __syncthreads();
  }
  for (int i = 0; i < 4; ++i) for (int j = 0; j < 4; ++j) { const int m = m0 + ty * 4 + i, n = n0 + tx * 4 + j; if (m < p.M && n < p.N) C[(size_t)m * p.ldc + n] = acc[i][j]; }
}
inline void sgemm(hipStream_t st, const float* A, const float* B, float* C, int M, int N, int K, int sam, int sbk, int sbn, int ldc,
                  int nb1 = 1, int nb2 = 1, long sA1 = 0, long sA2 = 0, long sB1 = 0, long sB2 = 0, long sC1 = 0, long sC2 = 0) {
  GemmP p{A, B, C, M, N, K, sam, sbk, sbn, ldc, nb2, sA1, sA2, sB1, sB2, sC1, sC2};
  hipLaunchKernelGGL(k_sgemm, dim3((N + 63) / 64, (M + 63) / 64, nb1 * nb2), dim3(256), 0, st, p);
}
__device__ __forceinline__ void rope_cs(int pos, int i, float& c, float& s) {
  const float inv = powf(10000.0f, -(float)(2 * i) / 64.0f); const float ang = (float)pos * inv; c = cosf(ang); s = sinf(ang);
}
__global__ void k_zpost(In in, const float* z, float* cqn, float* kcat, float* loga, float* out) {
  __shared__ float red[16];
  const int r = blockIdx.x, t = threadIdx.x; const float* zr = z + (size_t)r * INC;
  { float s = 0.f; for (int k = t; k < 384; k += 256) s += zr[O_CQ + k] * zr[O_CQ + k];
    s = block_sum(s, red); const float rs = rsqrtf(s / 384.f + 1e-6f);
    for (int k = t; k < 384; k += 256) cqn[(size_t)r * 384 + k] = zr[O_CQ + k] * rs * in.g_mla_q[k]; }
  { const float v = zr[O_CKV + t]; float s = block_sum(v * v, red); const float rs = rsqrtf(s / 256.f + 1e-6f);
    const float o = v * rs * in.g_mla_kv[t]; kcat[(size_t)r * 320 + t] = o;
    if (r < MP) out[OUT_LATP + (size_t)r * 256 + t] = o; else out[OUT_LATS + (size_t)(r - MP) * 256 + t] = o; }
  if (t < 32) { float c, s; rope_cs(row_pos(r), t, c, s); const float x1 = zr[O_KR + t], x2 = zr[O_KR + 32 + t];
    const float o1 = x1 * c - x2 * s, o2 = x1 * s + x2 * c; kcat[(size_t)r * 320 + 256 + t] = o1; kcat[(size_t)r * 320 + 288 + t] = o2;
    float* ko = r < MP ? out + OUT_KRP + (size_t)r * 64 : out + OUT_KRS + (size_t)(r - MP) * 64; ko[t] = o1; ko[32 + t] = o2; }
  { float a = in.b_gla_a[t]; for (int j = 0; j < 16; ++j) a += zr[O_GR + j] * in.w_gla_a2[j * 256 + t];
    const float ls = fminf(a, 0.f) - log1pf(expf(-fabsf(a)));
    loga[(size_t)r * 256 + t] = ls / 16.f; }
}
__global__ void k_qrope(const float* qb, float* qcat) {
  const int r = blockIdx.x, h = threadIdx.x >> 5, i = threadIdx.x & 31;
  float c, s; rope_cs(row_pos(r), i, c, s);
  const float x1 = qb[(size_t)r * 768 + h * 192 + 128 + i], x2 = qb[(size_t)r * 768 + h * 192 + 160 + i];
  qcat[(size_t)r * 1280 + h * 320 + 256 + i] = x1 * c - x2 * s; qcat[(size_t)r * 1280 + h * 320 + 288 + i] = x1 * s + x2 * c;
}
__global__ void k_softmax_causal(float* S, float scale) {
  __shared__ float red[16];
  const int t = blockIdx.x; float* row = S + ((size_t)blockIdx.y * T + t) * T;
  float m = -INFINITY; for (int s = threadIdx.x; s <= t; s += blockDim.x) m = fmaxf(m, row[s] * scale);
  for (int o = 32; o; o >>= 1) m = fmaxf(m, __shfl_xor(m, o));
  __syncthreads(); if ((threadIdx.x & 63) == 0) red[threadIdx.x >> 6] = m; __syncthreads();
  for (int i = 0; i < (int)(blockDim.x >> 6); ++i) m = fmaxf(m, red[i]);
  float sum = 0.f; for (int s = threadIdx.x; s < T; s += blockDim.x) { const float e = s <= t ? expf(row[s] * scale - m) : 0.f; row[s] = e; sum += e; }
  sum = block_sum(sum, red); const float inv = 1.f / sum;
  for (int s = threadIdx.x; s < T; s += blockDim.x) row[s] *= inv;
}
constexpr int NKEY = PAST + DT, NKEYP = PAST + 32;
__global__ void __launch_bounds__(256) k_dec_scores(In in, const float* qcat, const float* kcat, float* Ss) {
  __shared__ float Qs[32][320]; __shared__ float Ks[16][321];
  const int b = blockIdx.y, tile = blockIdx.x;
  for (int i = threadIdx.x; i < 32 * 320; i += 256) Qs[i / 320][i % 320] = qcat[(size_t)(MP + b * DT) * 1280 + i];
  const int nsub = tile < NPG ? 8 : 1;
  for (int sub = 0; sub < nsub; ++sub) {
    __syncthreads();
    for (int i = threadIdx.x; i < 16 * 320; i += 256) { const int k = i / 320, d = i % 320; float v;
      if (tile < NPG) { const int pg = in.page_table[b * NPG + tile], rw = sub * 16 + k;
        v = d < 256 ? in.cache_lat[((size_t)pg * 128 + rw) * 256 + d] : in.cache_kr[((size_t)pg * 128 + rw) * 64 + d - 256]; }
      else v = k < DT ? kcat[(size_t)(MP + b * DT + k) * 320 + d] : 0.f;
      Ks[k][d] = v; }
    __syncthreads();
    const int key = threadIdx.x & 15, rg = threadIdx.x >> 4; float a[2] = {0.f, 0.f};
    for (int d = 0; d < 320; ++d) { const float kv = Ks[key][d];
#pragma unroll
      for (int i = 0; i < 2; ++i) a[i] += kv * Qs[rg * 2 + i][d]; }
    const int j = tile * 128 + sub * 16 + key;
    for (int i = 0; i < 2; ++i) Ss[((size_t)b * 32 + rg * 2 + i) * NKEYP + j] = a[i];
  }
}
__global__ void k_dec_softmax(float* Ss, float scale) {
  __shared__ float red[16];
  const int rowi = blockIdx.x, tq = (rowi & 31) >> 2; float* row = Ss + (size_t)rowi * NKEYP; const int nk = PAST + tq + 1;
  float m = -INFINITY; for (int s = threadIdx.x; s < nk; s += blockDim.x) m = fmaxf(m, row[s] * scale);
  for (int o = 32; o; o >>= 1) m = fmaxf(m, __shfl_xor(m, o));
  __syncthreads(); if ((threadIdx.x & 63) == 0) red[threadIdx.x >> 6] = m; __syncthreads();
  for (int i = 0; i < (int)(blockDim.x >> 6); ++i) m = fmaxf(m, red[i]);
  float sum = 0.f; for (int s = threadIdx.x; s < NKEYP; s += blockDim.x) { const float e = s < nk ? expf(row[s] * scale - m) : 0.f; row[s] = e; sum += e; }
  sum = block_sum(sum, red); const float inv = 1.f / sum;
  for (int s = threadIdx.x; s < NKEYP; s += blockDim.x) row[s] *= inv;
}
__global__ void __launch_bounds__(256) k_dec_pv(In in, const float* Ss, const float* kcat, float* olat) {
  __shared__ float Ps[32][129];
  const int b = blockIdx.y, l = blockIdx.x * 64 + (threadIdx.x & 63), rg = threadIdx.x >> 6;
  float a[8] = {};
  for (int tile = 0; tile <= NPG; ++tile) {
    __syncthreads();
    for (int i = threadIdx.x; i < 32 * 128; i += 256) { const int r = i >> 7, k = i & 127, j = tile * 128 + k; Ps[r][k] = j < NKEYP ? Ss[((size_t)b * 32 + r) * NKEYP + j] : 0.f; }
    __syncthreads();
    const int nk = tile < NPG ? 128 : DT; const int pg = tile < NPG ? in.page_table[b * NPG + tile] : 0;
    for (int k = 0; k < nk; ++k) { const float v = tile < NPG ? in.cache_lat[((size_t)pg * 128 + k) * 256 + l] : kcat[(size_t)(MP + b * DT + k) * 320 + l];
#pragma unroll
      for (int i = 0; i < 8; ++i) a[i] += Ps[rg * 8 + i][k] * v; }
  }
  for (int i = 0; i < 8; ++i) { const int r = rg * 8 + i, t = r >> 2, h = r & 3; olat[((size_t)(MP + b * DT + t) * 4 + h) * 256 + l] = a[i]; }
}
__global__ void k_obnorm(In in, const float* ob, float* mixin) {
  const int r = blockIdx.x, h = threadIdx.x >> 6, l = threadIdx.x & 63;
  const float a = ob[(size_t)r * 512 + h * 128 + l], c = ob[(size_t)r * 512 + h * 128 + 64 + l];
  float s = a * a + c * c; for (int o = 32; o; o >>= 1) s += __shfl_xor(s, o);
  const float rs = rsqrtf(s / 128.f + 1e-6f);
  mixin[(size_t)r * D + 512 + h * 128 + l] = a * rs * in.g_mla_out[l]; mixin[(size_t)r * D + 512 + h * 128 + 64 + l] = c * rs * in.g_mla_out[64 + l];
}
__global__ void __launch_bounds__(512) k_gla(In in, const float* z, const float* loga, float* mixin, float* out) {
  __shared__ float part[4][128]; __shared__ float red[16];
  const int bh = blockIdx.x; const bool samp = bh >= NB * 4; const int b = samp ? (bh - NB * 4) >> 2 : bh >> 2, h = bh & 3;
  const int v = threadIdx.x & 127, kq = threadIdx.x >> 7; const int nt = samp ? DT : T; const int r0 = samp ? MP + b * DT : b * T;
  float S[16];
  for (int i = 0; i < 16; ++i) S[i] = samp ? in.state_gla[(((size_t)b * 4 + h) * 64 + kq * 16 + i) * 128 + v] : 0.f;
  for (int t = 0; t < nt; ++t) {
    const float* zr = z + (size_t)(r0 + t) * INC; const float* la = loga + (size_t)(r0 + t) * 256 + h * 64 + kq * 16;
    const float vv = zr[O_VA + h * 128 + v]; float o = 0.f;
    for (int i = 0; i < 16; ++i) { const int k = kq * 16 + i; S[i] = expf(la[i]) * S[i] + zr[O_KA + h * 64 + k] * vv; o += zr[O_QA + h * 64 + k] * 0.125f * S[i]; }
    part[kq][v] = o; __syncthreads();
    float ot = 0.f, sq = 0.f;
    if (kq == 0) { ot = part[0][v] + part[1][v] + part[2][v] + part[3][v]; sq = ot * ot; }
    sq = block_sum(sq, red);
    if (kq == 0) { const float rs = rsqrtf(sq / 128.f + 1e-6f); mixin[(size_t)(r0 + t) * D + h * 128 + v] = ot * rs * in.g_gla_out[v] * silu_f(zr[O_RA + h * 128 + v]); }
    __syncthreads();
  }
  float* so = samp ? out + OUT_GLAS : out + OUT_GLAP;
  for (int i = 0; i < 16; ++i) so[(((size_t)b * 4 + h) * 64 + kq * 16 + i) * 128 + v] = S[i];
}
__global__ void k_resid(In in, const float* xin, const float* y, const float* g, const float* mod, int gate_off, float* dst, float* out) {
  __shared__ float red[16];
  const int r = blockIdx.x; const float* x = xin ? xin + (size_t)r * D : row_x(in, r); const float* yr = y + (size_t)r * D;
  float s = 0.f; for (int k = threadIdx.x; k < D; k += blockDim.x) s += yr[k] * yr[k];
  s = block_sum(s, red); const float rs = rsqrtf(s / D + 1e-6f);
  const float* m = mod + (size_t)row_cond(r) * 6144 + gate_off;
  float* o = dst ? dst + (size_t)r * D : (r < MP ? out + OUT_YP + (size_t)r * D : out + OUT_YS + (size_t)(r - MP) * D);
  for (int k = threadIdx.x; k < D; k += blockDim.x) o[k] = x[k] + m[k] * yr[k] * rs * g[k];
}
__device__ __forceinline__ float gelu_tanh(float x) { return 0.5f * x * (1.f + tanhf(0.7978845608028654f * (x + 0.044715f * x * x * x))); }
__global__ void k_convgelu(In in, const float* u, float* hmid, float* out) {
  const int r = blockIdx.x; const bool samp = r >= MP; const int t = samp ? (r - MP) % DT : r % T, b = samp ? (r - MP) / DT : r / T;
  for (int f = threadIdx.x; f < FF; f += blockDim.x) {
    float uc[2];
    for (int half = 0; half < 2; ++half) { const int c = f + half * FF; float a = in.b_ffn_conv[c];
      for (int j = 0; j < 3; ++j) { const int tt = t - 2 + j; float val;
        if (tt >= 0) val = u[(size_t)(r - 2 + j) * F2 + c]; else val = samp ? in.state_conv[((size_t)b * 2 + (tt + 2)) * F2 + c] : 0.f;
        a += in.w_ffn_conv[j * F2 + c] * val; }
      uc[half] = a; }
    hmid[(size_t)r * FF + f] = uc[0] * gelu_tanh(uc[1]);
  }
  const int nt = samp ? DT : T;
  if (t >= nt - 2) { float* co = samp ? out + OUT_CONVS + ((size_t)b * 2 + (t - (nt - 2))) * F2 : out + OUT_CONVP + ((size_t)b * 2 + (t - (nt - 2))) * F2;
    for (int c = threadIdx.x; c < F2; c += blockDim.x) co[c] = u[(size_t)r * F2 + c]; }
}

struct Ws { float *mod, *h, *h2, *z, *cqn, *kcat, *loga, *qb, *qcat, *S, *olat, *ob, *mixin, *mix, *x1, *u, *hmid, *y, *Ss; size_t end_floats; };
inline Ws carve(float* base) {
  Ws w; size_t o = 0; auto take = [&](size_t n) { float* p = base + o; o += (n + 63) & ~(size_t)63; return p; };
  w.mod = take(40 * 6144); w.h = take((size_t)MT * D); w.h2 = take((size_t)MT * D); w.z = take((size_t)MT * INC); w.cqn = take((size_t)MT * 384); w.kcat = take((size_t)MT * 320);
  w.loga = take((size_t)MT * 256); w.qb = take((size_t)MT * 768); w.qcat = take((size_t)MT * 1280); w.S = take((size_t)4 * T * T);
  w.olat = take((size_t)MT * 1024); w.ob = take((size_t)MT * 512); w.mixin = take((size_t)MT * D); w.mix = take((size_t)MT * D); w.x1 = take((size_t)MT * D);
  w.u = take((size_t)MT * F2); w.hmid = take((size_t)MT * FF); w.y = take((size_t)MT * D); w.Ss = take((size_t)DB * 32 * NKEYP); w.end_floats = o;
  return w;
}

inline void run(hipStream_t st, const In& in, const Ws& w, float* out) {
  const float sc = 0.07216878364870322f;
  hipLaunchKernelGGL(k_mod, dim3(24, 40), dim3(256), 0, st, in, w.mod);
  hipLaunchKernelGGL(k_norm_mod, dim3(MT), dim3(256), 0, st, in, (const float*)nullptr, in.g_pre_mix, (const float*)w.mod, 0, 1024, w.h);
  sgemm(st, w.h, in.w_in, w.z, MT, INC, D, D, INC, 1, INC);
  hipLaunchKernelGGL(k_zpost, dim3(MT), dim3(256), 0, st, in, (const float*)w.z, w.cqn, w.kcat, w.loga, out);
  sgemm(st, w.cqn, in.w_mla_uq, w.qb, MT, 768, 384, 384, 768, 1, 768);
  hipLaunchKernelGGL(k_qrope, dim3(MT), dim3(128), 0, st, (const float*)w.qb, w.qcat);
  sgemm(st, w.qb, in.w_mla_uk, w.qcat, MT, 256, 128, 768, 1, 512, 1280, 1, 4, 0, 192, 0, 128, 0, 320);
  for (int b = 0; b < NB; ++b) {
    sgemm(st, w.qcat + (size_t)b * T * 1280, w.kcat + (size_t)b * T * 320, w.S, T, T, 320, 1280, 1, 320, T, 1, 4, 0, 320, 0, 0, 0, (long)T * T);
    hipLaunchKernelGGL(k_softmax_causal, dim3(T, 4), dim3(256), 0, st, w.S, sc);
    sgemm(st, w.S, w.kcat + (size_t)b * T * 320, w.olat + (size_t)b * T * 1024, T, 256, T, T, 320, 1, 1024, 1, 4, 0, (long)T * T, 0, 0, 0, 256);
  }
  hipLaunchKernelGGL(k_dec_scores, dim3(NPG + 1, DB), dim3(256), 0, st, in, (const float*)w.qcat, (const float*)w.kcat, w.Ss);
  hipLaunchKernelGGL(k_dec_softmax, dim3(DB * 32), dim3(256), 0, st, w.Ss, sc);
  hipLaunchKernelGGL(k_dec_pv, dim3(4, DB), dim3(256), 0, st, in, (const float*)w.Ss, (const float*)w.kcat, w.olat);
  sgemm(st, w.olat, in.w_mla_uv, w.ob, MT, 128, 256, 1024, 512, 1, 512, 1, 4, 0, 256, 0, 128, 0, 128);
  hipLaunchKernelGGL(k_obnorm, dim3(MT), dim3(256), 0, st, in, (const float*)w.ob, w.mixin);
  hipLaunchKernelGGL(k_gla, dim3(NB * 4 + DB * 4), dim3(512), 0, st, in, (const float*)w.z, (const float*)w.loga, w.mixin, out);
  sgemm(st, w.mixin, in.w_o, w.mix, MT, D, D, D, D, 1, D);
  hipLaunchKernelGGL(k_resid, dim3(MT), dim3(256), 0, st, in, (const float*)nullptr, (const float*)w.mix, in.g_post_mix, (const float*)w.mod, 2048, w.x1, out);
  hipLaunchKernelGGL(k_norm_mod, dim3(MT), dim3(256), 0, st, in, (const float*)w.x1, in.g_pre_ffn, (const float*)w.mod, 3072, 4096, w.h2);
  sgemm(st, w.h2, in.w_ffn_up, w.u, MT, F2, D, D, F2, 1, F2);
  hipLaunchKernelGGL(k_convgelu, dim3(MT), dim3(256), 0, st, in, (const float*)w.u, w.hmid, out);
  sgemm(st, w.hmid, in.w_ffn_down, w.y, MT, D, FF, FF, D, 1, D);
  hipLaunchKernelGGL(k_resid, dim3(MT), dim3(256), 0, st, in, (const float*)w.x1, (const float*)w.y, in.g_post_ffn, (const float*)w.mod, 5120, (float*)nullptr, out);
}
}
namespace pg8 {
#define PG8_LAS __attribute__((address_space(3)))
typedef unsigned short bf16_t;
typedef short bf16x8 __attribute__((ext_vector_type(8)));
typedef float f32x4 __attribute__((ext_vector_type(4)));
typedef unsigned u32x4 __attribute__((ext_vector_type(4)));
constexpr int BM = 256, BK = 64, HALF = 128, HTB = HALF * BK * 2  , STAGE_BYTES = 8 * HTB, NXCD = 8, WGM = 8;

__host__ __device__ __forceinline__ int lds_byte(int r, int c) { const int st = (r >> 4) * 2 + (c >> 5), rr = r & 15, cc = c & 31, ob = rr * 64 + cc * 2; return st * 1024 + (ob ^ (((ob >> 9) & 1) << 5)); }
__host__ __device__ __forceinline__ void stage_rc(int b, int& R, int& C) { const int st = b / 1024, sb = b % 1024, swz = sb ^ (((sb >> 9) & 1) << 5); R = (st >> 1) * 16 + swz / 64; C = (st & 1) * 32 + (swz % 64) / 2; }
__host__ __device__ __forceinline__ int perm32(int rho) { const int n = rho >> 4, i = rho & 15; return 8 * (i >> 2) + 4 * n + (i & 3); }

struct Unit { int pm, pn, kk; };
struct Gemm { const bf16_t* A; const bf16_t* Bt; int lda, ldb, K; };
__device__ __forceinline__ unsigned cvt_pk_bf16(float lo, float hi) { unsigned r; asm volatile("v_cvt_pk_bf16_f32 %0, %1, %2" : "=v"(r) : "v"(lo), "v"(hi)); return r; }
typedef float f32x2 __attribute__((ext_vector_type(2)));
template <class Epi, class Sched, bool ALIGN_EPI = false, bool SP2 = false>
__device__ __forceinline__ void gemm_phase(PG8_LAS unsigned char* lds, const Gemm g, const Sched& S, const Epi& E) {
    const int tid = threadIdx.x, wid = __builtin_amdgcn_readfirstlane(tid >> 6), lane = tid & 63, wr = wid >> 2, wc = wid & 3, fr = lane & 15, fq = lane >> 4;
    int K = g.K; asm volatile("" : "+s"(K)); const int nt = K / BK;
    unsigned voffA[2], voffB[2];
#pragma unroll
    for (int i = 0; i < 2; ++i) { int R, C; stage_rc(tid * 16 + i * 8192, R, C); const int Rb = Epi::PERM ? ((R & ~31) + perm32(R & 31)) : R;
        voffA[i] = (unsigned)(R * g.lda + C) * 2u; voffB[i] = (unsigned)(Rb * g.ldb + C) * 2u; }
    const size_t kstep = (size_t)(BK * 2);
    const size_t hstepA = (size_t)HALF * g.lda * 2, hstepB = (size_t)HALF * g.ldb * 2;
    const size_t tstepA = 2 * hstepA, tstepB = 2 * hstepB;
    const unsigned ldsw = (unsigned)wid * 1024u;
    const int aoff = lds_byte(wr * 64 + fr, fq * 8), boff = lds_byte(wc * 32 + fr, fq * 8);
#define PG8_SA(b, h) (((b) * 2 + (h)) * HTB)
#define PG8_SB(b, h) ((4 + (b) * 2 + (h)) * HTB)
#define PG8_STAGE(bufoff, gbase, voff) do { _Pragma("unroll") for (int _i = 0; _i < 2; ++_i) \
        __builtin_amdgcn_global_load_lds((const unsigned*)((const char*)(gbase) + (voff)[_i]), (PG8_LAS unsigned*)(lds + (bufoff) + ldsw + _i * 8192), 16, 0, 0); } while (0)
#define PG8_LDA(dst, b, h) do { _Pragma("unroll") for (int m = 0; m < 4; ++m) _Pragma("unroll") for (int k = 0; k < 2; ++k) dst[m][k] = *(const PG8_LAS bf16x8*)(lds + PG8_SA(b, h) + aoff + m * 2048 + k * 1024); } while (0)
#define PG8_LDB(dst, b, h) do { _Pragma("unroll") for (int n = 0; n < 2; ++n) _Pragma("unroll") for (int k = 0; k < 2; ++k) dst[n][k] = *(const PG8_LAS bf16x8*)(lds + PG8_SB(b, h) + boff + n * 2048 + k * 1024); } while (0)
#define PG8_MMA(ai, bj, At, Bt) do { __builtin_amdgcn_s_setprio(1); _Pragma("unroll") for (int m = 0; m < 4; ++m) _Pragma("unroll") for (int n = 0; n < 2; ++n) _Pragma("unroll") for (int k = 0; k < 2; ++k) \
        acc[ai][bj][m][n] = __builtin_amdgcn_mfma_f32_16x16x32_bf16(Bt[n][k], At[m][k], acc[ai][bj][m][n], 0, 0, 0); __builtin_amdgcn_s_setprio(0); } while (0)
#define PG8_WAIT_V(n) asm volatile("s_waitcnt vmcnt(" #n ")" ::: "memory")
#define PG8_WAIT_L(n) asm volatile("s_waitcnt lgkmcnt(" #n ")" ::: "memory")
#define PG8_BAR __builtin_amdgcn_s_barrier()
#define PG8_SCHED __builtin_amdgcn_sched_barrier(0)
    Unit cur, nxt; int ui = 0;
    if (!S.next(0, cur)) return;
    f32x4 acc[2][2][4][2];
#pragma unroll
    for (int a = 0; a < 2; ++a)
#pragma unroll
        for (int b = 0; b < 2; ++b)
#pragma unroll
            for (int m = 0; m < 4; ++m)
#pragma unroll
                for (int n = 0; n < 2; ++n) acc[a][b][m][n] = (f32x4){0.f, 0.f, 0.f, 0.f};
    bf16x8 At[4][2], B0[2][2], B1[2][2];
    const char* cA = (const char*)g.A + (size_t)cur.pm * tstepA + (size_t)cur.kk * K * 2; const char* cB = (const char*)g.Bt + (size_t)cur.pn * tstepB + (size_t)cur.kk * K * 2;
    S.a_ready(cur);
    if constexpr (SP2) {
        PG8_STAGE(PG8_SB(0, 0), cB, voffB); PG8_STAGE(PG8_SB(0, 1), cB + hstepB, voffB); PG8_STAGE(PG8_SA(0, 0), cA, voffA); PG8_STAGE(PG8_SA(0, 1), cA + hstepA, voffA);
        if (wr == 1) PG8_BAR;
        PG8_WAIT_V(2); PG8_BAR;
        PG8_STAGE(PG8_SB(1, 0), cB + kstep, voffB); PG8_STAGE(PG8_SA(1, 0), cA + kstep, voffA); PG8_STAGE(PG8_SB(1, 1), cB + hstepB + kstep, voffB);
        PG8_WAIT_V(6); PG8_BAR;
    } else {
        PG8_STAGE(PG8_SB(0, 0), cB, voffB); PG8_STAGE(PG8_SA(0, 0), cA, voffA); PG8_STAGE(PG8_SB(0, 1), cB + hstepB, voffB); PG8_STAGE(PG8_SA(0, 1), cA + hstepA, voffA);
        if (wr == 1) PG8_BAR;
        PG8_WAIT_V(4); PG8_BAR;
        PG8_STAGE(PG8_SB(1, 0), cB + kstep, voffB); PG8_STAGE(PG8_SA(1, 0), cA + kstep, voffA); PG8_STAGE(PG8_SB(1, 1), cB + hstepB + kstep, voffB);
        PG8_WAIT_V(6); PG8_BAR;
    }
    for (;;) {
        const bool has_next = S.next(ui + 1, nxt);
        const char* nA = has_next ? (const char*)g.A + (size_t)nxt.pm * tstepA + (size_t)nxt.kk * K * 2 : cA; const char* nB = has_next ? (const char*)g.Bt + (size_t)nxt.pn * tstepB + (size_t)nxt.kk * K * 2 : cB;
        for (int t = 0; t < nt; t += 2) {
            const bool last = (t == nt - 2);
            const char* a1 = cA + (size_t)(t + 1) * kstep;
            const char* a2 = last ? nA : cA + (size_t)(t + 2) * kstep; const char* b2 = last ? nB : cB + (size_t)(t + 2) * kstep;
            const char* a3 = a2 + kstep; const char* b3 = b2 + kstep;
            if (last && has_next) S.a_ready(nxt);
            if constexpr (SP2) {
            PG8_LDB(B0, 0, 0); PG8_LDB(B1, 0, 1); PG8_SCHED; PG8_LDA(At, 0, 0); PG8_STAGE(PG8_SA(1, 1), a1 + hstepA, voffA);
            PG8_WAIT_V(8); PG8_WAIT_L(0); PG8_BAR; PG8_MMA(0, 0, At, B0); PG8_MMA(0, 1, At, B1); PG8_BAR; PG8_SCHED;
            PG8_LDA(At, 0, 1); PG8_STAGE(PG8_SB(0, 0), b2, voffB); PG8_STAGE(PG8_SB(0, 1), b2 + hstepB, voffB); PG8_STAGE(PG8_SA(0, 0), a2, voffA);
            PG8_WAIT_V(8); PG8_WAIT_L(0); PG8_BAR; PG8_MMA(1, 0, At, B0); PG8_MMA(1, 1, At, B1); PG8_BAR; PG8_SCHED;
            PG8_LDB(B0, 1, 0); PG8_LDB(B1, 1, 1); PG8_SCHED; PG8_LDA(At, 1, 0); PG8_STAGE(PG8_SA(0, 1), a2 + hstepA, voffA);
            PG8_WAIT_V(8); PG8_WAIT_L(0); PG8_BAR; PG8_MMA(0, 0, At, B0); PG8_MMA(0, 1, At, B1); PG8_BAR; PG8_SCHED;
            PG8_LDA(At, 1, 1); PG8_STAGE(PG8_SB(1, 0), b3, voffB); PG8_STAGE(PG8_SB(1, 1), b3 + hstepB, voffB); PG8_STAGE(PG8_SA(1, 0), a3, voffA);
            PG8_WAIT_V(8); PG8_WAIT_L(0); PG8_BAR; PG8_MMA(1, 0, At, B0); PG8_MMA(1, 1, At, B1); PG8_BAR; PG8_SCHED;
            } else {
            PG8_LDB(B0, 0, 0); PG8_SCHED; PG8_LDA(At, 0, 0); PG8_STAGE(PG8_SA(1, 1), a1 + hstepA, voffA);
            PG8_WAIT_L(8); PG8_BAR; PG8_WAIT_L(0); PG8_MMA(0, 0, At, B0); PG8_BAR; PG8_SCHED;
            PG8_LDB(B1, 0, 1); PG8_STAGE(PG8_SB(0, 0), b2, voffB);
            PG8_BAR; PG8_WAIT_L(0); PG8_MMA(0, 1, At, B1); PG8_BAR;
            PG8_LDA(At, 0, 1); PG8_STAGE(PG8_SA(0, 0), a2, voffA);
            PG8_BAR; PG8_WAIT_L(0); PG8_MMA(1, 0, At, B0); PG8_BAR; PG8_SCHED;
            PG8_STAGE(PG8_SB(0, 1), b2 + hstepB, voffB);
            PG8_WAIT_V(6); PG8_BAR; PG8_MMA(1, 1, At, B1); PG8_BAR;
            PG8_LDB(B0, 1, 0); PG8_SCHED; PG8_LDA(At, 1, 0); PG8_STAGE(PG8_SA(0, 1), a2 + hstepA, voffA);
            PG8_WAIT_L(8); PG8_BAR; PG8_WAIT_L(0); PG8_MMA(0, 0, At, B0); PG8_BAR; PG8_SCHED;
            PG8_LDB(B1, 1, 1); PG8_STAGE(PG8_SB(1, 0), b3, voffB);
            PG8_BAR; PG8_WAIT_L(0); PG8_MMA(0, 1, At, B1); PG8_BAR;
            PG8_LDA(At, 1, 1); PG8_STAGE(PG8_SA(1, 0), a3, voffA);
            PG8_BAR; PG8_WAIT_L(0); PG8_MMA(1, 0, At, B0); PG8_BAR; PG8_SCHED;
            PG8_STAGE(PG8_SB(1, 1), b3 + hstepB, voffB);
            PG8_WAIT_V(6); PG8_BAR; PG8_MMA(1, 1, At, B1); PG8_BAR;
            }
        }
        if constexpr (ALIGN_EPI) { if (wr == 0) PG8_BAR; }
        if constexpr (!Epi::AFTER_DRAIN) { E(acc, cur, wr, wc, fr, fq); S.done(cur); }
        if (!has_next) break;
#pragma unroll
        for (int a = 0; a < 2; ++a)
#pragma unroll
            for (int b = 0; b < 2; ++b)
#pragma unroll
                for (int m = 0; m < 4; ++m)
#pragma unroll
                    for (int n = 0; n < 2; ++n) acc[a][b][m][n] = (f32x4){0.f, 0.f, 0.f, 0.f};
        cur = nxt; cA = nA; cB = nB; ++ui;
        if constexpr (ALIGN_EPI) { if (wr == 1) PG8_BAR; }
    }
    PG8_WAIT_V(0);
    if constexpr (!ALIGN_EPI) { if (wr == 0) PG8_BAR; }
    PG8_BAR;
    if constexpr (Epi::AFTER_DRAIN) { E.fused(acc, cur, wr, wc, fr, fq, lds, wid, lane); S.done(cur); }
#undef PG8_SA
#undef PG8_SB
#undef PG8_STAGE
#undef PG8_LDA
#undef PG8_LDB
#undef PG8_MMA
#undef PG8_WAIT_V
#undef PG8_WAIT_L
#undef PG8_BAR
#undef PG8_SCHED
}
}
namespace fz {
using nv::In;
using nv::D; using nv::NB; using nv::T; using nv::DB; using nv::DT; using nv::MP; using nv::MS; using nv::MT; using nv::FF; using nv::F2; using nv::PAST; using nv::NPG;
#define GAS __attribute__((address_space(1)))
#define LAS __attribute__((address_space(3)))
typedef unsigned short bf16;
typedef unsigned v4u __attribute__((ext_vector_type(4)));
typedef unsigned v2u __attribute__((ext_vector_type(2)));
typedef float f32x4 __attribute__((ext_vector_type(4)));
typedef float f32x2 __attribute__((ext_vector_type(2)));
typedef float f32x16 __attribute__((ext_vector_type(16)));
typedef short bf16x8 __attribute__((ext_vector_type(8)));
typedef short s16x4 __attribute__((ext_vector_type(4)));
typedef GAS unsigned gu32;
#define RLX_AGENT __ATOMIC_RELAXED, __HIP_MEMORY_SCOPE_AGENT
#define LDS_WAIT() asm volatile("s_waitcnt lgkmcnt(0)" ::: "memory")

constexpr int NWAVES = 8, NTHR = 512;
constexpr int ZW = 2304;
constexpr int ZC_QA = 0, ZC_KA = 256, ZC_VA = 512, ZC_RA = 1024, ZC_CKV = 1536, ZC_CQ = 1792, ZC_KR = 2176, ZC_GR = 2240;
constexpr int QW = 1792;
constexpr int NSPLIT = 8;
constexpr float C2 = 0.07216878364870322f * 1.4426950408889634f;

constexpr size_t al256(size_t x) { return (x + 255) & ~(size_t)255; }
constexpr size_t W_CTL = 0, CTL_BYTES = 1u << 20;
constexpr size_t W_MOD = W_CTL + CTL_BYTES;
constexpr size_t W_ROPE = W_MOD + al256((size_t)40 * 6144 * 4);
constexpr size_t W_WIN = W_ROPE + al256((size_t)2056 * 32 * 8);
constexpr size_t W_WQ = W_WIN + al256((size_t)ZW * 1024 * 2);
constexpr size_t W_WKV = W_WQ + al256((size_t)QW * 384 * 2);
constexpr size_t W_WO = W_WKV + al256((size_t)1024 * 256 * 2);
constexpr size_t W_WUP = W_WO + al256((size_t)1024 * 1024 * 2);
constexpr size_t W_WDN = W_WUP + al256((size_t)F2 * 1024 * 2);
constexpr size_t W_XN = W_WDN + al256((size_t)1024 * FF * 2);
constexpr size_t W_Z = W_XN + al256((size_t)MT * 1024 * 2);
constexpr size_t W_CQN = W_Z + al256((size_t)MT * ZW * 2);
constexpr size_t W_LATB = W_CQN + al256((size_t)MT * 384 * 2);
constexpr size_t W_KRB = W_LATB + al256((size_t)MT * 256 * 2);
constexpr size_t W_QD = W_KRB + al256((size_t)MT * 64 * 2);
constexpr size_t W_KD = W_QD + al256((size_t)MP * 256 * 2);
constexpr size_t W_KLT = W_KD + al256((size_t)MP * 256 * 2);
constexpr size_t W_VT = W_KLT + al256((size_t)MP * 256 * 2);
constexpr size_t W_DCH = W_VT + al256((size_t)MP * 512 * 2);
constexpr size_t W_UT = W_DCH + al256((size_t)NB * 32 * 256 * 4);
constexpr size_t W_ST = W_UT + al256((size_t)NB * 4 * 32 * 8192 * 4);
constexpr size_t W_QBUF = W_ST + al256((size_t)NB * 4 * 32 * 8192 * 2);
constexpr size_t W_KCOMB = W_QBUF + al256((size_t)MT * QW * 2);
constexpr size_t W_VB = W_KCOMB + al256((size_t)NB * 4 * T * 200 * 2);
constexpr size_t W_DPO = W_VB + al256((size_t)MP * 512 * 2);
constexpr size_t W_DPML = W_DPO + al256((size_t)DB * NSPLIT * 32 * 256 * 4);
constexpr size_t W_MIXIN = W_DPML + al256((size_t)DB * NSPLIT * 2 * 32 * 4);
constexpr size_t W_MIX = W_MIXIN + al256((size_t)MT * 1024 * 2);
constexpr size_t W_X1 = W_MIX + al256((size_t)MT * 1024 * 4);
constexpr size_t W_U = W_X1 + al256((size_t)MT * 1024 * 4);
constexpr size_t W_HMID = W_U + al256((size_t)MT * F2 * 2);
constexpr size_t W_MIXP = W_HMID + al256((size_t)MT * FF * 2);
constexpr size_t W_END = W_MIXP + al256((size_t)11 * 256 * 1024 * 4);

constexpr int CW_BAR = 4096, CW_Q5 = 64;

constexpr int RING_BYTES = 131072, LDSCTL_OFF = RING_BYTES, MISC_OFF = LDSCTL_OFF + 320, LDS_BYTES = 147456;

__device__ __forceinline__ unsigned f2bf(float f) { unsigned u = __builtin_bit_cast(unsigned, f); return (u + 0x7fffu + ((u >> 16) & 1u)) >> 16; }
__device__ __forceinline__ unsigned pk2(float lo, float hi) { return f2bf(lo) | (f2bf(hi) << 16); }
__device__ __forceinline__ float bf2f(unsigned b) { return __builtin_bit_cast(float, b << 16); }
__device__ __forceinline__ float bflo(unsigned w) { return __builtin_bit_cast(float, w << 16); }
__device__ __forceinline__ float bfhi(unsigned w) { return __builtin_bit_cast(float, w & 0xffff0000u); }
__device__ __forceinline__ float wave_sum(float v) {
#pragma unroll
  for (int o = 1; o < 64; o <<= 1) v += __shfl_xor(v, o);
  return v;
}
__device__ __forceinline__ float silu_f(float v) { return v / (1.f + __expf(-v)); }

#define XB_TMO      128
#define XB_XCNT(j)  (256  + 64 * (j))
#define XB_XSUB(j)  (1280 + 64 * (j))
#define XB_XGEN(j)  (2304 + 64 * (j))
#define XB_TOP      3328
#define XB_TOPGEN   3392
#define XCD_BAR_WORDS 3456
#define XB_SPIN_CAP (1u << 22)
__device__ __forceinline__ unsigned xb_ld(unsigned* p)              { return __hip_atomic_load(p, __ATOMIC_RELAXED, __HIP_MEMORY_SCOPE_AGENT); }
__device__ __forceinline__ unsigned xb_add(unsigned* p, unsigned v) { return __hip_atomic_fetch_add(p, v, __ATOMIC_RELAXED, __HIP_MEMORY_SCOPE_AGENT); }
__device__ __forceinline__ unsigned xb_xcc_id() { return (unsigned)__builtin_amdgcn_s_getreg((3 << 11) | 20) & 0xFu; }
#define XB_SPIN(cond, bar) do { unsigned _sp = 0; while (cond) { __builtin_amdgcn_s_sleep(1); \
    if ((++_sp & 255u) == 0u) { if (xb_ld(&(bar)[XB_TMO])) break; if (_sp > XB_SPIN_CAP) { atomicAdd(&(bar)[XB_TMO], 1u); break; } } } } while (0)
struct XcdBarrier { unsigned* bar; unsigned x; volatile LAS unsigned* st; };
__device__ __forceinline__ XcdBarrier xcd_barrier_post(unsigned* bar, volatile LAS unsigned* st) {
    XcdBarrier b; b.bar = bar; b.x = xb_xcc_id(); b.st = st;
    if (threadIdx.x == 0) (void)xb_add(&bar[XB_XCNT(b.x)], 1u);
    return b;
}
__device__ __forceinline__ void xcd_barrier_complete(unsigned* bar, unsigned x, unsigned& nloc, unsigned& nx) {
    const unsigned G = gridDim.x * gridDim.y * gridDim.z;
    unsigned sum, cnt, mine, sp = 0u;
    for (;;) {
        sum = 0u; cnt = 0u; mine = 0u;
#pragma unroll
        for (unsigned j = 0; j < 16; ++j) { const unsigned c = xb_ld(&bar[XB_XCNT(j)]); sum += c; cnt += (c > 0u) ? 1u : 0u; mine = (j == x) ? c : mine; }
        if (sum == G) break;
        __builtin_amdgcn_s_sleep(1);
        if ((++sp & 255u) == 0u) { if (xb_ld(&bar[XB_TMO])) break; if (sp > XB_SPIN_CAP) { atomicAdd(&bar[XB_TMO], 1u); break; } }
    }
    nloc = mine > 0u ? mine : 1u; nx = cnt > 0u ? cnt : 1u;
}
__device__ __forceinline__ void xcd_barrier(const XcdBarrier& b) {
    asm volatile("s_waitcnt vmcnt(0)" ::: "memory");
    __syncthreads();
    if (threadIdx.x == 0) {
        unsigned* bar = b.bar;
        __builtin_amdgcn_s_waitcnt(0);
        unsigned nloc = b.st[0], nx = b.st[1];
        if (nloc == 0u) { xcd_barrier_complete(bar, b.x, nloc, nx); b.st[0] = nloc; b.st[1] = nx; }
        const unsigned old = xb_add(&bar[XB_XSUB(b.x)], 1u);
        const unsigned gen = old / nloc;
        if (old + 1u == (gen + 1u) * nloc) {
            __builtin_amdgcn_fence(__ATOMIC_RELEASE, "agent");
            asm volatile("s_waitcnt vmcnt(0)" ::: "memory");
            const unsigned og = xb_add(&bar[XB_TOP], 1u);
            const unsigned tg = og / nx;
            if (og + 1u == (tg + 1u) * nx) xb_add(&bar[XB_TOPGEN], 1u);
            else XB_SPIN(xb_ld(&bar[XB_TOPGEN]) == tg, bar);
            __builtin_amdgcn_fence(__ATOMIC_ACQUIRE, "agent");
            xb_add(&bar[XB_XGEN(b.x)], 1u);
            asm volatile("s_waitcnt vmcnt(0)" ::: "memory");
        } else {
            XB_SPIN(xb_ld(&bar[XB_XGEN(b.x)]) == gen, bar);
            __builtin_amdgcn_fence(__ATOMIC_ACQUIRE, "agent");
            asm volatile("s_waitcnt vmcnt(0)" ::: "memory");
        }
    }
    __syncthreads();
}

struct Params { In in; float* out; unsigned char* ws; int ph_lo, ph_hi, repmask, pad; };
struct Frame {
  LAS unsigned char* lds;
  int tid, lane, wave, G, bid;
  const Params* P;
#define FZ_ACC(T_, name, off) __device__ __forceinline__ T_* name() const { return (T_*)(P->ws + (off)); }
  FZ_ACC(float, mod, W_MOD) FZ_ACC(f32x2, rope, W_ROPE) FZ_ACC(bf16, win_t, W_WIN) FZ_ACC(bf16, wq_t, W_WQ) FZ_ACC(bf16, wkv_t, W_WKV) FZ_ACC(bf16, wo_t, W_WO)
  FZ_ACC(bf16, wup_t, W_WUP) FZ_ACC(bf16, wdn_t, W_WDN) FZ_ACC(bf16, xn, W_XN) FZ_ACC(bf16, z, W_Z) FZ_ACC(bf16, cqn, W_CQN) FZ_ACC(bf16, latb, W_LATB) FZ_ACC(bf16, krb, W_KRB)
  FZ_ACC(bf16, qd, W_QD) FZ_ACC(bf16, kd, W_KD) FZ_ACC(bf16, klt, W_KLT) FZ_ACC(bf16, vt, W_VT) FZ_ACC(float, dch, W_DCH) FZ_ACC(float, ut, W_UT) FZ_ACC(bf16, st, W_ST)
  FZ_ACC(bf16, qbuf, W_QBUF) FZ_ACC(bf16, kcomb, W_KCOMB) FZ_ACC(bf16, vb, W_VB) FZ_ACC(float, dpo, W_DPO) FZ_ACC(float, dpml, W_DPML) FZ_ACC(bf16, mixin, W_MIXIN)
  FZ_ACC(float, mix, W_MIX) FZ_ACC(float, mixp, W_MIXP) FZ_ACC(float, x1, W_X1) FZ_ACC(bf16, u, W_U) FZ_ACC(bf16, hmid, W_HMID)
#undef FZ_ACC
};
__device__ __forceinline__ int cond_row(int r) { return r < MP ? (r >> 11) : NB + ((r - MP) >> 3); }
__device__ __forceinline__ int pos_idx(int r) { return r < MP ? (r & 2047) : 2048 + ((r - MP) & 7); }
__device__ __forceinline__ const float* x_row(const In& in, int r) { return r < MP ? in.x_p + (size_t)r * D : in.x_s + (size_t)(r - MP) * D; }
__device__ __forceinline__ float* y_row(float* out, int r) { return r < MP ? out + nv::OUT_YP + (size_t)r * D : out + nv::OUT_YS + (size_t)(r - MP) * D; }

__device__ __forceinline__ void p0_mod_unit(const Frame& F, int u) {
  LAS float* sc = (LAS float*)F.lds; LAS float* red = sc + 20 * 1024;
  const int tid = F.tid, cc = u >> 1, rh = u & 1, n0 = cc * 32;
  __syncthreads();
  for (int i = tid; i < 20 * 1024; i += NTHR) { const int cr = rh * 20 + (i >> 10), k = i & 1023;
    const float v = cr < NB ? F.P->in.c_p[cr * D + k] : F.P->in.c_s[(cr - NB) * D + k]; sc[i] = v / (1.f + expf(-v)); }
  __syncthreads();
  const int kg = tid >> 5, c = tid & 31;
  float acc[20];
#pragma unroll
  for (int r = 0; r < 20; ++r) acc[r] = 0.f;
#pragma unroll 1
  for (int hb = 0; hb < 4; ++hb) { float wv[16];
#pragma unroll
    for (int i = 0; i < 16; ++i) wv[i] = F.P->in.w_ada[(size_t)(kg + 16 * (16 * hb + i)) * 6144 + n0 + c];
#pragma unroll
    for (int i = 0; i < 16; ++i) { const int k = kg + 16 * (16 * hb + i);
#pragma unroll
      for (int r = 0; r < 20; ++r) acc[r] += sc[r * 1024 + k] * wv[i]; } }
#pragma unroll
  for (int r = 0; r < 20; ++r) red[(kg * 20 + r) * 32 + c] = acc[r];
  __syncthreads();
  for (int i = tid; i < 640; i += NTHR) { const int r = i >> 5, c2 = i & 31; float s = F.P->in.b_ada[n0 + c2];
    for (int g = 0; g < 16; ++g) s += red[(g * 20 + r) * 32 + c2];
    F.mod()[(size_t)(rh * 20 + r) * 6144 + n0 + c2] = s; }
}
template <class Map>
__device__ __forceinline__ void transpose_item(const float* W, int Nsrc, bf16* WT, int ldt, const Map map, LAS float* scr, int item, int nblk, int lane) {
  const int kb = item / nblk, nb = item % nblk, k0 = 64 * kb, n0 = 32 * nb;
  const int ncol = n0 + (lane & 31);
#pragma unroll 16
  for (int i = 0; i < 32; ++i) { const int kk = 2 * i + (lane >> 5); scr[kk * 33 + (lane & 31)] = ncol < Nsrc ? W[(size_t)(k0 + kk) * Nsrc + ncol] : 0.f; }
  LDS_WAIT();
  const int c = lane & 7;
#pragma unroll
  for (int j = 0; j < 4; ++j) { const int n = (lane >> 3) + 8 * j; const LAS float* s = scr + (8 * c) * 33 + n;
    v4u o; o.x = pk2(s[0 * 33], s[1 * 33]); o.y = pk2(s[2 * 33], s[3 * 33]); o.z = pk2(s[4 * 33], s[5 * 33]); o.w = pk2(s[6 * 33], s[7 * 33]);
    const int row = map(n0 + n);
    *(GAS v4u*)(WT + (size_t)row * ldt + k0 + 8 * c) = o; }
  LDS_WAIT();
}
struct MapId { int off; __device__ __forceinline__ int operator()(int n) const { return n + off; } };
struct MapWin { __device__ __forceinline__ int operator()(int n) const {
  if (n < 1536) return n; if (n < 1552) return ZC_GR + (n - 1536); if (n < 1936) return ZC_CQ + (n - 1552); if (n < 2192) return ZC_CKV + (n - 1936); if (n < 2256) return ZC_KR + (n - 2192); return n; } };

__device__ __forceinline__ void p0_prologue(const Frame& F) {
#if !defined(P0SUB) || P0SUB == 1
  for (int u = F.bid; u < 384; u += F.G) p0_mod_unit(F, u);
#endif
  __syncthreads();
#if !defined(P0SUB) || P0SUB == 2
  LAS float* scr = (LAS float*)(F.lds + F.wave * 16384);
  const int gw = F.bid * NWAVES + F.wave, NGW = F.G * NWAVES;
  constexpr int I_IN = 16 * 72, I_UQ = 6 * 24, I_UK = 4 * 16, I_UV = 4 * 16, I_O = 16 * 32, I_UP = 16 * 176, I_DN = 44 * 32;
  constexpr int NITEMS = I_IN + I_UQ + I_UK + I_UV + I_O + I_UP + I_DN;
  for (int it = gw; it < NITEMS; it += NGW) {
    int r = it;
    if (r < I_IN) { transpose_item(F.P->in.w_in, 2256, F.win_t(), 1024, MapWin{}, scr, r, 72, F.lane); continue; } r -= I_IN;
    if (r < I_UQ) { transpose_item(F.P->in.w_mla_uq, 768, F.wq_t(), 384, MapId{0}, scr, r, 24, F.lane); continue; } r -= I_UQ;
    if (r < I_UK) { transpose_item(F.P->in.w_mla_uk, 512, F.wkv_t(), 256, MapId{0}, scr, r, 16, F.lane); continue; } r -= I_UK;
    if (r < I_UV) { transpose_item(F.P->in.w_mla_uv, 512, F.wkv_t(), 256, MapId{512}, scr, r, 16, F.lane); continue; } r -= I_UV;
    if (r < I_O) { transpose_item(F.P->in.w_o, 1024, F.wo_t(), 1024, MapId{0}, scr, r, 32, F.lane); continue; } r -= I_O;
    if (r < I_UP) { transpose_item(F.P->in.w_ffn_up, F2, F.wup_t(), 1024, MapId{0}, scr, r, 176, F.lane); continue; } r -= I_UP;
    transpose_item(F.P->in.w_ffn_down, 1024, F.wdn_t(), FF, MapId{0}, scr, r, 32, F.lane);
  }
#endif
  const int gt = F.bid * NTHR + F.tid, NGT = F.G * NTHR;
#if !defined(P0SUB) || P0SUB == 3
  for (int i = gt; i < 2056 * 32; i += NGT) { const int p = i >> 5, j = i & 31; const int pos = p < 2048 ? p : PAST + (p - 2048);
    const float inv = powf(10000.0f, -(float)(2 * j) / 64.0f); const float ang = (float)pos * inv; F.rope()[i] = (f32x2){cosf(ang), sinf(ang)}; }
#endif
#if !defined(P0SUB) || P0SUB == 4
  __syncthreads();
  { LAS float* As = (LAS float*)F.lds; LAS float* Bs = As + 64 * 129;
    for (int u = F.bid; u < 96; u += F.G) { const int h = u / 24, ct = (u % 24) / 4, lt = u % 4;
      __syncthreads();
      for (int i = F.tid; i < 64 * 128; i += NTHR) { const int rr = i >> 7, n = i & 127;
        As[rr * 129 + n] = F.P->in.w_mla_uq[(size_t)(ct * 64 + rr) * 768 + h * 192 + n]; Bs[rr * 129 + n] = F.P->in.w_mla_uk[(size_t)(lt * 64 + rr) * 512 + h * 128 + n]; }
      __syncthreads();
      const int cc = F.tid & 63, lg = F.tid >> 6;
      float acc[8];
#pragma unroll
      for (int j = 0; j < 8; ++j) acc[j] = 0.f;
      for (int n = 0; n < 128; ++n) { const float a = As[cc * 129 + n];
#pragma unroll
        for (int j = 0; j < 8; ++j) acc[j] += a * Bs[(lg * 8 + j) * 129 + n]; }
#pragma unroll
      for (int j = 0; j < 8; ++j) F.wq_t()[(size_t)(768 + h * 256 + lt * 64 + lg * 8 + j) * 384 + ct * 64 + cc] = (bf16)f2bf(acc[j]); } }
#endif
}

template <int NR>
__device__ __forceinline__ void p1_rows(const Frame& F, const int (&rows)[NR]) {
  const int lane = F.lane; f32x4 v[NR][4]; float rs[NR];
#pragma unroll
  for (int q = 0; q < NR; ++q) { const f32x4* xr = (const f32x4*)x_row(F.P->in, rows[q]) + lane;
#pragma unroll
    for (int j = 0; j < 4; ++j) v[q][j] = xr[64 * j]; }
#pragma unroll
  for (int q = 0; q < NR; ++q) { float s = 0.f;
#pragma unroll
    for (int j = 0; j < 4; ++j) s += (v[q][j].x * v[q][j].x + v[q][j].y * v[q][j].y) + (v[q][j].z * v[q][j].z + v[q][j].w * v[q][j].w);
    rs[q] = rsqrtf(wave_sum(s) * (1.f / D) + 1e-6f); }
#pragma unroll
  for (int q = 0; q < NR; ++q) { const float* modrow = F.mod() + (size_t)cond_row(rows[q]) * 6144;
#pragma unroll
    for (int j = 0; j < 4; ++j) { const int col = 4 * (lane + 64 * j);
      const f32x4 gv = *(const f32x4*)(F.P->in.g_pre_mix + col), scv = *(const f32x4*)(modrow + 1024 + col), shv = *(const f32x4*)(modrow + col);
      const f32x4 o = v[q][j] * rs[q] * gv * (1.f + scv) + shv;
      v2u w; w.x = pk2(o.x, o.y); w.y = pk2(o.z, o.w); *(v2u*)(F.xn() + (size_t)rows[q] * D + col) = w; } }
}
__device__ __forceinline__ void p1_xn(const Frame& F) {
  const int gw = F.bid * NWAVES + F.wave, NGW = F.G * NWAVES;
  int r = gw;
  for (; r + 3 * NGW < MT; r += 4 * NGW) { const int rows[4] = {r, r + NGW, r + 2 * NGW, r + 3 * NGW}; p1_rows<4>(F, rows); }
  for (; r < MT; r += NGW) { const int rows[1] = {r}; p1_rows<1>(F, rows); }
}
template <int NR>
__device__ __forceinline__ void p8_rows(const Frame& F, const int (&rows)[NR]) {
  const int lane = F.lane; f32x4 v[NR][4], xv[NR][4]; float rs[NR];
#pragma unroll
  for (int q = 0; q < NR; ++q) { const int r = rows[q]; const f32x4* xr = (const f32x4*)x_row(F.P->in, r) + lane;
#pragma unroll
    for (int j = 0; j < 4; ++j) xv[q][j] = xr[64 * j];
    if (r < MP) { const f32x4* mr = (const f32x4*)(F.mix() + (size_t)r * D) + lane;
#pragma unroll
      for (int j = 0; j < 4; ++j) v[q][j] = mr[64 * j]; }
    else { const f32x4* mr = (const f32x4*)(F.mixp() + (size_t)(r - MP) * D) + lane;
#pragma unroll
      for (int j = 0; j < 4; ++j) { f32x4 a = mr[64 * j];
#pragma unroll
        for (int k = 1; k < 4; ++k) a += mr[(size_t)k * 256 * 256 + 64 * j];
        v[q][j] = a; } } }
#pragma unroll
  for (int q = 0; q < NR; ++q) { float s = 0.f;
#pragma unroll
    for (int j = 0; j < 4; ++j) s += (v[q][j].x * v[q][j].x + v[q][j].y * v[q][j].y) + (v[q][j].z * v[q][j].z + v[q][j].w * v[q][j].w);
    rs[q] = rsqrtf(wave_sum(s) * (1.f / D) + 1e-6f); }
#pragma unroll
  for (int q = 0; q < NR; ++q) { const int r = rows[q]; const float* modrow = F.mod() + (size_t)cond_row(r) * 6144; float s2 = 0.f;
#pragma unroll
    for (int j = 0; j < 4; ++j) { const int col = 4 * (lane + 64 * j);
      const f32x4 gv = *(const f32x4*)(F.P->in.g_post_mix + col), gt = *(const f32x4*)(modrow + 2048 + col);
      v[q][j] = xv[q][j] + gt * (v[q][j] * rs[q] * gv);
      *(f32x4*)(F.x1() + (size_t)r * D + col) = v[q][j];
      s2 += (v[q][j].x * v[q][j].x + v[q][j].y * v[q][j].y) + (v[q][j].z * v[q][j].z + v[q][j].w * v[q][j].w); }
    const float rs2 = rsqrtf(wave_sum(s2) * (1.f / D) + 1e-6f);
#pragma unroll
    for (int j = 0; j < 4; ++j) { const int col = 4 * (lane + 64 * j);
      const f32x4 gv = *(const f32x4*)(F.P->in.g_pre_ffn + col), scv = *(const f32x4*)(modrow + 4096 + col), shv = *(const f32x4*)(modrow + 3072 + col);
      const f32x4 o = v[q][j] * rs2 * gv * (1.f + scv) + shv;
      v2u w; w.x = pk2(o.x, o.y); w.y = pk2(o.z, o.w); *(v2u*)(F.xn() + (size_t)r * D + col) = w; } }
}
__device__ __forceinline__ void p8_all(const Frame& F) {
  const int gw = F.bid * NWAVES + F.wave, NGW = F.G * NWAVES;
  int r = gw;
  for (; r + NGW < MT; r += 2 * NGW) { const int rows[2] = {r, r + NGW}; p8_rows<2>(F, rows); }
  for (; r < MT; r += NGW) { const int rows[1] = {r}; p8_rows<1>(F, rows); }
}
template <int NR>
__device__ __forceinline__ void p12_rows(const Frame& F, const int (&rows)[NR]) {
  const int lane = F.lane; f32x4 v[NR][4], xv[NR][4]; float rs[NR];
#pragma unroll
  for (int q = 0; q < NR; ++q) { const int r = rows[q]; const f32x4* xr = (const f32x4*)(F.x1() + (size_t)r * D) + lane;
#pragma unroll
    for (int j = 0; j < 4; ++j) xv[q][j] = xr[64 * j];
    if (r < MP) { const f32x4* yr = (const f32x4*)(F.mix() + (size_t)r * D) + lane;
#pragma unroll
      for (int j = 0; j < 4; ++j) v[q][j] = yr[64 * j]; }
    else { const f32x4* yr = (const f32x4*)(F.mixp() + (size_t)(r - MP) * D) + lane;
#pragma unroll
      for (int j = 0; j < 4; ++j) { f32x4 a = yr[64 * j];
#pragma unroll
        for (int k = 1; k < 11; ++k) a += yr[(size_t)k * 256 * 256 + 64 * j];
        v[q][j] = a; } } }
#pragma unroll
  for (int q = 0; q < NR; ++q) { float s = 0.f;
#pragma unroll
    for (int j = 0; j < 4; ++j) s += (v[q][j].x * v[q][j].x + v[q][j].y * v[q][j].y) + (v[q][j].z * v[q][j].z + v[q][j].w * v[q][j].w);
    rs[q] = rsqrtf(wave_sum(s) * (1.f / D) + 1e-6f); }
#pragma unroll
  for (int q = 0; q < NR; ++q) { const int r = rows[q]; const float* modrow = F.mod() + (size_t)cond_row(r) * 6144; float* orow = y_row(F.P->out, r);
#pragma unroll
    for (int j = 0; j < 4; ++j) { const int col = 4 * (lane + 64 * j);
      const f32x4 gv = *(const f32x4*)(F.P->in.g_post_ffn + col), gt = *(const f32x4*)(modrow + 5120 + col);
      *(f32x4*)(orow + col) = xv[q][j] + gt * (v[q][j] * rs[q] * gv); } }
}
__device__ __forceinline__ void p12_all(const Frame& F) {
  const int gw = F.bid * NWAVES + F.wave, NGW = F.G * NWAVES;
  int r = gw;
  for (; r + NGW < MT; r += 2 * NGW) { const int rows[2] = {r, r + NGW}; p12_rows<2>(F, rows); }
  for (; r < MT; r += NGW) { const int rows[1] = {r}; p12_rows<1>(F, rows); }
}
__device__ __forceinline__ void p3_row(const Frame& F, int r) {
  const int lane = F.lane; const bf16* zr = F.z() + (size_t)r * ZW;
  { unsigned w[3]; float s = 0.f;
#pragma unroll
    for (int j = 0; j < 3; ++j) { w[j] = *(const unsigned*)(zr + ZC_CQ + 2 * lane + 128 * j); const float a = bflo(w[j]), b = bfhi(w[j]); s += a * a + b * b; }
    const float rs = rsqrtf(wave_sum(s) * (1.f / 384.f) + 1e-6f);
#pragma unroll
    for (int j = 0; j < 3; ++j) { const int col = 2 * lane + 128 * j; const f32x2 g = *(const f32x2*)(F.P->in.g_mla_q + col);
      *(unsigned*)(F.cqn() + (size_t)r * 384 + col) = pk2(bflo(w[j]) * rs * g.x, bfhi(w[j]) * rs * g.y); } }
  { const v2u w = *(const v2u*)(zr + ZC_CKV + 4 * lane); const f32x4 v = {bflo(w.x), bfhi(w.x), bflo(w.y), bfhi(w.y)};
    const float s = (v.x * v.x + v.y * v.y) + (v.z * v.z + v.w * v.w); const float rs = rsqrtf(wave_sum(s) * (1.f / 256.f) + 1e-6f);
    const f32x4 o = v * rs * *(const f32x4*)(F.P->in.g_mla_kv + 4 * lane);
    float* lo = r < MP ? F.P->out + nv::OUT_LATP + (size_t)r * 256 : F.P->out + nv::OUT_LATS + (size_t)(r - MP) * 256;
    *(f32x4*)(lo + 4 * lane) = o; v2u ob; ob.x = pk2(o.x, o.y); ob.y = pk2(o.z, o.w); *(v2u*)(F.latb() + (size_t)r * 256 + 4 * lane) = ob; }
  { const int i = lane & 31; const float x1 = bf2f(zr[ZC_KR + i]), x2 = bf2f(zr[ZC_KR + 32 + i]); const f32x2 cs = F.rope()[pos_idx(r) * 32 + i];
    const float o1 = x1 * cs.x - x2 * cs.y, o2 = x1 * cs.y + x2 * cs.x;
    float* ko = r < MP ? F.P->out + nv::OUT_KRP + (size_t)r * 64 : F.P->out + nv::OUT_KRS + (size_t)(r - MP) * 64;
    if (lane < 32) { const bf16 b1 = (bf16)f2bf(o1), b2 = (bf16)f2bf(o2); ko[i] = o1; ko[32 + i] = o2; F.krb()[(size_t)r * 64 + i] = b1; F.krb()[(size_t)r * 64 + 32 + i] = b2;
      if (r < MP) {
#pragma unroll
        for (int h = 0; h < 4; ++h) { bf16* kc = F.kcomb() + ((size_t)((r >> 11) * 4 + h) * T + (r & 2047)) * 200; kc[128 + i] = b1; kc[160 + i] = b2; } } } }
}
__device__ __forceinline__ float log_sigmoid_f(float a) { return fminf(a, 0.f) - log1pf(expf(-fabsf(a))); }
__device__ __forceinline__ f32x16 mfma32(bf16x8 a, bf16x8 b, f32x16 c) { return __builtin_amdgcn_mfma_f32_32x32x16_bf16(a, b, c, 0, 0, 0); }
__device__ __forceinline__ int crow(int rho, int hh) { return (rho & 3) + 8 * (rho >> 2) + 4 * hh; }

__device__ __forceinline__ void gla_prep_unit(const Frame& F, int b, int c) {
  LAS float* grs = (LAS float*)F.lds; LAS float* tot = grs + 1024;
  const int tid = F.tid, col = tid & 255, th = tid >> 8; const int r0 = b * T + c * 64;
  __syncthreads();
  for (int i = tid; i < 1024; i += NTHR) grs[i] = bf2f(F.z()[(size_t)(r0 + (i >> 4)) * ZW + ZC_GR + (i & 15)]);
  __syncthreads();
  float w2[16];
#pragma unroll
  for (int j = 0; j < 16; ++j) w2[j] = F.P->in.w_gla_a2[j * 256 + col];
  const float bias = F.P->in.b_gla_a[col];
  float bl[32]; float run = 0.f;
#pragma unroll
  for (int tt = 0; tt < 32; ++tt) { const int t = th * 32 + tt; float x = bias;
#pragma unroll
    for (int j = 0; j < 16; ++j) x += grs[t * 16 + j] * w2[j];
    run += log_sigmoid_f(x) * (1.f / 16.f); bl[tt] = run; }
  tot[th * 256 + col] = run;
  __syncthreads();
  const float base = th ? tot[col] : 0.f, blast = tot[col] + tot[256 + col];
  unsigned kl[16];
#pragma unroll
  for (int tt = 0; tt < 32; ++tt) { const float bt = bl[tt] + base; const size_t r = (size_t)(r0 + th * 32 + tt);
    const float q = bf2f(F.z()[r * ZW + ZC_QA + col]), k = bf2f(F.z()[r * ZW + ZC_KA + col]);
    F.qd()[r * 256 + col] = (bf16)f2bf(q * 0.125f * expf(bt)); F.kd()[r * 256 + col] = (bf16)f2bf(k * expf(-bt));
    const unsigned kv = f2bf(k * expf(blast - bt));
    if (tt & 1) kl[tt >> 1] |= kv << 16; else kl[tt >> 1] = kv; }
  { v4u* dst = (v4u*)(F.klt() + ((size_t)b * 256 + col) * T + c * 64 + th * 32);
#pragma unroll
    for (int i = 0; i < 4; ++i) dst[i] = (v4u){kl[4 * i], kl[4 * i + 1], kl[4 * i + 2], kl[4 * i + 3]}; }
  if (th == 0) F.dch()[((size_t)b * 32 + c) * 256 + col] = expf(blast);
  { const bf16* src = F.z() + (size_t)r0 * ZW + ZC_VA + tid; v4u* dst = (v4u*)(F.vt() + ((size_t)b * 512 + tid) * T + c * 64);
#pragma unroll
    for (int g = 0; g < 8; ++g) { unsigned w[4];
#pragma unroll
      for (int i = 0; i < 4; ++i) w[i] = (unsigned)src[(size_t)(8 * g + 2 * i) * ZW] | ((unsigned)src[(size_t)(8 * g + 2 * i + 1) * ZW] << 16);
      dst[g] = (v4u){w[0], w[1], w[2], w[3]}; } }
}

__device__ __forceinline__ void gla_sample_unit(const Frame& F, int b, int h) {
  LAS float* L = (LAS float*)F.lds;
  LAS float* bc = L;
  LAS float* qd = L + 512;
  LAS float* kd = L + 1024;
  LAS float* kl = L + 1536;
  LAS float* dk = L + 2048;
  LAS float* att = L + 2112;
  LAS float* vv = L + 2176;
  LAS float* part = L + 3200;
  const int tid = F.tid, r0 = MP + b * DT;
  __syncthreads();
  { const int t = tid >> 6, k = tid & 63; const bf16* zr = F.z() + (size_t)(r0 + t) * ZW; float x = F.P->in.b_gla_a[h * 64 + k];
#pragma unroll
    for (int j = 0; j < 16; ++j) x += bf2f(zr[ZC_GR + j]) * F.P->in.w_gla_a2[j * 256 + h * 64 + k];
    bc[t * 64 + k] = log_sigmoid_f(x) * (1.f / 16.f); }
  for (int i = tid; i < 1024; i += NTHR) vv[i] = bf2f(F.z()[(size_t)(r0 + (i >> 7)) * ZW + ZC_VA + h * 128 + (i & 127)]);
  __syncthreads();
  if (tid < 64) { float run = 0.f; for (int t = 0; t < 8; ++t) { run += bc[t * 64 + tid]; bc[t * 64 + tid] = run; } dk[tid] = expf(run); }
  __syncthreads();
  { const int t = tid >> 6, k = tid & 63; const bf16* zr = F.z() + (size_t)(r0 + t) * ZW; const float bt = bc[t * 64 + k], blast = bc[7 * 64 + k];
    const float q = bf2f(zr[ZC_QA + h * 64 + k]) * 0.125f, kk = bf2f(zr[ZC_KA + h * 64 + k]);
    qd[t * 64 + k] = q * expf(bt); kd[t * 64 + k] = kk * expf(-bt); kl[t * 64 + k] = kk * expf(blast - bt); }
  __syncthreads();
  if (tid < 64) { const int t = tid >> 3, s = tid & 7; float a = 0.f; for (int k = 0; k < 64; ++k) a += qd[t * 64 + k] * kd[s * 64 + k]; att[tid] = s <= t ? a : 0.f; }
  { const int v = tid & 127, kq = tid >> 7; float S0[16];
#pragma unroll
    for (int i = 0; i < 16; ++i) S0[i] = F.P->in.state_gla[(((size_t)b * 4 + h) * 64 + kq * 16 + i) * 128 + v];
#pragma unroll
    for (int t = 0; t < 8; ++t) { float o = 0.f;
#pragma unroll
      for (int i = 0; i < 16; ++i) o += qd[t * 64 + kq * 16 + i] * S0[i];
      part[(kq * 8 + t) * 128 + v] = o; }
#pragma unroll
    for (int i = 0; i < 16; ++i) { float sn = dk[kq * 16 + i] * S0[i];
#pragma unroll
      for (int s = 0; s < 8; ++s) sn += kl[s * 64 + kq * 16 + i] * vv[s * 128 + v];
      F.P->out[nv::OUT_GLAS + (((size_t)b * 4 + h) * 64 + kq * 16 + i) * 128 + v] = sn; } }
  __syncthreads();
  { const int t = F.wave, lane = F.lane; float o[2]; float ss = 0.f;
#pragma unroll
    for (int e = 0; e < 2; ++e) { const int v = lane + 64 * e; float a = part[(0 * 8 + t) * 128 + v] + part[(1 * 8 + t) * 128 + v] + part[(2 * 8 + t) * 128 + v] + part[(3 * 8 + t) * 128 + v];
      for (int s = 0; s <= t; ++s) a += att[t * 8 + s] * vv[s * 128 + v];
      o[e] = a; ss += a * a; }
    const float rs = rsqrtf(wave_sum(ss) * (1.f / 128.f) + 1e-6f);
#pragma unroll
    for (int e = 0; e < 2; ++e) { const int v = lane + 64 * e; const float ra = bf2f(F.z()[(size_t)(r0 + t) * ZW + ZC_RA + h * 128 + v]);
      F.mixin()[(size_t)(r0 + t) * D + h * 128 + v] = (bf16)f2bf(o[e] * rs * F.P->in.g_gla_out[v] * silu_f(ra)); } }
}

__device__ __forceinline__ void gla_passA_item(const Frame& F, int item) {
  const int vh = item & 1, c = (item >> 1) & 31, h = (item >> 6) & 3, b = item >> 8;
  const int lane = F.lane, r = lane & 31, hh = lane >> 5;
  f32x16 acc[2][2];
#pragma unroll
  for (int i = 0; i < 2; ++i)
#pragma unroll
    for (int j = 0; j < 2; ++j)
#pragma unroll
      for (int e = 0; e < 16; ++e) acc[i][j][e] = 0.f;
  const bf16* va = F.vt() + ((size_t)b * 512 + h * 128 + vh * 64 + r) * T + c * 64 + 8 * hh;
  const bf16* ka = F.klt() + ((size_t)b * 256 + h * 64 + r) * T + c * 64 + 8 * hh;
#pragma unroll
  for (int ks = 0; ks < 4; ++ks) { bf16x8 A[2], B[2];
#pragma unroll
    for (int i = 0; i < 2; ++i) { A[i] = *(const bf16x8*)(va + (size_t)i * 32 * T + 16 * ks); B[i] = *(const bf16x8*)(ka + (size_t)i * 32 * T + 16 * ks); }
#pragma unroll
    for (int i = 0; i < 2; ++i)
#pragma unroll
      for (int j = 0; j < 2; ++j) acc[i][j] = mfma32(A[i], B[j], acc[i][j]); }
  float* ub = F.ut() + (((size_t)b * 4 + h) * 32 + c) * 8192;
#pragma unroll
  for (int i = 0; i < 2; ++i)
#pragma unroll
    for (int j = 0; j < 2; ++j)
#pragma unroll
      for (int e = 0; e < 16; ++e) ub[(size_t)(vh * 64 + i * 32 + crow(e, hh)) * 64 + j * 32 + r] = acc[i][j][e];
}
__device__ __forceinline__ void gla_passB(const Frame& F) {
  const int gt = F.bid * NTHR + F.tid;
  if (gt >= 32 * 4096) return;
  const int bh = gt >> 12, pr = gt & 4095, v = pr >> 5, k2 = (pr & 31) * 2, b = bh >> 2, h = bh & 3;
  float s0 = 0.f, s1 = 0.f;
  for (int c = 0; c < 32; ++c) { const size_t e = (((size_t)bh * 32 + c) * 128 + v) * 64 + k2;
    *(unsigned*)(F.st() + e) = pk2(s0, s1);
    const f32x2 d = *(const f32x2*)(F.dch() + ((size_t)b * 32 + c) * 256 + h * 64 + k2), u = *(const f32x2*)(F.ut() + e);
    s0 = d.x * s0 + u.x; s1 = d.y * s1 + u.y; }
  F.P->out[nv::OUT_GLAP + ((size_t)bh * 64 + k2) * 128 + v] = s0; F.P->out[nv::OUT_GLAP + ((size_t)bh * 64 + k2 + 1) * 128 + v] = s1;
}
__device__ __forceinline__ void gla_passC_item(const Frame& F, int item) {
  const int th = item & 1, c = (item >> 1) & 31, h = (item >> 6) & 3, b = item >> 8;
  const int lane = F.lane, r = lane & 31, hh = lane >> 5;
  const size_t row0 = (size_t)b * T + c * 64;
  bf16x8 Bq[4];
  { const bf16* qa = F.qd() + (row0 + th * 32 + r) * 256 + h * 64 + 8 * hh;
#pragma unroll
    for (int ks = 0; ks < 4; ++ks) Bq[ks] = *(const bf16x8*)(qa + 16 * ks); }
  f32x16 p[2];
#pragma unroll
  for (int st = 0; st < 2; ++st) {
#pragma unroll
    for (int e = 0; e < 16; ++e) p[st][e] = 0.f;
    const bf16* ka = F.kd() + (row0 + st * 32 + r) * 256 + h * 64 + 8 * hh;
#pragma unroll
    for (int ks = 0; ks < 4; ++ks) p[st] = mfma32(*(const bf16x8*)(ka + 16 * ks), Bq[ks], p[st]);
#pragma unroll
    for (int e = 0; e < 16; ++e) { const int s = st * 32 + crow(e, hh); if (s > th * 32 + r) p[st][e] = 0.f; } }
  f32x16 o[4];
#pragma unroll
  for (int vt = 0; vt < 4; ++vt)
#pragma unroll
    for (int e = 0; e < 16; ++e) o[vt][e] = 0.f;
  { const bf16* sa = F.st() + ((((size_t)b * 4 + h) * 32 + c) * 128 + r) * 64 + 8 * hh;
#pragma unroll
    for (int vt = 0; vt < 4; ++vt)
#pragma unroll
      for (int ks = 0; ks < 4; ++ks) o[vt] = mfma32(*(const bf16x8*)(sa + (size_t)vt * 32 * 64 + 16 * ks), Bq[ks], o[vt]); }
  { const bf16* va = F.vt() + ((size_t)b * 512 + h * 128 + r) * T + c * 64 + 4 * hh;
#pragma unroll
    for (int st = 0; st < 2; ++st)
#pragma unroll
      for (int ks = 0; ks < 2; ++ks) { v4u pb;
        pb.x = pk2(p[st][8 * ks + 0], p[st][8 * ks + 1]); pb.y = pk2(p[st][8 * ks + 2], p[st][8 * ks + 3]); pb.z = pk2(p[st][8 * ks + 4], p[st][8 * ks + 5]); pb.w = pk2(p[st][8 * ks + 6], p[st][8 * ks + 7]);
        const bf16x8 Bp = __builtin_bit_cast(bf16x8, pb);
#pragma unroll
        for (int vt = 0; vt < 4; ++vt) { const bf16* ap = va + (size_t)vt * 32 * T + st * 32 + 16 * ks;
          const v2u lo = *(const v2u*)ap, hi = *(const v2u*)(ap + 8); const v4u av = {lo.x, lo.y, hi.x, hi.y};
          o[vt] = mfma32(__builtin_bit_cast(bf16x8, av), Bp, o[vt]); } } }
  float ss = 0.f;
#pragma unroll
  for (int vt = 0; vt < 4; ++vt)
#pragma unroll
    for (int e = 0; e < 16; ++e) ss += o[vt][e] * o[vt][e];
  ss += __shfl_xor(ss, 32);
  const float rs = rsqrtf(ss * (1.f / 128.f) + 1e-6f);
  const size_t row = row0 + th * 32 + r;
#pragma unroll
  for (int vt = 0; vt < 4; ++vt)
#pragma unroll
    for (int g = 0; g < 4; ++g) { const int v = vt * 32 + 8 * g + 4 * hh;
      const v2u ra = *(const v2u*)(F.z() + row * ZW + ZC_RA + h * 128 + v); const f32x4 gg = *(const f32x4*)(F.P->in.g_gla_out + v);
      v2u w; w.x = pk2(o[vt][4 * g + 0] * rs * gg.x * silu_f(bflo(ra.x)), o[vt][4 * g + 1] * rs * gg.y * silu_f(bfhi(ra.x)));
      w.y = pk2(o[vt][4 * g + 2] * rs * gg.z * silu_f(bflo(ra.y)), o[vt][4 * g + 3] * rs * gg.w * silu_f(bfhi(ra.y)));
      *(v2u*)(F.mixin() + row * D + h * 128 + v) = w; }
}
typedef short v4i16_t __attribute__((ext_vector_type(4)));
__device__ __forceinline__ s16x4 lds_tr(LAS const unsigned char* p) { return __builtin_bit_cast(s16x4, __builtin_amdgcn_ds_read_tr16_b64_v4i16((LAS v4i16_t*)p)); }
__device__ __forceinline__ bf16x8 mk8(s16x4 lo, s16x4 hi) { return (bf16x8){lo[0], lo[1], lo[2], lo[3], hi[0], hi[1], hi[2], hi[3]}; }
__device__ __forceinline__ bf16x8 pack8(const f32x16& p, int o) { v4u w; w.x = pk2(p[o], p[o + 1]); w.y = pk2(p[o + 2], p[o + 3]); w.z = pk2(p[o + 4], p[o + 5]); w.w = pk2(p[o + 6], p[o + 7]); return __builtin_bit_cast(bf16x8, w); }
__device__ __forceinline__ float max16(const f32x16& p) { float a = fmaxf(fmaxf(p[0], p[1]), fmaxf(p[2], p[3])), b = fmaxf(fmaxf(p[4], p[5]), fmaxf(p[6], p[7])), c = fmaxf(fmaxf(p[8], p[9]), fmaxf(p[10], p[11])), d = fmaxf(fmaxf(p[12], p[13]), fmaxf(p[14], p[15])); return fmaxf(fmaxf(a, b), fmaxf(c, d)); }

constexpr int PA_KROW = 400;
constexpr int PA_KB = 64 * PA_KROW, PA_VB = 16384, PA_BUF = PA_KB + PA_VB;
__device__ __forceinline__ void pattn_unit(const Frame& F, int b, int h, int qb) {
  const int tid = F.tid, lane = F.lane, r = lane & 31, hh = lane >> 5, w = F.wave;
  const size_t row0 = (size_t)b * T; const int q = qb * 256 + w * 32 + r;
  bf16x8 qf[12];
  { const bf16* qp = F.qbuf() + (row0 + q) * QW + h * 192;
#pragma unroll
    for (int s = 0; s < 8; ++s) { const v4u x = *(const v4u*)(qp + 16 * s + 8 * hh); v4u y;
      y.x = pk2(bflo(x.x) * C2, bfhi(x.x) * C2); y.y = pk2(bflo(x.y) * C2, bfhi(x.y) * C2); y.z = pk2(bflo(x.z) * C2, bfhi(x.z) * C2); y.w = pk2(bflo(x.w) * C2, bfhi(x.w) * C2);
      qf[s] = __builtin_bit_cast(bf16x8, y); }
#pragma unroll
    for (int e = 0; e < 2; ++e) { const int i0 = 16 * e + 8 * hh; const v4u a = *(const v4u*)(qp + 128 + i0), c = *(const v4u*)(qp + 160 + i0);
      const f32x2* cs = F.rope() + (size_t)q * 32 + i0; unsigned o1[4], o2[4];
#pragma unroll
      for (int j = 0; j < 4; ++j) { const unsigned aw = a[j], cw = c[j]; const f32x2 c0 = cs[2 * j], c1 = cs[2 * j + 1];
        const float x1a = bflo(aw), x1b = bfhi(aw), x2a = bflo(cw), x2b = bfhi(cw);
        o1[j] = pk2((x1a * c0.x - x2a * c0.y) * C2, (x1b * c1.x - x2b * c1.y) * C2); o2[j] = pk2((x1a * c0.y + x2a * c0.x) * C2, (x1b * c1.y + x2b * c1.x) * C2); }
      qf[8 + e] = __builtin_bit_cast(bf16x8, ((v4u){o1[0], o1[1], o1[2], o1[3]})); qf[10 + e] = __builtin_bit_cast(bf16x8, ((v4u){o2[0], o2[1], o2[2], o2[3]})); } }
  f32x16 o[4];
#pragma unroll
  for (int dt = 0; dt < 4; ++dt)
#pragma unroll
    for (int e = 0; e < 16; ++e) o[dt][e] = 0.f;
  float m = -INFINITY, lsum = 0.f;
  const int nt = 4 * qb + 4, jdiag = 4 * qb + (w >> 1);
  const unsigned char* ksrc = (const unsigned char*)(F.kcomb() + ((size_t)(b * 4 + h) * T) * 200) + lane * 16;
  const unsigned char* vsrc = (const unsigned char*)(F.vb() + row0 * 512 + h * 128) + (lane >> 2) * 1024 + (lane & 3) * 16;
#define PA_ISSUE(j_, buf_) do { LAS unsigned char* kb_ = F.lds + (buf_) * PA_BUF; \
    for (int c_ = w; c_ < 25; c_ += 8) __builtin_amdgcn_global_load_lds((const unsigned*)(ksrc + (size_t)(j_) * PA_KB + c_ * 1024), (LAS unsigned*)(kb_ + c_ * 1024), 16, 0, 0); \
    _Pragma("unroll") for (int i_ = 0; i_ < 2; ++i_) { const int c_ = w + 8 * i_; \
      __builtin_amdgcn_global_load_lds((const unsigned*)(vsrc + (size_t)(j_) * 65536 + (c_ & 3) * 16384 + (c_ >> 2) * 64), (LAS unsigned*)(kb_ + PA_KB + c_ * 1024), 16, 0, 0); } } while (0)
  __syncthreads();
  PA_ISSUE(0, 0);
  const int trbase = ((lane >> 4) & 1) * 32 + (lane & 3) * 8 + (4 * hh + ((lane & 15) >> 2)) * 64;
  for (int j = 0; j < nt; ++j) {
    __syncthreads();
    if (j + 1 < nt) PA_ISSUE(j + 1, (j + 1) & 1);
    if (j <= jdiag) {
      LAS const unsigned char* kb = F.lds + (j & 1) * PA_BUF; LAS const unsigned char* vbp = kb + PA_KB;
      f32x16 p0, p1;
#pragma unroll
      for (int e = 0; e < 16; ++e) { p0[e] = 0.f; p1[e] = 0.f; }
      LAS const unsigned char* ka = kb + r * PA_KROW + 16 * hh;
#pragma unroll
      for (int sg = 0; sg < 3; ++sg) {
#pragma unroll
        for (int s = 4 * sg; s < 4 * sg + 4; ++s) { const bf16x8 a0 = *(LAS const bf16x8*)(ka + 32 * s), a1 = *(LAS const bf16x8*)(ka + 32 * PA_KROW + 32 * s);
          p0 = mfma32(a0, qf[s], p0); p1 = mfma32(a1, qf[s], p1); } }
      if (j == jdiag) {
#pragma unroll
        for (int e = 0; e < 16; ++e) { const int kv = 64 * j + crow(e, hh); if (kv > q) p0[e] = -INFINITY; if (kv + 32 > q) p1[e] = -INFINITY; } }
      float tmax = fmaxf(max16(p0), max16(p1)); tmax = fmaxf(tmax, __shfl_xor(tmax, 32));
      const float mn = fmaxf(m, tmax), alpha = __builtin_amdgcn_exp2f(m - mn); m = mn;
      float ps = 0.f;
#pragma unroll
      for (int e = 0; e < 16; ++e) { p0[e] = __builtin_amdgcn_exp2f(p0[e] - mn); p1[e] = __builtin_amdgcn_exp2f(p1[e] - mn); ps += p0[e] + p1[e]; }
      lsum = lsum * alpha + ps;
      if (__any(alpha != 1.f)) {
#pragma unroll
        for (int dt = 0; dt < 4; ++dt)
#pragma unroll
          for (int e = 0; e < 16; ++e) o[dt][e] *= alpha; }
#pragma unroll
      for (int u = 0; u < 2; ++u)
#pragma unroll
        for (int ks = 0; ks < 2; ++ks) { const bf16x8 pb = pack8(u ? p1 : p0, 8 * ks);
#pragma unroll
          for (int dt = 0; dt < 4; ++dt) { LAS const unsigned char* vp = vbp + dt * 4096 + (32 * u + 16 * ks) * 64 + trbase;
            o[dt] = mfma32(mk8(lds_tr(vp), lds_tr(vp + 512)), pb, o[dt]); } }
    }
  }
#undef PA_ISSUE
  const float lt = lsum + __shfl_xor(lsum, 32); const float inv = 1.f / lt;
  float ss = 0.f;
#pragma unroll
  for (int dt = 0; dt < 4; ++dt)
#pragma unroll
    for (int e = 0; e < 16; ++e) { o[dt][e] *= inv; ss += o[dt][e] * o[dt][e]; }
  ss += __shfl_xor(ss, 32);
  const float rs = rsqrtf(ss * (1.f / 128.f) + 1e-6f);
  bf16* op = F.mixin() + (row0 + q) * D + 512 + h * 128;
#pragma unroll
  for (int dt = 0; dt < 4; ++dt)
#pragma unroll
    for (int g = 0; g < 4; ++g) { const int d = dt * 32 + 8 * g + 4 * hh; const f32x4 gg = *(const f32x4*)(F.P->in.g_mla_out + d);
      v2u wv; wv.x = pk2(o[dt][4 * g] * rs * gg.x, o[dt][4 * g + 1] * rs * gg.y); wv.y = pk2(o[dt][4 * g + 2] * rs * gg.z, o[dt][4 * g + 3] * rs * gg.w);
      *(v2u*)(op + d) = wv; }
}

constexpr int DA_KROW = 656;
constexpr int DA_Q = 32 * DA_KROW, DA_KB = 32 * DA_KROW, DA_VB = 16384, DA_BUF = DA_KB + DA_VB;
__device__ __forceinline__ int split_tile0(int s) { return (512 * s) / NSPLIT; }
__device__ __forceinline__ void dattn_unit(const Frame& F, int b, int sp) {
  const int tid = F.tid, lane = F.lane, r = lane & 31, hh = lane >> 5, w = F.wave;
  LAS unsigned char* qs = F.lds; LAS unsigned char* bufs = F.lds + DA_Q;
  __syncthreads();
  { const int rr = tid >> 4, cg = tid & 15, t = rr >> 2, h = rr & 3; const bf16* qrow = F.qbuf() + (size_t)(MP + b * DT + t) * QW;
    const v4u* src = (const v4u*)(qrow + 768 + h * 256 + cg * 16); LAS v4u* dst = (LAS v4u*)(qs + rr * DA_KROW + cg * 32);
#pragma unroll
    for (int e = 0; e < 2; ++e) { const v4u x = src[e]; v4u y;
      y.x = pk2(bflo(x.x) * C2, bfhi(x.x) * C2); y.y = pk2(bflo(x.y) * C2, bfhi(x.y) * C2); y.z = pk2(bflo(x.z) * C2, bfhi(x.z) * C2); y.w = pk2(bflo(x.w) * C2, bfhi(x.w) * C2); dst[e] = y; }
    LAS bf16* qd = (LAS bf16*)(qs + rr * DA_KROW);
#pragma unroll
    for (int e = 0; e < 2; ++e) { const int i = 2 * cg + e; const float x1 = bf2f(qrow[h * 192 + 128 + i]), x2 = bf2f(qrow[h * 192 + 160 + i]); const f32x2 cs = F.rope()[(2048 + t) * 32 + i];
      qd[256 + i] = (bf16)f2bf((x1 * cs.x - x2 * cs.y) * C2); qd[288 + i] = (bf16)f2bf((x1 * cs.y + x2 * cs.x) * C2); } }
  const int t0 = split_tile0(sp), t1 = split_tile0(sp + 1); const bool has_new = (sp == NSPLIT - 1); const int nt = (t1 - t0) + (has_new ? 1 : 0);
  f32x4 la[4], ra, lb[4], rb;
#define DA_LOAD(L_, R_, ti_) do { const int tile_ = t0 + (ti_); const int page_ = F.P->in.page_table[b * NPG + (tile_ >> 2)]; const size_t prow_ = (size_t)page_ * 128 + (tile_ & 3) * 32; \
    _Pragma("unroll") for (int i_ = 0; i_ < 4; ++i_) { const int f_ = tid + NTHR * i_; L_[i_] = __builtin_nontemporal_load((const f32x4*)(F.P->in.cache_lat + (prow_ + (f_ >> 6)) * 256 + (f_ & 63) * 4)); } \
    R_ = __builtin_nontemporal_load((const f32x4*)(F.P->in.cache_kr + (prow_ + (tid >> 4)) * 64 + (tid & 15) * 4)); } while (0)
#define DA_STORE(L_, R_, buf_) do { LAS unsigned char* kb_ = bufs + (buf_) * DA_BUF; LAS unsigned char* vb_ = kb_ + DA_KB; \
    _Pragma("unroll") for (int i_ = 0; i_ < 4; ++i_) { const int f_ = tid + NTHR * i_, row_ = f_ >> 6, c4_ = f_ & 63; v2u wv_; wv_.x = pk2(L_[i_].x, L_[i_].y); wv_.y = pk2(L_[i_].z, L_[i_].w); \
      *(LAS v2u*)(kb_ + row_ * DA_KROW + c4_ * 8) = wv_; *(LAS v2u*)(vb_ + (c4_ >> 3) * 2048 + row_ * 64 + (c4_ & 7) * 8) = wv_; } \
    { const int row_ = tid >> 4, c4_ = tid & 15; v2u wv_; wv_.x = pk2(R_.x, R_.y); wv_.y = pk2(R_.z, R_.w); *(LAS v2u*)(kb_ + row_ * DA_KROW + 512 + c4_ * 8) = wv_; } } while (0)
#define DA_STORE_NEW(buf_) do { LAS unsigned char* kb_ = bufs + (buf_) * DA_BUF; LAS unsigned char* vb_ = kb_ + DA_KB; \
    _Pragma("unroll") for (int i_ = 0; i_ < 4; ++i_) { const int f_ = tid + NTHR * i_, row_ = f_ >> 6, c4_ = f_ & 63; v2u wv_ = {0u, 0u}; \
      if (row_ < DT) wv_ = *(const v2u*)(F.latb() + (size_t)(MP + b * DT + row_) * 256 + c4_ * 4); \
      *(LAS v2u*)(kb_ + row_ * DA_KROW + c4_ * 8) = wv_; *(LAS v2u*)(vb_ + (c4_ >> 3) * 2048 + row_ * 64 + (c4_ & 7) * 8) = wv_; } \
    { const int row_ = tid >> 4, c4_ = tid & 15; v2u wv_ = {0u, 0u}; if (row_ < DT) wv_ = *(const v2u*)(F.krb() + (size_t)(MP + b * DT + row_) * 64 + c4_ * 4); \
      *(LAS v2u*)(kb_ + row_ * DA_KROW + 512 + c4_ * 8) = wv_; } } while (0)
  const int npast = t1 - t0;
  f32x16 o;
#pragma unroll
  for (int e = 0; e < 16; ++e) o[e] = 0.f;
  float m = -INFINITY, lsum = 0.f;
  const int trbase = ((lane >> 4) & 1) * 32 + (lane & 3) * 8 + (4 * hh + ((lane & 15) >> 2)) * 64;
#define DA_COMPUTE(buf_, j_) do { \
      LAS const unsigned char* kb = bufs + (buf_) * DA_BUF; LAS const unsigned char* vbp = kb + DA_KB; \
      f32x16 p; \
      _Pragma("unroll") for (int e = 0; e < 16; ++e) p[e] = 0.f; \
      LAS const unsigned char* ka = kb + r * DA_KROW + 16 * hh; LAS const unsigned char* qa = qs + r * DA_KROW + 16 * hh; \
      _Pragma("unroll") for (int s = 0; s < 20; ++s) p = mfma32(*(LAS const bf16x8*)(ka + 32 * s), *(LAS const bf16x8*)(qa + 32 * s), p); \
      if ((j_) >= npast) { _Pragma("unroll") for (int e = 0; e < 16; ++e) { const int kv = crow(e, hh); if (kv > (r >> 2)) p[e] = -INFINITY; } } \
      float tmax = max16(p); tmax = fmaxf(tmax, __shfl_xor(tmax, 32)); \
      const float mn = fmaxf(m, tmax), alpha = __builtin_amdgcn_exp2f(m - mn); m = mn; \
      float ps = 0.f; \
      _Pragma("unroll") for (int e = 0; e < 16; ++e) { p[e] = __builtin_amdgcn_exp2f(p[e] - mn); ps += p[e]; } \
      lsum = lsum * alpha + ps; \
      _Pragma("unroll") for (int e = 0; e < 16; ++e) o[e] *= alpha; \
      _Pragma("unroll") for (int ks = 0; ks < 2; ++ks) { LAS const unsigned char* vp = vbp + w * 2048 + (16 * ks) * 64 + trbase; \
        o = mfma32(mk8(lds_tr(vp), lds_tr(vp + 512)), pack8(p, 8 * ks), o); } } while (0)
  DA_LOAD(la, ra, 0); DA_STORE(la, ra, 0);
  if (npast > 1) DA_LOAD(la, ra, 1);
  for (int j = 0; j < nt; j += 2) {
    __syncthreads();
    if (j + 2 < npast) DA_LOAD(lb, rb, j + 2);
    DA_COMPUTE(0, j);
    if (j + 1 < npast) DA_STORE(la, ra, 1); else if (j + 1 < nt) DA_STORE_NEW(1);
    if (j + 1 >= nt) break;
    __syncthreads();
    if (j + 3 < npast) DA_LOAD(la, ra, j + 3);
    DA_COMPUTE(1, j + 1);
    if (j + 2 < npast) DA_STORE(lb, rb, 0); else if (j + 2 < nt) DA_STORE_NEW(0);
  }
#undef DA_LOAD
#undef DA_STORE
#undef DA_STORE_NEW
#undef DA_COMPUTE
  float* po = F.dpo() + (((size_t)b * NSPLIT + sp) * 32 + r) * 256 + 32 * w;
#pragma unroll
  for (int g = 0; g < 4; ++g) *(f32x4*)(po + 8 * g + 4 * hh) = (f32x4){o[4 * g], o[4 * g + 1], o[4 * g + 2], o[4 * g + 3]};
  const float lt = lsum + __shfl_xor(lsum, 32);
  if (w == 0 && lane < 32) { float* pm = F.dpml() + ((size_t)b * NSPLIT + sp) * 64; pm[r] = m; pm[32 + r] = lt; }
}
__device__ __forceinline__ void dcombine_unit(const Frame& F, int b) {
  LAS float* ol = (LAS float*)F.lds;
  const int tid = F.tid;
  __syncthreads();
  { const int q = tid >> 4, c0 = (tid & 15) * 16; float mm[NSPLIT], M = -INFINITY;
#pragma unroll
    for (int s = 0; s < NSPLIT; ++s) { mm[s] = F.dpml()[((size_t)b * NSPLIT + s) * 64 + q]; M = fmaxf(M, mm[s]); }
    float Lt = 0.f; f32x4 a[4];
#pragma unroll
    for (int i = 0; i < 4; ++i) a[i] = (f32x4){0.f, 0.f, 0.f, 0.f};
#pragma unroll
    for (int s = 0; s < NSPLIT; ++s) { const float ws = __builtin_amdgcn_exp2f(mm[s] - M); Lt += ws * F.dpml()[((size_t)b * NSPLIT + s) * 64 + 32 + q];
      const f32x4* src = (const f32x4*)(F.dpo() + (((size_t)b * NSPLIT + s) * 32 + q) * 256 + c0);
#pragma unroll
      for (int i = 0; i < 4; ++i) a[i] += ws * src[i]; }
    const float inv = 1.f / Lt;
#pragma unroll
    for (int i = 0; i < 4; ++i) *(LAS f32x4*)(ol + q * 256 + c0 + 4 * i) = a[i] * inv; }
  __syncthreads();
  { const int q = tid >> 4, vg = tid & 15, h = q & 3, t = q >> 2; float acc[8];
#pragma unroll
    for (int i = 0; i < 8; ++i) acc[i] = 0.f;
    const float* wv = F.P->in.w_mla_uv + h * 128 + vg * 8;
    for (int l = 0; l < 256; ++l) { const float x = ol[q * 256 + l]; const f32x4 w0 = *(const f32x4*)(wv + (size_t)l * 512), w1 = *(const f32x4*)(wv + (size_t)l * 512 + 4);
      acc[0] += x * w0.x; acc[1] += x * w0.y; acc[2] += x * w0.z; acc[3] += x * w0.w; acc[4] += x * w1.x; acc[5] += x * w1.y; acc[6] += x * w1.z; acc[7] += x * w1.w; }
    float ss = 0.f;
#pragma unroll
    for (int i = 0; i < 8; ++i) ss += acc[i] * acc[i];
#pragma unroll
    for (int o = 1; o < 16; o <<= 1) ss += __shfl_xor(ss, o);
    const float rs = rsqrtf(ss * (1.f / 128.f) + 1e-6f); const float* g = F.P->in.g_mla_out + vg * 8;
    v4u wo; wo.x = pk2(acc[0] * rs * g[0], acc[1] * rs * g[1]); wo.y = pk2(acc[2] * rs * g[2], acc[3] * rs * g[3]); wo.z = pk2(acc[4] * rs * g[4], acc[5] * rs * g[5]); wo.w = pk2(acc[6] * rs * g[6], acc[7] * rs * g[7]);
    *(v4u*)(F.mixin() + (size_t)(MP + b * DT + t) * D + 512 + h * 128 + vg * 8) = wo; }
}
struct StaticOrder {
  int nM, nN, nwg, G, c;
  __device__ void init(int nM_, int nN_, int G_, int c_) { nM = nM_; nN = nN_; nwg = nM * nN; G = G_; c = c_; }
  __device__ bool next(int i, pg8::Unit& u) const {
    const long L = (long)i * G + c; if (L >= nwg) return false;
    int wgid = (int)L; { const int q = nwg / 8, r = nwg % 8, xcd = wgid % 8, off = wgid / 8; wgid = (xcd < r ? xcd * (q + 1) : r * (q + 1) + (xcd - r) * q) + off; }
    const int nig = 8 * nN, gid = wgid / nig, fm = gid * 8, gsz = (nM - fm) < 8 ? (nM - fm) : 8;
    u.pm = fm + ((wgid % nig) % gsz); u.pn = (wgid % nig) / gsz; u.kk = 0; return true;
  }
  __device__ __forceinline__ void a_ready(const pg8::Unit&) const {}
  __device__ __forceinline__ void done(const pg8::Unit&) const {}
};
struct SchedQ {
  int G, c;
  __device__ bool next(int i, pg8::Unit& u) const {
    const int L = i * G + c; if (L >= 199) return false;
    if (L < 192) { u.pm = L / 3; u.pn = L % 3; } else { u.pm = 64; u.pn = L - 192; }
    u.kk = 0; return true;
  }
  __device__ __forceinline__ void a_ready(const pg8::Unit&) const {}
  __device__ __forceinline__ void done(const pg8::Unit&) const {}
};
struct EpiBf16 {
  static constexpr bool PERM = true, AFTER_DRAIN = false;
  bf16* O; int ldc; int split_cols; size_t split_stride;
  __device__ __forceinline__ void operator()(const pg8::f32x4 (&acc)[2][2][4][2], const pg8::Unit& u, int wr, int wc, int fr, int fq) const {
    const int row0 = u.pm * 256 + wr * 64 + fr; int colt = u.pn * 256; bf16* base = O;
    if (split_cols) { const int t = colt / split_cols; base += (size_t)t * split_stride; colt -= t * split_cols; }
    const int col0 = colt + wc * 32 + 8 * fq;
#pragma unroll
    for (int ai = 0; ai < 2; ++ai)
#pragma unroll
      for (int m = 0; m < 4; ++m) { bf16* rowp = base + (size_t)(row0 + ai * 128 + m * 16) * ldc + col0;
#pragma unroll
        for (int bj = 0; bj < 2; ++bj) { const pg8::f32x4 v0 = acc[ai][bj][m][0], v1 = acc[ai][bj][m][1];
          v4u w; w.x = pg8::cvt_pk_bf16(v0[0], v0[1]); w.y = pg8::cvt_pk_bf16(v0[2], v0[3]); w.z = pg8::cvt_pk_bf16(v1[0], v1[1]); w.w = pg8::cvt_pk_bf16(v1[2], v1[3]);
          *(v4u*)(rowp + bj * 128) = w; } }
  }
};
struct EpiKV {
  static constexpr bool PERM = true, AFTER_DRAIN = false;
  bf16* KC; bf16* VB;
  __device__ __forceinline__ void operator()(const pg8::f32x4 (&acc)[2][2][4][2], const pg8::Unit& u, int wr, int wc, int fr, int fq) const {
    const int row0 = u.pm * 256 + wr * 64 + fr; const int cin = wc * 32 + 8 * fq;
#pragma unroll
    for (int ai = 0; ai < 2; ++ai)
#pragma unroll
      for (int m = 0; m < 4; ++m) { const int row = row0 + ai * 128 + m * 16;
#pragma unroll
        for (int bj = 0; bj < 2; ++bj) { const pg8::f32x4 v0 = acc[ai][bj][m][0], v1 = acc[ai][bj][m][1];
          v4u w; w.x = pg8::cvt_pk_bf16(v0[0], v0[1]); w.y = pg8::cvt_pk_bf16(v0[2], v0[3]); w.z = pg8::cvt_pk_bf16(v1[0], v1[1]); w.w = pg8::cvt_pk_bf16(v1[2], v1[3]);
          if (u.pn < 2) *(v4u*)(KC + ((size_t)((row >> 11) * 4 + 2 * u.pn + bj) * T + (row & 2047)) * 200 + cin) = w;
          else *(v4u*)(VB + (size_t)row * 512 + (u.pn - 2) * 256 + bj * 128 + cin) = w; } }
  }
};
struct EpiUp {
  static constexpr bool PERM = true, AFTER_DRAIN = false;
  bf16* O; float* out;
  __device__ __forceinline__ void operator()(const pg8::f32x4 (&acc)[2][2][4][2], const pg8::Unit& u, int wr, int wc, int fr, int fq) const {
    const int row0 = u.pm * 256 + wr * 64 + fr; const int col0 = u.pn * 256 + wc * 32 + 8 * fq;
#pragma unroll
    for (int ai = 0; ai < 2; ++ai)
#pragma unroll
      for (int m = 0; m < 4; ++m) { const int row = row0 + ai * 128 + m * 16; bf16* rowp = O + (size_t)row * F2 + col0;
        float* cv = nullptr;
        if (row < MP) { const int t = row & 2047; if (t >= T - 2) cv = out + nv::OUT_CONVP + ((size_t)(row >> 11) * 2 + (t - (T - 2))) * F2 + col0; }
        else { const int t = (row - MP) & 7; if (t >= DT - 2) cv = out + nv::OUT_CONVS + ((size_t)((row - MP) >> 3) * 2 + (t - (DT - 2))) * F2 + col0; }
#pragma unroll
        for (int bj = 0; bj < 2; ++bj) { const pg8::f32x4 v0 = acc[ai][bj][m][0], v1 = acc[ai][bj][m][1];
          v4u w; w.x = pg8::cvt_pk_bf16(v0[0], v0[1]); w.y = pg8::cvt_pk_bf16(v0[2], v0[3]); w.z = pg8::cvt_pk_bf16(v1[0], v1[1]); w.w = pg8::cvt_pk_bf16(v1[2], v1[3]);
          *(v4u*)(rowp + bj * 128) = w;
          if (cv) { *(pg8::f32x4*)(cv + bj * 128) = v0; *(pg8::f32x4*)(cv + bj * 128 + 4) = v1; } } }
  }
};
struct EpiF32 {
  static constexpr bool PERM = false, AFTER_DRAIN = false;
  float* C; int ldc;
  __device__ __forceinline__ void operator()(const pg8::f32x4 (&acc)[2][2][4][2], const pg8::Unit& u, int wr, int wc, int fr, int fq) const {
    const int row0 = u.pm * 256 + wr * 64 + fr, col0 = u.pn * 256 + wc * 32 + 4 * fq;
#pragma unroll
    for (int ai = 0; ai < 2; ++ai)
#pragma unroll
      for (int m = 0; m < 4; ++m) { float* rowp = C + (size_t)(row0 + ai * 128 + m * 16) * ldc + col0;
#pragma unroll
        for (int bj = 0; bj < 2; ++bj)
#pragma unroll
          for (int n = 0; n < 2; ++n) *(pg8::f32x4*)(rowp + bj * 128 + n * 16) = acc[ai][bj][m][n]; }
  }
};

struct SchedPart {
  int n, G, c;
  __device__ bool next(int i, pg8::Unit& u) const { const int L = i * G + c; if (L >= n) return false; u.pm = 64; u.pn = L & 3; u.kk = L >> 2; return true; }
  __device__ __forceinline__ void a_ready(const pg8::Unit&) const {}
  __device__ __forceinline__ void done(const pg8::Unit&) const {}
};
struct EpiPart {
  static constexpr bool PERM = false, AFTER_DRAIN = false;
  float* P;
  __device__ __forceinline__ void operator()(const pg8::f32x4 (&acc)[2][2][4][2], const pg8::Unit& u, int wr, int wc, int fr, int fq) const {
    const int row0 = wr * 64 + fr, col0 = u.pn * 256 + wc * 32 + 4 * fq; float* base = P + (size_t)u.kk * 256 * 1024;
#pragma unroll
    for (int ai = 0; ai < 2; ++ai)
#pragma unroll
      for (int m = 0; m < 4; ++m) { float* rowp = base + (size_t)(row0 + ai * 128 + m * 16) * 1024 + col0;
#pragma unroll
        for (int bj = 0; bj < 2; ++bj)
#pragma unroll
          for (int n = 0; n < 2; ++n) *(pg8::f32x4*)(rowp + bj * 128 + n * 16) = acc[ai][bj][m][n]; }
  }
};

__device__ __forceinline__ float gelu_tanh_f(float x) { const float y = 0.7978845608028654f * (x + 0.044715f * x * x * x); const float th = 1.f - 2.f / (1.f + __expf(2.f * y)); return 0.5f * x * (1.f + th); }
__device__ __forceinline__ void ld8bf(const bf16* p, float (&v)[8]) { const v4u x = *(const v4u*)p;
  v[0] = bflo(x.x); v[1] = bfhi(x.x); v[2] = bflo(x.y); v[3] = bfhi(x.y); v[4] = bflo(x.z); v[5] = bfhi(x.z); v[6] = bflo(x.w); v[7] = bfhi(x.w); }
__device__ __forceinline__ void ld8f(const float* p, float (&v)[8]) { const f32x4 a = *(const f32x4*)p, b = *(const f32x4*)(p + 4);
  v[0] = a.x; v[1] = a.y; v[2] = a.z; v[3] = a.w; v[4] = b.x; v[5] = b.y; v[6] = b.z; v[7] = b.w; }
constexpr int P10_ROWS = 45;
__device__ __forceinline__ void p10_convgelu(const Frame& F) {
  const int gt = F.bid * NTHR + F.tid; const int fg = gt % 352, chunk = gt / 352, f = fg * 8;
  const int rbeg = chunk * P10_ROWS; if (rbeg >= MT) return; const int rend = rbeg + P10_ROWS < MT ? rbeg + P10_ROWS : MT;
  float w[2][3][8], bias[2][8], um2[2][8], um1[2][8];
#pragma unroll
  for (int half = 0; half < 2; ++half) { const int col = f + half * FF; ld8f(F.P->in.b_ffn_conv + col, bias[half]);
#pragma unroll
    for (int j = 0; j < 3; ++j) ld8f(F.P->in.w_ffn_conv + (size_t)j * F2 + col, w[half][j]); }
  auto seq_t = [](int r) { return r >= MP ? (r - MP) & 7 : r & 2047; };
  { const int t = seq_t(rbeg);
#pragma unroll
    for (int half = 0; half < 2; ++half) { const int col = f + half * FF;
      if (t >= 2) { ld8bf(F.u() + (size_t)(rbeg - 2) * F2 + col, um2[half]); ld8bf(F.u() + (size_t)(rbeg - 1) * F2 + col, um1[half]); }
      else if (t == 1) { ld8bf(F.u() + (size_t)(rbeg - 1) * F2 + col, um1[half]);
        if (rbeg >= MP) ld8f(F.P->in.state_conv + ((size_t)((rbeg - MP) >> 3) * 2 + 1) * F2 + col, um2[half]);
        else {
#pragma unroll
          for (int e = 0; e < 8; ++e) um2[half][e] = 0.f; } }
      else {
#pragma unroll
        for (int e = 0; e < 8; ++e) { um2[half][e] = 0.f; um1[half][e] = 0.f; } } } }
#pragma unroll 3
  for (int r = rbeg; r < rend; ++r) {
    float uc[2][8], cur[2][8];
#pragma unroll
    for (int half = 0; half < 2; ++half) ld8bf(F.u() + (size_t)r * F2 + f + half * FF, cur[half]);
    if (seq_t(r) == 0) {
#pragma unroll
      for (int half = 0; half < 2; ++half) { const int col = f + half * FF;
        if (r >= MP) { const float* sc = F.P->in.state_conv + (size_t)((r - MP) >> 3) * 2 * F2 + col; ld8f(sc, um2[half]); ld8f(sc + F2, um1[half]); }
        else {
#pragma unroll
          for (int e = 0; e < 8; ++e) { um2[half][e] = 0.f; um1[half][e] = 0.f; } } } }
#pragma unroll
    for (int half = 0; half < 2; ++half)
#pragma unroll
      for (int e = 0; e < 8; ++e) { uc[half][e] = bias[half][e] + w[half][0][e] * um2[half][e] + w[half][1][e] * um1[half][e] + w[half][2][e] * cur[half][e]; um2[half][e] = um1[half][e]; um1[half][e] = cur[half][e]; }
    v4u o;
    o.x = pk2(uc[0][0] * gelu_tanh_f(uc[1][0]), uc[0][1] * gelu_tanh_f(uc[1][1])); o.y = pk2(uc[0][2] * gelu_tanh_f(uc[1][2]), uc[0][3] * gelu_tanh_f(uc[1][3]));
    o.z = pk2(uc[0][4] * gelu_tanh_f(uc[1][4]), uc[0][5] * gelu_tanh_f(uc[1][5])); o.w = pk2(uc[0][6] * gelu_tanh_f(uc[1][6]), uc[0][7] * gelu_tanh_f(uc[1][7]));
    *(v4u*)(F.hmid() + (size_t)r * FF + f) = o;
  }
}

constexpr int N_PHASES = 13;
__global__ void __launch_bounds__(NTHR, 2) mega(Params prm) {
  extern __shared__ __attribute__((aligned(16))) unsigned char lds_raw[];
  Frame F;
  F.lds = (LAS unsigned char*)lds_raw;
  F.tid = threadIdx.x; F.lane = F.tid & 63; F.wave = __builtin_amdgcn_readfirstlane(F.tid >> 6); F.G = gridDim.x; F.bid = blockIdx.x;
  F.P = &prm;
  unsigned char* ws = prm.ws;
  volatile LAS unsigned* MISC = (volatile LAS unsigned*)(F.lds + MISC_OFF);
  for (int i = F.tid; i < (LDS_BYTES - LDSCTL_OFF) / 4; i += NTHR) ((LAS unsigned*)(F.lds + LDSCTL_OFF))[i] = 0u;
  __syncthreads();
  const int lo = prm.ph_lo, hi = prm.ph_hi;
  XcdBarrier bar; bar.bar = (unsigned*)(ws + W_CTL) + CW_BAR; bar.x = 0; bar.st = nullptr;
  if (hi - lo > 1) bar = xcd_barrier_post((unsigned*)(ws + W_CTL) + CW_BAR, MISC + 8);
#ifndef PHMASK
#define PHMASK 0x1fff
#endif
#define IN(k) ((((PHMASK) >> (k)) & 1) && lo <= (k) && (k) < hi)
#ifdef PROBE_A
#define STAMP(k) do { if (F.bid == 0 && F.tid == 0) __hip_atomic_store((unsigned long long*)(ws + W_CTL) + 1024 + (k), (unsigned long long)__builtin_amdgcn_s_memrealtime(), __ATOMIC_RELAXED, __HIP_MEMORY_SCOPE_AGENT); } while (0)
#else
#define STAMP(k) do {} while (0)
#endif
#define SEAM(k) do { if (IN(k) && IN((k) + 1)) xcd_barrier(bar); STAMP((k) + 1); } while (0)
  const int gw = F.bid * NWAVES + F.wave, NGW = F.G * NWAVES;
  LAS unsigned char* ring = F.lds;

  STAMP(0);
  if (IN(0)) { p0_prologue(F); } SEAM(0);
  if (IN(1)) { p1_xn(F); } SEAM(1);
  if (IN(2)) {
    pg8::Gemm g{F.xn(), F.win_t(), 1024, 1024, 1024}; StaticOrder S; S.init(65, 9, F.G, F.bid);
    EpiBf16 E{F.z(), ZW, 0, 0};
    pg8::gemm_phase<EpiBf16, StaticOrder, true, true>(ring, g, S, E);
  } SEAM(2);
  if (IN(3)) {
    for (int u = F.bid; u < 384; u += F.G) { if (u < 256) gla_prep_unit(F, u >> 5, u & 31); else gla_sample_unit(F, (u - 256) >> 2, (u - 256) & 3); }
    for (int r = gw; r < MT; r += NGW) p3_row(F, r);
  } SEAM(3);
  if (IN(4)) {
#if !defined(SUB) || SUB == 1
    { pg8::Gemm g{F.cqn(), F.wq_t(), 384, 384, 384}; SchedQ S{F.G, F.bid}; EpiBf16 E{F.qbuf(), QW, 0, 0};
      pg8::gemm_phase<EpiBf16, SchedQ, true, true>(ring, g, S, E); }
#endif
#if !defined(SUB) || SUB == 2
    { pg8::Gemm g{F.latb(), F.wkv_t(), 256, 256, 256}; StaticOrder S; S.init(64, 4, F.G, F.bid); EpiKV E{F.kcomb(), F.vb()};
      pg8::gemm_phase<EpiKV, StaticOrder, true, true>(ring, g, S, E); }
#endif
#if !defined(SUB) || SUB == 3
    for (int it = gw; it < 2048; it += NGW) gla_passA_item(F, it);
#endif
  } SEAM(4);
  if (IN(5)) {
#if !defined(SUB) || SUB == 4
    gla_passB(F);
#endif
    { gu32* head = (gu32*)(ws + W_CTL) + CW_Q5; constexpr int ND = DB * NSPLIT, NU = ND + 256;
      for (;;) {
        __syncthreads();
        if (F.tid == 0) MISC[16] = __hip_atomic_fetch_add(head, 1u, RLX_AGENT);
        __syncthreads();
        const int idx = (int)MISC[16];
        if (idx >= NU) break;
        if (idx < ND) { if (prm.pad != 2) dattn_unit(F, idx / NSPLIT, idx % NSPLIT); }
        else if (prm.pad != 1) { const int p = idx - ND; const int bh = p & 31; pattn_unit(F, bh >> 2, bh & 3, 7 - (p >> 5)); }
      } }
  } SEAM(5);
  if (IN(6)) {
    for (int b = F.bid; b < DB; b += F.G) dcombine_unit(F, b);
    for (int it = gw; it < 2048; it += NGW) gla_passC_item(F, it);
  } SEAM(6);
  if (IN(7)) {
    { pg8::Gemm g{F.mixin(), F.wo_t(), 1024, 1024, 1024}; StaticOrder S; S.init(64, 4, F.G, F.bid); EpiF32 E{F.mix(), 1024};
      pg8::gemm_phase<EpiF32, StaticOrder, true, true>(ring, g, S, E); }
    { pg8::Gemm g{F.mixin(), F.wo_t(), 1024, 1024, 256}; SchedPart S{16, F.G, F.bid}; EpiPart E{F.mixp()};
      pg8::gemm_phase<EpiPart, SchedPart, true, true>(ring, g, S, E); }
  } SEAM(7);
  if (IN(8)) { p8_all(F); } SEAM(8);
  if (IN(9)) {
    pg8::Gemm g{F.xn(), F.wup_t(), 1024, 1024, 1024}; StaticOrder S; S.init(65, 22, F.G, F.bid); EpiUp E{F.u(), F.P->out};
    pg8::gemm_phase<EpiUp, StaticOrder, true, true>(ring, g, S, E);
  } SEAM(9);
  if (IN(10)) { p10_convgelu(F); } SEAM(10);
  if (IN(11)) {
    { pg8::Gemm g{F.hmid(), F.wdn_t(), FF, FF, FF}; StaticOrder S; S.init(64, 4, F.G, F.bid); EpiF32 E{F.mix(), 1024};
      pg8::gemm_phase<EpiF32, StaticOrder, true, true>(ring, g, S, E); }
    { pg8::Gemm g{F.hmid(), F.wdn_t(), FF, FF, 256}; SchedPart S{44, F.G, F.bid}; EpiPart E{F.mixp()};
      pg8::gemm_phase<EpiPart, SchedPart, true, true>(ring, g, S, E); }
  } SEAM(11);
  if (IN(12)) { p12_all(F); }
#undef IN
#undef SEAM
}
}
#ifndef DIAG
#define DIAG 1
#endif
#ifndef REPMASK
#define REPMASK 0
#endif
#ifndef PROBE_SUB
#define PROBE_SUB 0
#endif
#ifndef DIAG_PH
#define DIAG_PH 13
#endif
namespace dg {
constexpr int NCHK = 32;
struct Tol { float t[NCHK]; };
__global__ void k_cmp(const float* ref, long ref_ld, const void* tst, int tst_bf16, long tst_ld, int rows, int cols, float* acc) {
  __shared__ float red[16];
  float num = 0.f, den = 0.f; const long n = (long)rows * cols;
  for (long i = (long)blockIdx.x * blockDim.x + threadIdx.x; i < n; i += (long)gridDim.x * blockDim.x) { const long r = i / cols, c = i % cols;
    const float a = ref[r * ref_ld + c]; const float b = tst_bf16 ? fz::bf2f(((const unsigned short*)tst)[r * tst_ld + c]) : ((const float*)tst)[r * tst_ld + c];
    num += (a - b) * (a - b); den += a * a; }
  num = nv::block_sum(num, red); den = nv::block_sum(den, red);
  if (threadIdx.x == 0) { atomicAdd(acc, num); atomicAdd(acc + 1, den); }
}
__global__ void k_report(const float* acc, float* out, Tol tol, float* code) {
  __shared__ int sidx; __shared__ float serr;
  if (threadIdx.x == 0) { int idx = 0; float err = 0.f;
    for (int i = 1; i < NCHK; ++i) { const float num = acc[2 * i], den = acc[2 * i + 1]; if (den == 0.f && num == 0.f) continue; const float e = sqrtf(num / den); if (!(e <= tol.t[i])) { idx = i; err = e; break; } }
    sidx = idx; serr = err; }
  __syncthreads();
  const int idx = sidx; if (idx == 0) return;
  float e = serr; if (!(e >= 0.1f)) e = 0.1f; if (!(e <= 2.f)) e = 2.f; if (serr != serr) e = 2.f;
  for (long i = (long)blockIdx.x * blockDim.x + threadIdx.x; i < (long)nv::MP * nv::D; i += (long)gridDim.x * blockDim.x) { float v = out[i] * (1.f + e); if (i == 0) v += 8.f * idx; out[i] = v; }
  if (blockIdx.x == 0 && threadIdx.x == 0) { code[0] = (float)idx; code[1] = serr; }
}
}

extern "C" void kernel_launch(void* const* d_in, const int* in_sizes, int n_in, void* d_out, int out_size, void* d_ws, size_t ws_size, hipStream_t stream) {
  static int grid = 0;
  if (grid == 0) {
    int dev = 0, cus = 0;
    if (hipGetDevice(&dev) != hipSuccess || hipDeviceGetAttribute(&cus, hipDeviceAttributeMultiprocessorCount, dev) != hipSuccess) { grid = -1; return; }
    if (hipFuncSetAttribute((const void*)fz::mega, hipFuncAttributeMaxDynamicSharedMemorySize, fz::LDS_BYTES) != hipSuccess) { fprintf(stderr, "hipFuncSetAttribute failed\n"); grid = -1; return; }
    int per_cu = 0; (void)hipOccupancyMaxActiveBlocksPerMultiprocessor(&per_cu, (const void*)fz::mega, fz::NTHR, fz::LDS_BYTES); (void)hipGetLastError();
    grid = cus;
    if (per_cu < 1) fprintf(stderr, "occupancy query reports %d\n", per_cu);
  }
  if (grid < 0) return;
  nv::In in = nv::make_in(d_in);
  if ((size_t)out_size != nv::OUT_END) { fprintf(stderr, "bad out size\n"); return; }
#if DIAG
  nv::Ws w = nv::carve((float*)d_ws);
  unsigned char* fws = (unsigned char*)d_ws + ((w.end_floats * 4 + 255) & ~(size_t)255);
  float* out2 = (float*)(fws + fz::W_END); float* acc = out2 + ((nv::OUT_END + 63) & ~(size_t)63);
  const size_t need = (size_t)((unsigned char*)(acc + 256) - (unsigned char*)d_ws);
  if (need > ws_size) { fprintf(stderr, "ws too small: need %zu have %zu\n", need, ws_size); return; }
  (void)hipMemsetAsync(fws + fz::W_CTL, 0, fz::CTL_BYTES, stream);
  (void)hipMemsetAsync(acc, 0, 256 * 4, stream);
  nv::run(stream, in, w, (float*)d_out);
  fz::Params p{}; p.in = in; p.out = out2; p.ws = fws; p.ph_lo = 0; p.ph_hi = DIAG_PH;
  void* args[] = {&p};
  hipError_t e = hipLaunchCooperativeKernel((const void*)fz::mega, dim3(grid), dim3(fz::NTHR), args, fz::LDS_BYTES, stream);
  if (e != hipSuccess) { fprintf(stderr, "coop launch failed: %s\n", hipGetErrorString(e)); return; }
  using namespace fz; using namespace nv;
  auto cmp = [&](int idx, int ph, const float* ref, long ref_ld, const void* tst, int isbf, long tst_ld, int rows, int cols) {
    if (DIAG_PH <= ph) return;
    hipLaunchKernelGGL(dg::k_cmp, dim3(512), dim3(256), 0, stream, ref, ref_ld, tst, isbf, tst_ld, rows, cols, acc + 2 * idx); };
  const float* dout = (const float*)d_out;
  bf16* Z = (bf16*)(fws + W_Z); bf16* XN = (bf16*)(fws + W_XN); bf16* MIXIN = (bf16*)(fws + W_MIXIN); bf16* QB = (bf16*)(fws + W_QBUF);
  cmp(1, 0, w.mod, 6144, fws + W_MOD, 0, 6144, 40, 6144);
  if (DIAG_PH <= 8) cmp(2, 1, w.h, 1024, XN, 1, 1024, MT, 1024);
  cmp(3, 2, w.z, INC, Z, 1, ZW, MT, 1536);
  cmp(3, 2, w.z + O_GR, INC, Z + ZC_GR, 1, ZW, MT, 16);
  cmp(3, 2, w.z + O_CQ, INC, Z + ZC_CQ, 1, ZW, MT, 384);
  cmp(3, 2, w.z + O_CKV, INC, Z + ZC_CKV, 1, ZW, MT, 256);
  cmp(3, 2, w.z + O_KR, INC, Z + ZC_KR, 1, ZW, MT, 64);
  cmp(4, 3, w.cqn, 384, fws + W_CQN, 1, 384, MT, 384);
  cmp(5, 3, w.kcat, 320, fws + W_LATB, 1, 256, MT, 256);
  cmp(6, 3, w.kcat + 256, 320, fws + W_KRB, 1, 64, MT, 64);
  cmp(7, 3, dout + OUT_LATP, 256, out2 + OUT_LATP, 0, 256, MP, 256);
  cmp(8, 3, dout + OUT_KRP, 64, out2 + OUT_KRP, 0, 64, MP, 64);
  cmp(9, 3, dout + OUT_LATS, 256, out2 + OUT_LATS, 0, 256, MS, 256);
  cmp(10, 3, dout + OUT_KRS, 64, out2 + OUT_KRS, 0, 64, MS, 64);
  cmp(11, 3, w.mixin + (size_t)MP * 1024, 1024, MIXIN + (size_t)MP * 1024, 1, 1024, MS, 512);
  cmp(12, 3, dout + OUT_GLAS, 128, out2 + OUT_GLAS, 0, 128, DB * 4 * 64, 128);
  cmp(13, 4, w.qb, 768, QB, 1, QW, MT, 768);
  for (int h = 0; h < 4; ++h) cmp(14, 4, w.qcat + (size_t)MP * 1280 + h * 320, 1280, QB + (size_t)MP * QW + 768 + h * 256, 1, QW, MS, 256);
  cmp(15, 5, dout + OUT_GLAP, 128, out2 + OUT_GLAP, 0, 128, NB * 4 * 64, 128);
  cmp(16, 5, w.mixin + 512, 1024, MIXIN + 512, 1, 1024, MP, 512);
  cmp(17, 6, w.mixin + (size_t)MP * 1024 + 512, 1024, MIXIN + (size_t)MP * 1024 + 512, 1, 1024, MS, 512);
  cmp(18, 6, w.mixin, 1024, MIXIN, 1, 1024, MP, 512);
  if (DIAG_PH <= 11) cmp(19, 7, w.mix, 1024, fws + W_MIX, 0, 1024, MT, 1024);
  cmp(20, 8, w.x1, 1024, fws + W_X1, 0, 1024, MT, 1024);
  cmp(21, 8, w.h2, 1024, XN, 1, 1024, MT, 1024);
  cmp(22, 9, w.u, F2, fws + W_U, 1, F2, MT, F2);
  cmp(23, 9, dout + OUT_CONVP, F2, out2 + OUT_CONVP, 0, F2, NB * 2, F2);
  cmp(24, 9, dout + OUT_CONVS, F2, out2 + OUT_CONVS, 0, F2, DB * 2, F2);
  cmp(25, 10, w.hmid, FF, fws + W_HMID, 1, FF, MT, FF);
  cmp(26, 11, w.y, 1024, fws + W_MIX, 0, 1024, MT, 1024);
  cmp(27, 12, dout + OUT_YP, 1024, out2 + OUT_YP, 0, 1024, MP, 1024);
  cmp(28, 12, dout + OUT_YS, 1024, out2 + OUT_YS, 0, 1024, MS, 1024);
  dg::Tol tol; for (int i = 0; i < dg::NCHK; ++i) tol.t[i] = 0.02f; tol.t[1] = 1e-3f; tol.t[27] = 0.01f; tol.t[28] = 0.01f;
  hipLaunchKernelGGL(dg::k_report, dim3(512), dim3(256), 0, stream, (const float*)acc, (float*)d_out, tol, acc + 128);
#else
  (void)hipMemsetAsync((unsigned char*)d_ws + fz::W_CTL, 0, fz::CTL_BYTES, stream);
  fz::Params p{}; p.in = in; p.out = (float*)d_out; p.ws = (unsigned char*)d_ws; p.ph_lo = 0; p.ph_hi = fz::N_PHASES; p.repmask = REPMASK;
  void* args[] = {&p};
  hipError_t e = hipLaunchCooperativeKernel((const void*)fz::mega, dim3(grid), dim3(fz::NTHR), args, fz::LDS_BYTES, stream);
  if (e != hipSuccess) fprintf(stderr, "coop launch failed: %s\n", hipGetErrorString(e));
  for (int k = 0; k < fz::N_PHASES; ++k) if ((REPMASK >> k) & 1) {
    (void)hipMemsetAsync((unsigned char*)d_ws + fz::W_CTL, 0, 4096, stream);
    fz::Params q = p; q.ph_lo = k; q.ph_hi = k + 1; q.pad = PROBE_SUB; void* a2[] = {&q};
    (void)hipLaunchCooperativeKernel((const void*)fz::mega, dim3(grid), dim3(fz::NTHR), a2, fz::LDS_BYTES, stream); }
#endif
}
```

```cpp
#include <hip/hip_runtime.h>
#include <cstdio>
#include <cmath>
#include <cstdint>
#define DIAG 0
#define DIAG_PH 13
namespace nv {
constexpr int D = 1024, NB = 8, T = 2048, DB = 32, DT = 8, MP = NB * T, MS = DB * DT, MT = MP + MS;
constexpr int INC = 2256, FF = 2816, F2 = 5632, PAST = 16384, NPG = 128;
constexpr int O_QA = 0, O_KA = 256, O_VA = 512, O_RA = 1024, O_GR = 1536, O_CQ = 1552, O_CKV = 1936, O_KR = 2192;
constexpr size_t OUT_YP = 0, OUT_YS = OUT_YP + (size_t)MP * D, OUT_LATP = OUT_YS + (size_t)MS * D, OUT_KRP = OUT_LATP + (size_t)MP * 256,
                 OUT_GLAP = OUT_KRP + (size_t)MP * 64, OUT_CONVP = OUT_GLAP + (size_t)NB * 4 * 64 * 128, OUT_LATS = OUT_CONVP + (size_t)NB * 2 * F2,
                 OUT_KRS = OUT_LATS + (size_t)MS * 256, OUT_GLAS = OUT_KRS + (size_t)MS * 64, OUT_CONVS = OUT_GLAS + (size_t)DB * 4 * 64 * 128,
                 OUT_END = OUT_CONVS + (size_t)DB * 2 * F2;

struct In {
  const float *x_p, *x_s, *c_p, *c_s, *cache_lat, *cache_kr, *state_gla, *state_conv; const int* page_table;
  const float *w_ada, *b_ada, *g_pre_mix, *g_post_mix, *g_pre_ffn, *g_post_ffn, *w_in, *w_gla_a2, *b_gla_a, *g_gla_out, *g_mla_q, *g_mla_kv,
      *w_mla_uq, *w_mla_uk, *w_mla_uv, *g_mla_out, *w_o, *w_ffn_up, *w_ffn_conv, *b_ffn_conv, *w_ffn_down;
};
__host__ inline In make_in(void* const* d) {
  In i;
  i.x_p = (const float*)d[0]; i.x_s = (const float*)d[1]; i.c_p = (const float*)d[2]; i.c_s = (const float*)d[3]; i.cache_lat = (const float*)d[4];
  i.cache_kr = (const float*)d[5]; i.state_gla = (const float*)d[6]; i.state_conv = (const float*)d[7]; i.page_table = (const int*)d[8];
  i.w_ada = (const float*)d[9]; i.b_ada = (const float*)d[10]; i.g_pre_mix = (const float*)d[11]; i.g_post_mix = (const float*)d[12];
  i.g_pre_ffn = (const float*)d[13]; i.g_post_ffn = (const float*)d[14]; i.w_in = (const float*)d[15]; i.w_gla_a2 = (const float*)d[16];
  i.b_gla_a = (const float*)d[17]; i.g_gla_out = (const float*)d[18]; i.g_mla_q = (const float*)d[19]; i.g_mla_kv = (const float*)d[20];
  i.w_mla_uq = (const float*)d[21]; i.w_mla_uk = (const float*)d[22]; i.w_mla_uv = (const float*)d[23]; i.g_mla_out = (const float*)d[24];
  i.w_o = (const float*)d[25]; i.w_ffn_up = (const float*)d[26]; i.w_ffn_conv = (const float*)d[27]; i.b_ffn_conv = (const float*)d[28];
  i.w_ffn_down = (const float*)d[29];
  return i;
}
__device__ __forceinline__ int row_cond(int r) { return r < MP ? r / T : NB + (r - MP) / DT; }
__device__ __forceinline__ int row_pos(int r) { return r < MP ? r % T : PAST + (r - MP) % DT; }
__device__ __forceinline__ const float* row_x(const In& in, int r) { return r < MP ? in.x_p + (size_t)r * D : in.x_s + (size_t)(r - MP) * D; }
__device__ __forceinline__ float silu_f(float v) { return v / (1.f + expf(-v)); }
__device__ __forceinline__ float block_sum(float v, float* red) {
  for (int o = 32; o; o >>= 1) v += __shfl_xor(v, o);
  __syncthreads();
  if ((threadIdx.x & 63) == 0) red[threadIdx.x >> 6] = v;
  __syncthreads();
  float s = 0.f; for (int i = 0; i < (int)(blockDim.x >> 6); ++i) s += red[i];
  return s;
}
__global__ void k_mod(In in, float* mod) {
  const int n = blockIdx.x * 256 + threadIdx.x, r = blockIdx.y;
  const float* c = r < NB ? in.c_p + (size_t)r * D : in.c_s + (size_t)(r - NB) * D;
  float a = in.b_ada[n];
  for (int k = 0; k < D; ++k) a += silu_f(c[k]) * in.w_ada[(size_t)k * 6144 + n];
  mod[(size_t)r * 6144 + n] = a;
}
__global__ void k_norm_mod(In in, const float* src, const float* g, const float* mod, int sh_off, int sc_off, float* out) {
  __shared__ float red[16];
  const int r = blockIdx.x; const float* x = src ? src + (size_t)r * D : row_x(in, r);
  float s = 0.f; for (int k = threadIdx.x; k < D; k += blockDim.x) s += x[k] * x[k];
  s = block_sum(s, red); const float rs = rsqrtf(s / D + 1e-6f);
  const float* m = mod + (size_t)row_cond(r) * 6144;
  for (int k = threadIdx.x; k < D; k += blockDim.x) out[(size_t)r * D + k] = x[k] * rs * g[k] * (1.f + m[sc_off + k]) + m[sh_off + k];
}
struct GemmP { const float* A; const float* B; float* C; int M, N, K, sam, sbk, sbn, ldc, nb2; long sA1, sA2, sB1, sB2, sC1, sC2; };
__global__ void __launch_bounds__(256) k_sgemm(GemmP p) {
  __shared__ float As[16][65], Bs[16][65];
  const int z1 = blockIdx.z / p.nb2, z2 = blockIdx.z % p.nb2;
  const float* A = p.A + z1 * p.sA1 + z2 * p.sA2; const float* B = p.B + z1 * p.sB1 + z2 * p.sB2; float* C = p.C + z1 * p.sC1 + z2 * p.sC2;
  const int m0 = blockIdx.y * 64, n0 = blockIdx.x * 64, tx = threadIdx.x & 15, ty = threadIdx.x >> 4;
  float acc[4][4] = {};
  for (int k0 = 0; k0 < p.K; k0 += 16) {
    for (int i = threadIdx.x; i < 1024; i += 256) {
      { const int m = i >> 4, k = i & 15; As[k][m] = (m0 + m < p.M) ? A[(size_t)(m0 + m) * p.sam + k0 + k] : 0.f; }
      { int k, n; if (p.sbn == 1) { k = i >> 6; n = i & 63; } else { n = i >> 4; k = i & 15; }
        Bs[k][n] = (n0 + n < p.N) ? B[(size_t)(k0 + k) * p.sbk + (size_t)(n0 + n) * p.sbn] : 0.f; }
    }
    __syncthreads();
#pragma unroll
    for (int k = 0; k < 16; ++k) {
      float a[4], b[4];
#pragma unroll
      for (int i = 0; i < 4; ++i) { a[i] = As[k][ty * 4 + i]; b[i] = Bs[k][tx * 4 + i]; }
#pragma unroll
      for (int i = 0; i < 4; ++i)
#pragma unroll
        for (int j = 0; j < 4; ++j) acc[i][j] += a[i] * b[j];
    }
    __syncthreads();
  }
  for (int i = 0; i < 4; ++i) for (int j = 0; j < 4; ++j) { const int m = m0 + ty * 4 + i, n = n0 + tx * 4 + j; if (m < p.M && n < p.N) C[(size_t)m * p.ldc + n] = acc[i][j]; }
}
inline void sgemm(hipStream_t st, const float* A, const float* B, float* C, int M, int N, int K, int sam, int sbk, int sbn, int ldc,
                  int nb1 = 1, int nb2 = 1, long sA1 = 0, long sA2 = 0, long sB1 = 0, long sB2 = 0, long sC1 = 0, long sC2 = 0) {
  GemmP p{A, B, C, M, N, K, sam, sbk, sbn, ldc, nb2, sA1, sA2, sB1, sB2, sC1, sC2};
  hipLaunchKernelGGL(k_sgemm, dim3((N + 63) / 64, (M + 63) / 64, nb1 * nb2), dim3(256), 0, st, p);
}
__device__ __forceinline__ void rope_cs(int pos, int i, float& c, float& s) {
  const float inv = powf(10000.0f, -(float)(2 * i) / 64.0f); const float ang = (float)pos * inv; c = cosf(ang); s = sinf(ang);
}
__global__ void k_zpost(In in, const float* z, float* cqn, float* kcat, float* loga, float* out) {
  __shared__ float red[16];
  const int r = blockIdx.x, t = threadIdx.x; const float* zr = z + (size_t)r * INC;
  { float s = 0.f; for (int k = t; k < 384; k += 256) s += zr[O_CQ + k] * zr[O_CQ + k];
    s = block_sum(s, red); const float rs = rsqrtf(s / 384.f + 1e-6f);
    for (int k = t; k < 384; k += 256) cqn[(size_t)r * 384 + k] = zr[O_CQ + k] * rs * in.g_mla_q[k]; }
  { const float v = zr[O_CKV + t]; float s = block_sum(v * v, red); const float rs = rsqrtf(s / 256.f + 1e-6f);
    const float o = v * rs * in.g_mla_kv[t]; kcat[(size_t)r * 320 + t] = o;
    if (r < MP) out[OUT_LATP + (size_t)r * 256 + t] = o; else out[OUT_LATS + (size_t)(r - MP) * 256 + t] = o; }
  if (t < 32) { float c, s; rope_cs(row_pos(r), t, c, s); const float x1 = zr[O_KR + t], x2 = zr[O_KR + 32 + t];
    const float o1 = x1 * c - x2 * s, o2 = x1 * s + x2 * c; kcat[(size_t)r * 320 + 256 + t] = o1; kcat[(size_t)r * 320 + 288 + t] = o2;
    float* ko = r < MP ? out + OUT_KRP + (size_t)r * 64 : out + OUT_KRS + (size_t)(r - MP) * 64; ko[t] = o1; ko[32 + t] = o2; }
  { float a = in.b_gla_a[t]; for (int j = 0; j < 16; ++j) a += zr[O_GR + j] * in.w_gla_a2[j * 256 + t];
    const float ls = fminf(a, 0.f) - log1pf(expf(-fabsf(a)));
    loga[(size_t)r * 256 + t] = ls / 16.f; }
}
__global__ void k_qrope(const float* qb, float* qcat) {
  const int r = blockIdx.x, h = threadIdx.x >> 5, i = threadIdx.x & 31;
  float c, s; rope_cs(row_pos(r), i, c, s);
  const float x1 = qb[(size_t)r * 768 + h * 192 + 128 + i], x2 = qb[(size_t)r * 768 + h * 192 + 160 + i];
  qcat[(size_t)r * 1280 + h * 320 + 256 + i] = x1 * c - x2 * s; qcat[(size_t)r * 1280 + h * 320 + 288 + i] = x1 * s + x2 * c;
}
__global__ void k_softmax_causal(float* S, float scale) {
  __shared__ float red[16];
  const int t = blockIdx.x; float* row = S + ((size_t)blockIdx.y * T + t) * T;
  float m = -INFINITY; for (int s = threadIdx.x; s <= t; s += blockDim.x) m = fmaxf(m, row[s] * scale);
  for (int o = 32; o; o >>= 1) m = fmaxf(m, __shfl_xor(m, o));
  __syncthreads(); if ((threadIdx.x & 63) == 0) red[threadIdx.x >> 6] = m; __syncthreads();
  for (int i = 0; i < (int)(blockDim.x >> 6); ++i) m = fmaxf(m, red[i]);
  float sum = 0.f; for (int s = threadIdx.x; s < T; s += blockDim.x) { const float e = s <= t ? expf(row[s] * scale - m) : 0.f; row[s] = e; sum += e; }
  sum = block_sum(sum, red); const float inv = 1.f / sum;
  for (int s = threadIdx.x; s < T; s += blockDim.x) row[s] *= inv;
}
constexpr int NKEY = PAST + DT, NKEYP = PAST + 32;
__global__ void __launch_bounds__(256) k_dec_scores(In in, const float* qcat, const float* kcat, float* Ss) {
  __shared__ float Qs[32][320]; __shared__ float Ks[16][321];
  const int b = blockIdx.y, tile = blockIdx.x;
  for (int i = threadIdx.x; i < 32 * 320; i += 256) Qs[i / 320][i % 320] = qcat[(size_t)(MP + b * DT) * 1280 + i];
  const int nsub = tile < NPG ? 8 : 1;
  for (int sub = 0; sub < nsub; ++sub) {
    __syncthreads();
    for (int i = threadIdx.x; i < 16 * 320; i += 256) { const int k = i / 320, d = i % 320; float v;
      if (tile < NPG) { const int pg = in.page_table[b * NPG + tile], rw = sub * 16 + k;
        v = d < 256 ? in.cache_lat[((size_t)pg * 128 + rw) * 256 + d] : in.cache_kr[((size_t)pg * 128 + rw) * 64 + d - 256]; }
      else v = k < DT ? kcat[(size_t)(MP + b * DT + k) * 320 + d] : 0.f;
      Ks[k][d] = v; }
    __syncthreads();
    const int key = threadIdx.x & 15, rg = threadIdx.x >> 4; float a[2] = {0.f, 0.f};
    for (int d = 0; d < 320; ++d) { const float kv = Ks[key][d];
#pragma unroll
      for (int i = 0; i < 2; ++i) a[i] += kv * Qs[rg * 2 + i][d]; }
    const int j = tile * 128 + sub * 16 + key;
    for (int i = 0; i < 2; ++i) Ss[((size_t)b * 32 + rg * 2 + i) * NKEYP + j] = a[i];
  }
}
__global__ void k_dec_softmax(float* Ss, float scale) {
  __shared__ float red[16];
  const int rowi = blockIdx.x, tq = (rowi & 31) >> 2; float* row = Ss + (size_t)rowi * NKEYP; const int nk = PAST + tq + 1;
  float m = -INFINITY; for (int s = threadIdx.x; s < nk; s += blockDim.x) m = fmaxf(m, row[s] * scale);
  for (int o = 32; o; o >>= 1) m = fmaxf(m, __shfl_xor(m, o));
  __syncthreads(); if ((threadIdx.x & 63) == 0) red[threadIdx.x >> 6] = m; __syncthreads();
  for (int i = 0; i < (int)(blockDim.x >> 6); ++i) m = fmaxf(m, red[i]);
  float sum = 0.f; for (int s = threadIdx.x; s < NKEYP; s += blockDim.x) { const float e = s < nk ? expf(row[s] * scale - m) : 0.f; row[s] = e; sum += e; }
  sum = block_sum(sum, red); const float inv = 1.f / sum;
  for (int s = threadIdx.x; s < NKEYP; s += blockDim.x) row[s] *= inv;
}
__global__ void __launch_bounds__(256) k_dec_pv(In in, const float* Ss, const float* kcat, float* olat) {
  __shared__ float Ps[32][129];
  const int b = blockIdx.y, l = blockIdx.x * 64 + (threadIdx.x & 63), rg = threadIdx.x >> 6;
  float a[8] = {};
  for (int tile = 0; tile <= NPG; ++tile) {
    __syncthreads();
    for (int i = threadIdx.x; i < 32 * 128; i += 256) { const int r = i >> 7, k = i & 127, j = tile * 128 + k; Ps[r][k] = j < NKEYP ? Ss[((size_t)b * 32 + r) * NKEYP + j] : 0.f; }
    __syncthreads();
    const int nk = tile < NPG ? 128 : DT; const int pg = tile < NPG ? in.page_table[b * NPG + tile] : 0;
    for (int k = 0; k < nk; ++k) { const float v = tile < NPG ? in.cache_lat[((size_t)pg * 128 + k) * 256 + l] : kcat[(size_t)(MP + b * DT + k) * 320 + l];
#pragma unroll
      for (int i = 0; i < 8; ++i) a[i] += Ps[rg * 8 + i][k] * v; }
  }
  for (int i = 0; i < 8; ++i) { const int r = rg * 8 + i, t = r >> 2, h = r & 3; olat[((size_t)(MP + b * DT + t) * 4 + h) * 256 + l] = a[i]; }
}
__global__ void k_obnorm(In in, const float* ob, float* mixin) {
  const int r = blockIdx.x, h = threadIdx.x >> 6, l = threadIdx.x & 63;
  const float a = ob[(size_t)r * 512 + h * 128 + l], c = ob[(size_t)r * 512 + h * 128 + 64 + l];
  float s = a * a + c * c; for (int o = 32; o; o >>= 1) s += __shfl_xor(s, o);
  const float rs = rsqrtf(s / 128.f + 1e-6f);
  mixin[(size_t)r * D + 512 + h * 128 + l] = a * rs * in.g_mla_out[l]; mixin[(size_t)r * D + 512 + h * 128 + 64 + l] = c * rs * in.g_mla_out[64 + l];
}
__global__ void __launch_bounds__(512) k_gla(In in, const float* z, const float* loga, float* mixin, float* out) {
  __shared__ float part[4][128]; __shared__ float red[16];
  const int bh = blockIdx.x; const bool samp = bh >= NB * 4; const int b = samp ? (bh - NB * 4) >> 2 : bh >> 2, h = bh & 3;
  const int v = threadIdx.x & 127, kq = threadIdx.x >> 7; const int nt = samp ? DT : T; const int r0 = samp ? MP + b * DT : b * T;
  float S[16];
  for (int i = 0; i < 16; ++i) S[i] = samp ? in.state_gla[(((size_t)b * 4 + h) * 64 + kq * 16 + i) * 128 + v] : 0.f;
  for (int t = 0; t < nt; ++t) {
    const float* zr = z + (size_t)(r0 + t) * INC; const float* la = loga + (size_t)(r0 + t) * 256 + h * 64 + kq * 16;
    const float vv = zr[O_VA + h * 128 + v]; float o = 0.f;
    for (int i = 0; i < 16; ++i) { const int k = kq * 16 + i; S[i] = expf(la[i]) * S[i] + zr[O_KA + h * 64 + k] * vv; o += zr[O_QA + h * 64 + k] * 0.125f * S[i]; }
    part[kq][v] = o; __syncthreads();
    float ot = 0.f, sq = 0.f;
    if (kq == 0) { ot = part[0][v] + part[1][v] + part[2][v] + part[3][v]; sq = ot * ot; }
    sq = block_sum(sq, red);
    if (kq == 0) { const float rs = rsqrtf(sq / 128.f + 1e-6f); mixin[(size_t)(r0 + t) * D + h * 128 + v] = ot * rs * in.g_gla_out[v] * silu_f(zr[O_RA + h * 128 + v]); }
    __syncthreads();
  }
  float* so = samp ? out + OUT_GLAS : out + OUT_GLAP;
  for (int i = 0; i < 16; ++i) so[(((size_t)b * 4 + h) * 64 + kq * 16 + i) * 128 + v] = S[i];
}
__global__ void k_resid(In in, const float* xin, const float* y, const float* g, const float* mod, int gate_off, float* dst, float* out) {
  __shared__ float red[16];
  const int r = blockIdx.x; const float* x = xin ? xin + (size_t)r * D : row_x(in, r); const float* yr = y + (size_t)r * D;
  float s = 0.f; for (int k = threadIdx.x; k < D; k += blockDim.x) s += yr[k] * yr[k];
  s = block_sum(s, red); const float rs = rsqrtf(s / D + 1e-6f);
  const float* m = mod + (size_t)row_cond(r) * 6144 + gate_off;
  float* o = dst ? dst + (size_t)r * D : (r < MP ? out + OUT_YP + (size_t)r * D : out + OUT_YS + (size_t)(r - MP) * D);
  for (int k = threadIdx.x; k < D; k += blockDim.x) o[k] = x[k] + m[k] * yr[k] * rs * g[k];
}
__device__ __forceinline__ float gelu_tanh(float x) { return 0.5f * x * (1.f + tanhf(0.7978845608028654f * (x + 0.044715f * x * x * x))); }
__global__ void k_convgelu(In in, const float* u, float* hmid, float* out) {
  const int r = blockIdx.x; const bool samp = r >= MP; const int t = samp ? (r - MP) % DT : r % T, b = samp ? (r - MP) / DT : r / T;
  for (int f = threadIdx.x; f < FF; f += blockDim.x) {
    float uc[2];
    for (int half = 0; half < 2; ++half) { const int c = f + half * FF; float a = in.b_ffn_conv[c];
      for (int j = 0; j < 3; ++j) { const int tt = t - 2 + j; float val;
        if (tt >= 0) val = u[(size_t)(r - 2 + j) * F2 + c]; else val = samp ? in.state_conv[((size_t)b * 2 + (tt + 2)) * F2 + c] : 0.f;
        a += in.w_ffn_conv[j * F2 + c] * val; }
      uc[half] = a; }
    hmid[(size_t)r * FF + f] = uc[0] * gelu_tanh(uc[1]);
  }
  const int nt = samp ? DT : T;
  if (t >= nt - 2) { float* co = samp ? out + OUT_CONVS + ((size_t)b * 2 + (t - (nt - 2))) * F2 : out + OUT_CONVP + ((size_t)b * 2 + (t - (nt - 2))) * F2;
    for (int c = threadIdx.x; c < F2; c += blockDim.x) co[c] = u[(size_t)r * F2 + c]; }
}

struct Ws { float *mod, *h, *h2, *z, *cqn, *kcat, *loga, *qb, *qcat, *S, *olat, *ob, *mixin, *mix, *x1, *u, *hmid, *y, *Ss; size_t end_floats; };
inline Ws carve(float* base) {
  Ws w; size_t o = 0; auto take = [&](size_t n) { float* p = base + o; o += (n + 63) & ~(size_t)63; return p; };
  w.mod = take(40 * 6144); w.h = take((size_t)MT * D); w.h2 = take((size_t)MT * D); w.z = take((size_t)MT * INC); w.cqn = take((size_t)MT * 384); w.kcat = take((size_t)MT * 320);
  w.loga = take((size_t)MT * 256); w.qb = take((size_t)MT * 768); w.qcat = take((size_t)MT * 1280); w.S = take((size_t)4 * T * T);
  w.olat = take((size_t)MT * 1024); w.ob = take((size_t)MT * 512); w.mixin = take((size_t)MT * D); w.mix = take((size_t)MT * D); w.x1 = take((size_t)MT * D);
  w.u = take((size_t)MT * F2); w.hmid = take((size_t)MT * FF); w.y = take((size_t)MT * D); w.Ss = take((size_t)DB * 32 * NKEYP); w.end_floats = o;
  return w;
}

inline void run(hipStream_t st, const In& in, const Ws& w, float* out) {
  const float sc = 0.07216878364870322f;
  hipLaunchKernelGGL(k_mod, dim3(24, 40), dim3(256), 0, st, in, w.mod);
  hipLaunchKernelGGL(k_norm_mod, dim3(MT), dim3(256), 0, st, in, (const float*)nullptr, in.g_pre_mix, (const float*)w.mod, 0, 1024, w.h);
  sgemm(st, w.h, in.w_in, w.z, MT, INC, D, D, INC, 1, INC);
  hipLaunchKernelGGL(k_zpost, dim3(MT), dim3(256), 0, st, in, (const float*)w.z, w.cqn, w.kcat, w.loga, out);
  sgemm(st, w.cqn, in.w_mla_uq, w.qb, MT, 768, 384, 384, 768, 1, 768);
  hipLaunchKernelGGL(k_qrope, dim3(MT), dim3(128), 0, st, (const float*)w.qb, w.qcat);
  sgemm(st, w.qb, in.w_mla_uk, w.qcat, MT, 256, 128, 768, 1, 512, 1280, 1, 4, 0, 192, 0, 128, 0, 320);
  for (int b = 0; b < NB; ++b) {
    sgemm(st, w.qcat + (size_t)b * T * 1280, w.kcat + (size_t)b * T * 320, w.S, T, T, 320, 1280, 1, 320, T, 1, 4, 0, 320, 0, 0, 0, (long)T * T);
    hipLaunchKernelGGL(k_softmax_causal, dim3(T, 4), dim3(256), 0, st, w.S, sc);
    sgemm(st, w.S, w.kcat + (size_t)b * T * 320, w.olat + (size_t)b * T * 1024, T, 256, T, T, 320, 1, 1024, 1, 4, 0, (long)T * T, 0, 0, 0, 256);
  }
  hipLaunchKernelGGL(k_dec_scores, dim3(NPG + 1, DB), dim3(256), 0, st, in, (const float*)w.qcat, (const float*)w.kcat, w.Ss);
  hipLaunchKernelGGL(k_dec_softmax, dim3(DB * 32), dim3(256), 0, st, w.Ss, sc);
  hipLaunchKernelGGL(k_dec_pv, dim3(4, DB), dim3(256), 0, st, in, (const float*)w.Ss, (const float*)w.kcat, w.olat);
  sgemm(st, w.olat, in.w_mla_uv, w.ob, MT, 128, 256, 1024, 512, 1, 512, 1, 4, 0, 256, 0, 128, 0, 128);
  hipLaunchKernelGGL(k_obnorm, dim3(MT), dim3(256), 0, st, in, (const float*)w.ob, w.mixin);
  hipLaunchKernelGGL(k_gla, dim3(NB * 4 + DB * 4), dim3(512), 0, st, in, (const float*)w.z, (const float*)w.loga, w.mixin, out);
  sgemm(st, w.mixin, in.w_o, w.mix, MT, D, D, D, D, 1, D);
  hipLaunchKernelGGL(k_resid, dim3(MT), dim3(256), 0, st, in, (const float*)nullptr, (const float*)w.mix, in.g_post_mix, (const float*)w.mod, 2048, w.x1, out);
  hipLaunchKernelGGL(k_norm_mod, dim3(MT), dim3(256), 0, st, in, (const float*)w.x1, in.g_pre_ffn, (const float*)w.mod, 3072, 4096, w.h2);
  sgemm(st, w.h2, in.w_ffn_up, w.u, MT, F2, D, D, F2, 1, F2);
  hipLaunchKernelGGL(k_convgelu, dim3(MT), dim3(256), 0, st, in, (const float*)w.u, w.hmid, out);
  sgemm(st, w.hmid, in.w_ffn_down, w.y, MT, D, FF, FF, D, 1, D);
  hipLaunchKernelGGL(k_resid, dim3(MT), dim3(256), 0, st, in, (const float*)w.x1, (const float*)w.y, in.g_post_ffn, (const float*)w.mod, 5120, (float*)nullptr, out);
}
}
namespace pg8 {
#define PG8_LAS __attribute__((address_space(3)))
typedef unsigned short bf16_t;
typedef short bf16x8 __attribute__((ext_vector_type(8)));
typedef float f32x4 __attribute__((ext_vector_type(4)));
typedef unsigned u32x4 __attribute__((ext_vector_type(4)));
constexpr int BM = 256, BK = 64, HALF = 128, HTB = HALF * BK * 2  , STAGE_BYTES = 8 * HTB, NXCD = 8, WGM = 8;

__host__ __device__ __forceinline__ int lds_byte(int r, int c) { const int st = (r >> 4) * 2 + (c >> 5), rr = r & 15, cc = c & 31, ob = rr * 64 + cc * 2; return st * 1024 + (ob ^ (((ob >> 9) & 1) << 5)); }
__host__ __device__ __forceinline__ void stage_rc(int b, int& R, int& C) { const int st = b / 1024, sb = b % 1024, swz = sb ^ (((sb >> 9) & 1) << 5); R = (st >> 1) * 16 + swz / 64; C = (st & 1) * 32 + (swz % 64) / 2; }
__host__ __device__ __forceinline__ int perm32(int rho) { const int n = rho >> 4, i = rho & 15; return 8 * (i >> 2) + 4 * n + (i & 3); }

struct Unit { int pm, pn, kk; };
struct Gemm { const bf16_t* A; const bf16_t* Bt; int lda, ldb, K; };
__device__ __forceinline__ unsigned cvt_pk_bf16(float lo, float hi) { unsigned r; asm volatile("v_cvt_pk_bf16_f32 %0, %1, %2" : "=v"(r) : "v"(lo), "v"(hi)); return r; }
typedef float f32x2 __attribute__((ext_vector_type(2)));
template <class Epi, class Sched, bool ALIGN_EPI = false, bool SP2 = false>
__device__ __forceinline__ void gemm_phase(PG8_LAS unsigned char* lds, const Gemm g, const Sched& S, const Epi& E) {
    int tid = threadIdx.x; asm volatile("" : "+v"(tid));
    const int wid = __builtin_amdgcn_readfirstlane(tid >> 6), lane = tid & 63, wr = wid >> 2, wc = wid & 3, fr = lane & 15, fq = lane >> 4;
    int K = g.K; asm volatile("" : "+s"(K)); const int nt = K / BK;
    unsigned voffA[2], voffB[2];
#pragma unroll
    for (int i = 0; i < 2; ++i) { int R, C; stage_rc(tid * 16 + i * 8192, R, C); const int Rb = Epi::PERM ? ((R & ~31) + perm32(R & 31)) : R;
        voffA[i] = (unsigned)(R * g.lda + C) * 2u; voffB[i] = (unsigned)(Rb * g.ldb + C) * 2u; }
    const size_t kstep = (size_t)(BK * 2);
    const size_t hstepA = (size_t)HALF * g.lda * 2, hstepB = (size_t)HALF * g.ldb * 2;
    const size_t tstepA = 2 * hstepA, tstepB = 2 * hstepB;
    const unsigned ldsw = (unsigned)wid * 1024u;
    const int aoff = lds_byte(wr * 64 + fr, fq * 8), boff = lds_byte(wc * 32 + fr, fq * 8);
#define PG8_SA(b, h) (((b) * 2 + (h)) * HTB)
#define PG8_SB(b, h) ((4 + (b) * 2 + (h)) * HTB)
#define PG8_STAGE(bufoff, gbase, voff) do { _Pragma("unroll") for (int _i = 0; _i < 2; ++_i) \
        __builtin_amdgcn_global_load_lds((const unsigned*)((const char*)(gbase) + (voff)[_i]), (PG8_LAS unsigned*)(lds + (bufoff) + ldsw + _i * 8192), 16, 0, 0); } while (0)
#define PG8_LDA(dst, b, h) do { _Pragma("unroll") for (int m = 0; m < 4; ++m) _Pragma("unroll") for (int k = 0; k < 2; ++k) dst[m][k] = *(const PG8_LAS bf16x8*)(lds + PG8_SA(b, h) + aoff + m * 2048 + k * 1024); } while (0)
#define PG8_LDB(dst, b, h) do { _Pragma("unroll") for (int n = 0; n < 2; ++n) _Pragma("unroll") for (int k = 0; k < 2; ++k) dst[n][k] = *(const PG8_LAS bf16x8*)(lds + PG8_SB(b, h) + boff + n * 2048 + k * 1024); } while (0)
#define PG8_MMA(ai, bj, At, Bt) do { __builtin_amdgcn_s_setprio(1); _Pragma("unroll") for (int m = 0; m < 4; ++m) _Pragma("unroll") for (int n = 0; n < 2; ++n) _Pragma("unroll") for (int k = 0; k < 2; ++k) \
        acc[ai][bj][m][n] = __builtin_amdgcn_mfma_f32_16x16x32_bf16(Bt[n][k], At[m][k], acc[ai][bj][m][n], 0, 0, 0); __builtin_amdgcn_s_setprio(0); } while (0)
#define PG8_WAIT_V(n) asm volatile("s_waitcnt vmcnt(" #n ")" ::: "memory")
#define PG8_WAIT_L(n) asm volatile("s_waitcnt lgkmcnt(" #n ")" ::: "memory")
#define PG8_BAR __builtin_amdgcn_s_barrier()
#define PG8_SCHED __builtin_amdgcn_sched_barrier(0)
    Unit cur, nxt; int ui = 0;
    if (!S.next(0, cur)) return;
    f32x4 acc[2][2][4][2];
#pragma unroll
    for (int a = 0; a < 2; ++a)
#pragma unroll
        for (int b = 0; b < 2; ++b)
#pragma unroll
            for (int m = 0; m < 4; ++m)
#pragma unroll
                for (int n = 0; n < 2; ++n) acc[a][b][m][n] = (f32x4){0.f, 0.f, 0.f, 0.f};
    bf16x8 At[4][2], B0[2][2], B1[2][2];
    const char* cA = (const char*)g.A + (size_t)cur.pm * tstepA + (size_t)cur.kk * K * 2; const char* cB = (const char*)g.Bt + (size_t)cur.pn * tstepB + (size_t)cur.kk * K * 2;
    S.a_ready(cur);
    if constexpr (SP2) {
        PG8_STAGE(PG8_SB(0, 0), cB, voffB); PG8_STAGE(PG8_SB(0, 1), cB + hstepB, voffB); PG8_STAGE(PG8_SA(0, 0), cA, voffA); PG8_STAGE(PG8_SA(0, 1), cA + hstepA, voffA);
        if (wr == 1) PG8_BAR;
        PG8_WAIT_V(2); PG8_BAR;
        PG8_STAGE(PG8_SB(1, 0), cB + kstep, voffB); PG8_STAGE(PG8_SA(1, 0), cA + kstep, voffA); PG8_STAGE(PG8_SB(1, 1), cB + hstepB + kstep, voffB);
        PG8_WAIT_V(6); PG8_BAR;
    } else {
        PG8_STAGE(PG8_SB(0, 0), cB, voffB); PG8_STAGE(PG8_SA(0, 0), cA, voffA); PG8_STAGE(PG8_SB(0, 1), cB + hstepB, voffB); PG8_STAGE(PG8_SA(0, 1), cA + hstepA, voffA);
        if (wr == 1) PG8_BAR;
        PG8_WAIT_V(4); PG8_BAR;
        PG8_STAGE(PG8_SB(1, 0), cB + kstep, voffB); PG8_STAGE(PG8_SA(1, 0), cA + kstep, voffA); PG8_STAGE(PG8_SB(1, 1), cB + hstepB + kstep, voffB);
        PG8_WAIT_V(6); PG8_BAR;
    }
    for (;;) {
        const bool has_next = S.next(ui + 1, nxt);
        const char* nA = has_next ? (const char*)g.A + (size_t)nxt.pm * tstepA + (size_t)nxt.kk * K * 2 : cA; const char* nB = has_next ? (const char*)g.Bt + (size_t)nxt.pn * tstepB + (size_t)nxt.kk * K * 2 : cB;
        for (int t = 0; t < nt; t += 2) {
            const bool last = (t == nt - 2);
            const char* a1 = cA + (size_t)(t + 1) * kstep;
            const char* a2 = last ? nA : cA + (size_t)(t + 2) * kstep; const char* b2 = last ? nB : cB + (size_t)(t + 2) * kstep;
            const char* a3 = a2 + kstep; const char* b3 = b2 + kstep;
            if (last && has_next) S.a_ready(nxt);
            if constexpr (SP2) {
            PG8_LDB(B0, 0, 0); PG8_LDB(B1, 0, 1); PG8_SCHED; PG8_LDA(At, 0, 0); PG8_STAGE(PG8_SA(1, 1), a1 + hstepA, voffA);
            PG8_WAIT_V(8); PG8_WAIT_L(0); PG8_BAR; PG8_MMA(0, 0, At, B0); PG8_MMA(0, 1, At, B1); PG8_BAR; PG8_SCHED;
            PG8_LDA(At, 0, 1); PG8_STAGE(PG8_SB(0, 0), b2, voffB); PG8_STAGE(PG8_SB(0, 1), b2 + hstepB, voffB); PG8_STAGE(PG8_SA(0, 0), a2, voffA);
            PG8_WAIT_V(8); PG8_WAIT_L(0); PG8_BAR; PG8_MMA(1, 0, At, B0); PG8_MMA(1, 1, At, B1); PG8_BAR; PG8_SCHED;
            PG8_LDB(B0, 1, 0); PG8_LDB(B1, 1, 1); PG8_SCHED; PG8_LDA(At, 1, 0); PG8_STAGE(PG8_SA(0, 1), a2 + hstepA, voffA);
            PG8_WAIT_V(8); PG8_WAIT_L(0); PG8_BAR; PG8_MMA(0, 0, At, B0); PG8_MMA(0, 1, At, B1); PG8_BAR; PG8_SCHED;
            PG8_LDA(At, 1, 1); PG8_STAGE(PG8_SB(1, 0), b3, voffB); PG8_STAGE(PG8_SB(1, 1), b3 + hstepB, voffB); PG8_STAGE(PG8_SA(1, 0), a3, voffA);
            PG8_WAIT_V(8); PG8_WAIT_L(0); PG8_BAR; PG8_MMA(1, 0, At, B0); PG8_MMA(1, 1, At, B1); PG8_BAR; PG8_SCHED;
            } else {
            PG8_LDB(B0, 0, 0); PG8_SCHED; PG8_LDA(At, 0, 0); PG8_STAGE(PG8_SA(1, 1), a1 + hstepA, voffA);
            PG8_WAIT_L(8); PG8_BAR; PG8_WAIT_L(0); PG8_MMA(0, 0, At, B0); PG8_BAR; PG8_SCHED;
            PG8_LDB(B1, 0, 1); PG8_STAGE(PG8_SB(0, 0), b2, voffB);
            PG8_BAR; PG8_WAIT_L(0); PG8_MMA(0, 1, At, B1); PG8_BAR;
            PG8_LDA(At, 0, 1); PG8_STAGE(PG8_SA(0, 0), a2, voffA);
            PG8_BAR; PG8_WAIT_L(0); PG8_MMA(1, 0, At, B0); PG8_BAR; PG8_SCHED;
            PG8_STAGE(PG8_SB(0, 1), b2 + hstepB, voffB);
            PG8_WAIT_V(6); PG8_BAR; PG8_MMA(1, 1, At, B1); PG8_BAR;
            PG8_LDB(B0, 1, 0); PG8_SCHED; PG8_LDA(At, 1, 0); PG8_STAGE(PG8_SA(0, 1), a2 + hstepA, voffA);
            PG8_WAIT_L(8); PG8_BAR; PG8_WAIT_L(0); PG8_MMA(0, 0, At, B0); PG8_BAR; PG8_SCHED;
            PG8_LDB(B1, 1, 1); PG8_STAGE(PG8_SB(1, 0), b3, voffB);
            PG8_BAR; PG8_WAIT_L(0); PG8_MMA(0, 1, At, B1); PG8_BAR;
            PG8_LDA(At, 1, 1); PG8_STAGE(PG8_SA(1, 0), a3, voffA);
            PG8_BAR; PG8_WAIT_L(0); PG8_MMA(1, 0, At, B0); PG8_BAR; PG8_SCHED;
            PG8_STAGE(PG8_SB(1, 1), b3 + hstepB, voffB);
            PG8_WAIT_V(6); PG8_BAR; PG8_MMA(1, 1, At, B1); PG8_BAR;
            }
        }
        if constexpr (ALIGN_EPI) { if (wr == 0) PG8_BAR; }
        if constexpr (!Epi::AFTER_DRAIN) { E(acc, cur, wr, wc, fr, fq); S.done(cur); }
        if (!has_next) break;
#pragma unroll
        for (int a = 0; a < 2; ++a)
#pragma unroll
            for (int b = 0; b < 2; ++b)
#pragma unroll
                for (int m = 0; m < 4; ++m)
#pragma unroll
                    for (int n = 0; n < 2; ++n) acc[a][b][m][n] = (f32x4){0.f, 0.f, 0.f, 0.f};
        cur = nxt; cA = nA; cB = nB; ++ui;
        if constexpr (ALIGN_EPI) { if (wr == 1) PG8_BAR; }
    }
    PG8_WAIT_V(0);
    if constexpr (!ALIGN_EPI) { if (wr == 0) PG8_BAR; }
    PG8_BAR;
    if constexpr (Epi::AFTER_DRAIN) { E.fused(acc, cur, wr, wc, fr, fq, lds, wid, lane); S.done(cur); }
#undef PG8_SA
#undef PG8_SB
#undef PG8_STAGE
#undef PG8_LDA
#undef PG8_LDB
#undef PG8_MMA
#undef PG8_WAIT_V
#undef PG8_WAIT_L
#undef PG8_BAR
#undef PG8_SCHED
}
}
namespace fz {
using nv::In;
using nv::D; using nv::NB; using nv::T; using nv::DB; using nv::DT; using nv::MP; using nv::MS; using nv::MT; using nv::FF; using nv::F2; using nv::PAST; using nv::NPG;
#define GAS __attribute__((address_space(1)))
#define LAS __attribute__((address_space(3)))
typedef unsigned short bf16;
typedef unsigned v4u __attribute__((ext_vector_type(4)));
typedef unsigned v2u __attribute__((ext_vector_type(2)));
typedef float f32x4 __attribute__((ext_vector_type(4)));
typedef float f32x2 __attribute__((ext_vector_type(2)));
typedef float f32x16 __attribute__((ext_vector_type(16)));
typedef short bf16x8 __attribute__((ext_vector_type(8)));
typedef short s16x4 __attribute__((ext_vector_type(4)));
typedef GAS unsigned gu32;
#define RLX_AGENT __ATOMIC_RELAXED, __HIP_MEMORY_SCOPE_AGENT
#define LDS_WAIT() asm volatile("s_waitcnt lgkmcnt(0)" ::: "memory")

constexpr int NWAVES = 8, NTHR = 512;
constexpr int ZW = 2304;
constexpr int ZC_QA = 0, ZC_KA = 256, ZC_VA = 512, ZC_RA = 1024, ZC_CKV = 1536, ZC_CQ = 1792, ZC_KR = 2176, ZC_GR = 2240;
constexpr int QW = 1792;
constexpr int NSPLIT = 16;
constexpr float C2 = 0.07216878364870322f * 1.4426950408889634f;

constexpr size_t al256(size_t x) { return (x + 255) & ~(size_t)255; }
constexpr size_t W_CTL = 0, CTL_BYTES = 1u << 20;
constexpr size_t W_MOD = W_CTL + CTL_BYTES;
constexpr size_t W_ROPE = W_MOD + al256((size_t)40 * 6144 * 4);
constexpr size_t W_WIN = W_ROPE + al256((size_t)2056 * 32 * 8);
constexpr size_t W_WQ = W_WIN + al256((size_t)ZW * 1024 * 2);
constexpr size_t W_WKV = W_WQ + al256((size_t)QW * 384 * 2);
constexpr size_t W_WO = W_WKV + al256((size_t)1024 * 256 * 2);
constexpr size_t W_WUP = W_WO + al256((size_t)1024 * 1024 * 2);
constexpr size_t W_WDN = W_WUP + al256((size_t)F2 * 1024 * 2);
constexpr size_t W_XN = W_WDN + al256((size_t)1024 * FF * 2);
constexpr size_t W_Z = W_XN + al256((size_t)MT * 1024 * 2);
constexpr size_t W_CQN = W_Z + al256((size_t)MT * ZW * 2);
constexpr size_t W_LATB = W_CQN + al256((size_t)MT * 384 * 2);
constexpr size_t W_KRB = W_LATB + al256((size_t)MT * 256 * 2);
constexpr size_t W_QD = W_KRB + al256((size_t)MT * 64 * 2);
constexpr size_t W_KD = W_QD + al256((size_t)MP * 256 * 2);
constexpr size_t W_KLT = W_KD + al256((size_t)MP * 256 * 2);
constexpr size_t W_VT = W_KLT + al256((size_t)MP * 256 * 2);
constexpr size_t W_DCH = W_VT + al256((size_t)MP * 512 * 2);
constexpr size_t W_UT = W_DCH + al256((size_t)NB * 32 * 256 * 4);
constexpr size_t W_ST = W_UT + al256((size_t)NB * 4 * 32 * 8192 * 4);
constexpr size_t W_QBUF = W_ST + al256((size_t)NB * 4 * 32 * 8192 * 2);
constexpr size_t W_KCOMB = W_QBUF + al256((size_t)MT * QW * 2);
constexpr size_t W_VB = W_KCOMB + al256((size_t)NB * 4 * T * 200 * 2);
constexpr size_t W_DPO = W_VB + al256((size_t)MP * 512 * 2);
constexpr size_t W_DPML = W_DPO + al256((size_t)DB * NSPLIT * 32 * 256 * 4);
constexpr size_t W_MIXIN = W_DPML + al256((size_t)DB * NSPLIT * 2 * 32 * 4);
constexpr size_t W_MIX = W_MIXIN + al256((size_t)MT * 1024 * 2);
constexpr size_t W_X1 = W_MIX + al256((size_t)MT * 1024 * 4);
constexpr size_t W_U = W_X1 + al256((size_t)MT * 1024 * 4);
constexpr size_t W_HMID = W_U + al256((size_t)MT * F2 * 2);
constexpr size_t W_MIXP = W_HMID + al256((size_t)MT * FF * 2);
constexpr size_t W_END = W_MIXP + al256((size_t)11 * 256 * 1024 * 4);

constexpr int CW_BAR = 4096, CW_Q5 = 64;

constexpr int RING_BYTES = 131072, LDSCTL_OFF = 139264, MISC_OFF = LDSCTL_OFF + 320, LDS_BYTES = 147456;

__device__ __forceinline__ unsigned f2bf(float f) { unsigned u = __builtin_bit_cast(unsigned, f); return (u + 0x7fffu + ((u >> 16) & 1u)) >> 16; }
typedef __bf16 hwbf2 __attribute__((ext_vector_type(2)));
__device__ __forceinline__ unsigned pk2(float lo, float hi) { const f32x2 v = {lo, hi}; return __builtin_bit_cast(unsigned, __builtin_convertvector(v, hwbf2)); }
__device__ __forceinline__ float bf2f(unsigned b) { return __builtin_bit_cast(float, b << 16); }
__device__ __forceinline__ float bflo(unsigned w) { return __builtin_bit_cast(float, w << 16); }
__device__ __forceinline__ float bfhi(unsigned w) { return __builtin_bit_cast(float, w & 0xffff0000u); }
__device__ __forceinline__ float wave_sum(float v) {
#pragma unroll
  for (int o = 1; o < 64; o <<= 1) v += __shfl_xor(v, o);
  return v;
}
__device__ __forceinline__ float silu_f(float v) { return v / (1.f + __expf(-v)); }

#define XB_TMO      128
#define XB_XCNT(j)  (256  + 64 * (j))
#define XB_XSUB(j)  (1280 + 64 * (j))
#define XB_XGEN(j)  (2304 + 64 * (j))
#define XB_TOP      3328
#define XB_TOPGEN   3392
#define XCD_BAR_WORDS 3456
#define XB_SPIN_CAP (1u << 22)
__device__ __forceinline__ unsigned xb_ld(unsigned* p)              { return __hip_atomic_load(p, __ATOMIC_RELAXED, __HIP_MEMORY_SCOPE_AGENT); }
__device__ __forceinline__ unsigned xb_add(unsigned* p, unsigned v) { return __hip_atomic_fetch_add(p, v, __ATOMIC_RELAXED, __HIP_MEMORY_SCOPE_AGENT); }
__device__ __forceinline__ unsigned xb_xcc_id() { return (unsigned)__builtin_amdgcn_s_getreg((3 << 11) | 20) & 0xFu; }
#define XB_SPIN(cond, bar) do { unsigned _sp = 0; while (cond) { __builtin_amdgcn_s_sleep(1); \
    if ((++_sp & 255u) == 0u) { if (xb_ld(&(bar)[XB_TMO])) break; if (_sp > XB_SPIN_CAP) { atomicAdd(&(bar)[XB_TMO], 1u); break; } } } } while (0)
struct XcdBarrier { unsigned* bar; unsigned x; volatile LAS unsigned* st; };
__device__ __forceinline__ XcdBarrier xcd_barrier_post(unsigned* bar, volatile LAS unsigned* st) {
    XcdBarrier b; b.bar = bar; b.x = xb_xcc_id(); b.st = st;
    if (threadIdx.x == 0) (void)xb_add(&bar[XB_XCNT(b.x)], 1u);
    return b;
}
__device__ __forceinline__ void xcd_barrier_complete(unsigned* bar, unsigned x, unsigned& nloc, unsigned& nx) {
    const unsigned G = gridDim.x * gridDim.y * gridDim.z;
    unsigned sum, cnt, mine, sp = 0u;
    for (;;) {
        sum = 0u; cnt = 0u; mine = 0u;
#pragma unroll
        for (unsigned j = 0; j < 16; ++j) { const unsigned c = xb_ld(&bar[XB_XCNT(j)]); sum += c; cnt += (c > 0u) ? 1u : 0u; mine = (j == x) ? c : mine; }
        if (sum == G) break;
        __builtin_amdgcn_s_sleep(1);
        if ((++sp & 255u) == 0u) { if (xb_ld(&bar[XB_TMO])) break; if (sp > XB_SPIN_CAP) { atomicAdd(&bar[XB_TMO], 1u); break; } }
    }
    nloc = mine > 0u ? mine : 1u; nx = cnt > 0u ? cnt : 1u;
}
__device__ __forceinline__ void xcd_barrier(const XcdBarrier& b) {
    asm volatile("s_waitcnt vmcnt(0)" ::: "memory");
    __syncthreads();
    if (threadIdx.x == 0) {
        unsigned* bar = b.bar;
        __builtin_amdgcn_s_waitcnt(0);
        unsigned nloc = b.st[0], nx = b.st[1];
        if (nloc == 0u) { xcd_barrier_complete(bar, b.x, nloc, nx); b.st[0] = nloc; b.st[1] = nx; }
        const unsigned old = xb_add(&bar[XB_XSUB(b.x)], 1u);
        const unsigned gen = old / nloc;
        if (old + 1u == (gen + 1u) * nloc) {
            __builtin_amdgcn_fence(__ATOMIC_RELEASE, "agent");
            asm volatile("s_waitcnt vmcnt(0)" ::: "memory");
            const unsigned og = xb_add(&bar[XB_TOP], 1u);
            const unsigned tg = og / nx;
            if (og + 1u == (tg + 1u) * nx) xb_add(&bar[XB_TOPGEN], 1u);
            else XB_SPIN(xb_ld(&bar[XB_TOPGEN]) == tg, bar);
            __builtin_amdgcn_fence(__ATOMIC_ACQUIRE, "agent");
            xb_add(&bar[XB_XGEN(b.x)], 1u);
            asm volatile("s_waitcnt vmcnt(0)" ::: "memory");
        } else {
            XB_SPIN(xb_ld(&bar[XB_XGEN(b.x)]) == gen, bar);
            __builtin_amdgcn_fence(__ATOMIC_ACQUIRE, "agent");
            asm volatile("s_waitcnt vmcnt(0)" ::: "memory");
        }
    }
    __syncthreads();
}

struct Params { In in; float* out; unsigned char* ws; int ph_lo, ph_hi, repmask, pad; };
struct Frame {
  LAS unsigned char* lds;
  int tid, lane, wave, G, bid;
  const Params* P;
#define FZ_ACC(T_, name, off) __device__ __forceinline__ T_* name() const { return (T_*)(P->ws + (off)); }
  FZ_ACC(float, mod, W_MOD) FZ_ACC(f32x2, rope, W_ROPE) FZ_ACC(bf16, win_t, W_WIN) FZ_ACC(bf16, wq_t, W_WQ) FZ_ACC(bf16, wkv_t, W_WKV) FZ_ACC(bf16, wo_t, W_WO)
  FZ_ACC(bf16, wup_t, W_WUP) FZ_ACC(bf16, wdn_t, W_WDN) FZ_ACC(bf16, xn, W_XN) FZ_ACC(bf16, z, W_Z) FZ_ACC(bf16, cqn, W_CQN) FZ_ACC(bf16, latb, W_LATB) FZ_ACC(bf16, krb, W_KRB)
  FZ_ACC(bf16, qd, W_QD) FZ_ACC(bf16, kd, W_KD) FZ_ACC(bf16, klt, W_KLT) FZ_ACC(bf16, vt, W_VT) FZ_ACC(float, dch, W_DCH) FZ_ACC(float, ut, W_UT) FZ_ACC(bf16, st, W_ST)
  FZ_ACC(bf16, qbuf, W_QBUF) FZ_ACC(bf16, kcomb, W_KCOMB) FZ_ACC(bf16, vb, W_VB) FZ_ACC(float, dpo, W_DPO) FZ_ACC(float, dpml, W_DPML) FZ_ACC(bf16, mixin, W_MIXIN)
  FZ_ACC(float, mix, W_MIX) FZ_ACC(bf16, mixb, W_MIX) FZ_ACC(float, mixp, W_MIXP) FZ_ACC(float, x1, W_X1) FZ_ACC(bf16, u, W_U) FZ_ACC(bf16, hmid, W_HMID)
#undef FZ_ACC
};
__device__ __forceinline__ int cond_row(int r) { return r < MP ? (r >> 11) : NB + ((r - MP) >> 3); }
__device__ __forceinline__ int pos_idx(int r) { return r < MP ? (r & 2047) : 2048 + ((r - MP) & 7); }
__device__ __forceinline__ const float* x_row(const In& in, int r) { return r < MP ? in.x_p + (size_t)r * D : in.x_s + (size_t)(r - MP) * D; }
__device__ __forceinline__ float* y_row(float* out, int r) { return r < MP ? out + nv::OUT_YP + (size_t)r * D : out + nv::OUT_YS + (size_t)(r - MP) * D; }

__device__ __forceinline__ void p0_mod_unit(const Frame& F, int u) {
  LAS float* sc = (LAS float*)F.lds; LAS float* red = sc;
  const int tid = F.tid, cc = u >> 1, kh = u & 1, n0 = cc * 64;
  __syncthreads();
  for (int i = tid; i < 40 * 512; i += NTHR) { const int cr = i >> 9, k = kh * 512 + (i & 511);
    const float v = cr < NB ? F.P->in.c_p[cr * D + k] : F.P->in.c_s[(cr - NB) * D + k]; sc[(i & 511) * 40 + cr] = v / (1.f + __expf(-v)); }
  __syncthreads();
  const int kg = tid >> 6, c = tid & 63;
  float acc[40];
#pragma unroll
  for (int r = 0; r < 40; ++r) acc[r] = 0.f;
#pragma unroll 1
  for (int hb = 0; hb < 4; ++hb) { float wv[16];
#pragma unroll
    for (int i = 0; i < 16; ++i) wv[i] = F.P->in.w_ada[(size_t)(kh * 512 + kg + 8 * (16 * hb + i)) * 6144 + n0 + c];
#pragma unroll
    for (int i = 0; i < 16; ++i) { const int k = kg + 8 * (16 * hb + i); const LAS f32x4* s4 = (const LAS f32x4*)(sc + k * 40);
#pragma unroll
      for (int r4 = 0; r4 < 10; ++r4) { const f32x4 x = s4[r4]; acc[4 * r4] += x.x * wv[i]; acc[4 * r4 + 1] += x.y * wv[i]; acc[4 * r4 + 2] += x.z * wv[i]; acc[4 * r4 + 3] += x.w * wv[i]; } } }
  __syncthreads();
#pragma unroll
  for (int r = 0; r < 40; ++r) red[(kg * 40 + r) * 64 + c] = acc[r];
  __syncthreads();
  for (int i = tid; i < 40 * 64; i += NTHR) { const int r = i >> 6, c2 = i & 63; float s = kh == 0 ? F.P->in.b_ada[n0 + c2] : 0.f;
#pragma unroll
    for (int g = 0; g < 8; ++g) s += red[(g * 40 + r) * 64 + c2];
    atomicAdd(F.mod() + (size_t)r * 6144 + n0 + c2, s); }
}
template <class Map>
__device__ __forceinline__ void transpose_item(const float* W, int Nsrc, bf16* WT, int ldt, const Map map, LAS float* scr, int item, int nblk, int lane) {
  const int kb = item / nblk, nb = item % nblk, k0 = 64 * kb, n0 = 64 * nb;
  const int ncol = n0 + lane;
#pragma unroll 16
  for (int i = 0; i < 64; ++i) scr[i * 65 + lane] = ncol < Nsrc ? W[(size_t)(k0 + i) * Nsrc + ncol] : 0.f;
  LDS_WAIT();
  const int c = lane & 7;
#pragma unroll
  for (int j = 0; j < 8; ++j) { const int n = (lane >> 3) + 8 * j; const LAS float* s = scr + (8 * c) * 65 + n;
    v4u o; o.x = pk2(s[0 * 65], s[1 * 65]); o.y = pk2(s[2 * 65], s[3 * 65]); o.z = pk2(s[4 * 65], s[5 * 65]); o.w = pk2(s[6 * 65], s[7 * 65]);
    const int row = map(n0 + n);
    *(GAS v4u*)(WT + (size_t)row * ldt + k0 + 8 * c) = o; }
  LDS_WAIT();
}
struct MapId { int off; __device__ __forceinline__ int operator()(int n) const { return n + off; } };
struct MapWin { __device__ __forceinline__ int operator()(int n) const {
  if (n < 1536) return n; if (n < 1552) return ZC_GR + (n - 1536); if (n < 1936) return ZC_CQ + (n - 1552); if (n < 2192) return ZC_CKV + (n - 1936); if (n < 2256) return ZC_KR + (n - 2192); return n; } };

__device__ __forceinline__ void p0_prologue(const Frame& F) {
#if !defined(P0SUB) || P0SUB == 1
  for (int u = F.bid; u < 192; u += F.G) p0_mod_unit(F, u);
#endif
  __syncthreads();
#if !defined(P0SUB) || P0SUB == 2
  LAS float* scr = (LAS float*)(F.lds + F.wave * 16640);
  const int gw = F.bid * NWAVES + F.wave, NGW = F.G * NWAVES;
  constexpr int I_IN = 16 * 36, I_UQ = 6 * 12, I_UK = 4 * 8, I_UV = 4 * 8;
  constexpr int NITEMS = I_IN + I_UQ + I_UK + I_UV;
  for (int it = gw; it < NITEMS; it += NGW) {
    int r = it;
    if (r < I_IN) { transpose_item(F.P->in.w_in, 2256, F.win_t(), 1024, MapWin{}, scr, r, 36, F.lane); continue; } r -= I_IN;
    if (r < I_UQ) { transpose_item(F.P->in.w_mla_uq, 768, F.wq_t(), 384, MapId{0}, scr, r, 12, F.lane); continue; } r -= I_UQ;
    if (r < I_UK) { transpose_item(F.P->in.w_mla_uk, 512, F.wkv_t(), 256, MapId{0}, scr, r, 8, F.lane); continue; } r -= I_UK;
    transpose_item(F.P->in.w_mla_uv, 512, F.wkv_t(), 256, MapId{512}, scr, r, 8, F.lane);
  }
#endif
  const int gt = F.bid * NTHR + F.tid, NGT = F.G * NTHR;
#if !defined(P0SUB) || P0SUB == 3
  for (int i = gt; i < 2056 * 32; i += NGT) { const int p = i >> 5, j = i & 31; const int pos = p < 2048 ? p : PAST + (p - 2048);
    const float inv = powf(10000.0f, -(float)(2 * j) / 64.0f); const float ang = (float)pos * inv; F.rope()[i] = (f32x2){cosf(ang), sinf(ang)}; }
#endif
#if !defined(P0SUB) || P0SUB == 4
  __syncthreads();
  { LAS float* As = (LAS float*)F.lds; LAS float* Bs = As + 64 * 129;
    for (int u = F.bid; u < 96; u += F.G) { const int h = u / 24, ct = (u % 24) / 4, lt = u % 4;
      __syncthreads();
      for (int i = F.tid; i < 64 * 128; i += NTHR) { const int rr = i >> 7, n = i & 127;
        As[rr * 129 + n] = F.P->in.w_mla_uq[(size_t)(ct * 64 + rr) * 768 + h * 192 + n]; Bs[rr * 129 + n] = F.P->in.w_mla_uk[(size_t)(lt * 64 + rr) * 512 + h * 128 + n]; }
      __syncthreads();
      const int cc = F.tid & 63, lg = F.tid >> 6;
      float acc[8];
#pragma unroll
      for (int j = 0; j < 8; ++j) acc[j] = 0.f;
      for (int n = 0; n < 128; ++n) { const float a = As[cc * 129 + n];
#pragma unroll
        for (int j = 0; j < 8; ++j) acc[j] += a * Bs[(lg * 8 + j) * 129 + n]; }
#pragma unroll
      for (int j = 0; j < 8; ++j) F.wq_t()[(size_t)(768 + h * 256 + lt * 64 + lg * 8 + j) * 384 + ct * 64 + cc] = (bf16)f2bf(acc[j]); } }
#endif
}

__device__ __forceinline__ void p0_late_transposes(const Frame& F) {
  const int first = (65 * 9) % F.G;
  if (F.bid < first) return;
  LAS float* scr = (LAS float*)(F.lds + F.wave * 16640);
  const int gw = (F.bid - first) * NWAVES + F.wave, NGW = (F.G - first) * NWAVES;
  constexpr int I_O = 16 * 16, I_UP = 16 * 88, I_DN = 44 * 16;
  for (int it = gw; it < I_O + I_UP + I_DN; it += NGW) {
    int r = it;
    if (r < I_UP) { transpose_item(F.P->in.w_ffn_up, F2, F.wup_t(), 1024, MapId{0}, scr, r, 88, F.lane); continue; } r -= I_UP;
    if (r < I_DN) { transpose_item(F.P->in.w_ffn_down, 1024, F.wdn_t(), FF, MapId{0}, scr, r, 16, F.lane); continue; } r -= I_DN;
    transpose_item(F.P->in.w_o, 1024, F.wo_t(), 1024, MapId{0}, scr, r, 16, F.lane);
  }
}

template <int NR>
__device__ __forceinline__ void p1_rows(const Frame& F, const int (&rows)[NR]) {
  const int lane = F.lane; f32x4 v[NR][4]; float rs[NR];
#pragma unroll
  for (int q = 0; q < NR; ++q) { const f32x4* xr = (const f32x4*)x_row(F.P->in, rows[q]) + lane;
#pragma unroll
    for (int j = 0; j < 4; ++j) v[q][j] = xr[64 * j]; }
#pragma unroll
  for (int q = 0; q < NR; ++q) { float s = 0.f;
#pragma unroll
    for (int j = 0; j < 4; ++j) s += (v[q][j].x * v[q][j].x + v[q][j].y * v[q][j].y) + (v[q][j].z * v[q][j].z + v[q][j].w * v[q][j].w);
    rs[q] = rsqrtf(wave_sum(s) * (1.f / D) + 1e-6f); }
#pragma unroll
  for (int q = 0; q < NR; ++q) { const float* modrow = F.mod() + (size_t)cond_row(rows[q]) * 6144;
#pragma unroll
    for (int j = 0; j < 4; ++j) { const int col = 4 * (lane + 64 * j);
      const f32x4 gv = *(const f32x4*)(F.P->in.g_pre_mix + col), scv = *(const f32x4*)(modrow + 1024 + col), shv = *(const f32x4*)(modrow + col);
      const f32x4 o = v[q][j] * rs[q] * gv * (1.f + scv) + shv;
      v2u w; w.x = pk2(o.x, o.y); w.y = pk2(o.z, o.w); *(v2u*)(F.xn() + (size_t)rows[q] * D + col) = w; } }
}
__device__ __forceinline__ void p1_xn(const Frame& F) {
  const int gw = F.bid * NWAVES + F.wave, NGW = F.G * NWAVES;
  int r = gw;
  for (; r + 3 * NGW < MT; r += 4 * NGW) { const int rows[4] = {r, r + NGW, r + 2 * NGW, r + 3 * NGW}; p1_rows<4>(F, rows); }
  for (; r < MT; r += NGW) { const int rows[1] = {r}; p1_rows<1>(F, rows); }
}
template <int NR>
__device__ __forceinline__ void p8_rows(const Frame& F, const int (&rows)[NR]) {
  const int lane = F.lane; f32x4 v[NR][4], xv[NR][4]; float rs[NR];
#pragma unroll
  for (int q = 0; q < NR; ++q) { const int r = rows[q]; const f32x4* xr = (const f32x4*)x_row(F.P->in, r) + lane;
#pragma unroll
    for (int j = 0; j < 4; ++j) xv[q][j] = xr[64 * j];
    if (r < MP) { const v2u* mr = (const v2u*)(F.mixb() + (size_t)r * D) + lane;
#pragma unroll
      for (int j = 0; j < 4; ++j) { const v2u w = mr[64 * j]; v[q][j] = (f32x4){bflo(w.x), bfhi(w.x), bflo(w.y), bfhi(w.y)}; } }
    else { const f32x4* mr = (const f32x4*)(F.mixp() + (size_t)(r - MP) * D) + lane;
#pragma unroll
      for (int j = 0; j < 4; ++j) { f32x4 a = mr[64 * j];
#pragma unroll
        for (int k = 1; k < 4; ++k) a += mr[(size_t)k * 256 * 256 + 64 * j];
        v[q][j] = a; } } }
#pragma unroll
  for (int q = 0; q < NR; ++q) { float s = 0.f;
#pragma unroll
    for (int j = 0; j < 4; ++j) s += (v[q][j].x * v[q][j].x + v[q][j].y * v[q][j].y) + (v[q][j].z * v[q][j].z + v[q][j].w * v[q][j].w);
    rs[q] = rsqrtf(wave_sum(s) * (1.f / D) + 1e-6f); }
#pragma unroll
  for (int q = 0; q < NR; ++q) { const int r = rows[q]; const float* modrow = F.mod() + (size_t)cond_row(r) * 6144; float s2 = 0.f;
#pragma unroll
    for (int j = 0; j < 4; ++j) { const int col = 4 * (lane + 64 * j);
      const f32x4 gv = *(const f32x4*)(F.P->in.g_post_mix + col), gt = *(const f32x4*)(modrow + 2048 + col);
      v[q][j] = xv[q][j] + gt * (v[q][j] * rs[q] * gv);
      *(f32x4*)(F.x1() + (size_t)r * D + col) = v[q][j];
      s2 += (v[q][j].x * v[q][j].x + v[q][j].y * v[q][j].y) + (v[q][j].z * v[q][j].z + v[q][j].w * v[q][j].w); }
    const float rs2 = rsqrtf(wave_sum(s2) * (1.f / D) + 1e-6f);
#pragma unroll
    for (int j = 0; j < 4; ++j) { const int col = 4 * (lane + 64 * j);
      const f32x4 gv = *(const f32x4*)(F.P->in.g_pre_ffn + col), scv = *(const f32x4*)(modrow + 4096 + col), shv = *(const f32x4*)(modrow + 3072 + col);
      const f32x4 o = v[q][j] * rs2 * gv * (1.f + scv) + shv;
      v2u w; w.x = pk2(o.x, o.y); w.y = pk2(o.z, o.w); *(v2u*)(F.xn() + (size_t)r * D + col) = w; } }
}
__device__ __forceinline__ void p8_all(const Frame& F) {
  const int gw = F.bid * NWAVES + F.wave, NGW = F.G * NWAVES;
  int r = gw;
  for (; r + NGW < MT; r += 2 * NGW) { const int rows[2] = {r, r + NGW}; p8_rows<2>(F, rows); }
  for (; r < MT; r += NGW) { const int rows[1] = {r}; p8_rows<1>(F, rows); }
}
template <int NR>
__device__ __forceinline__ void p12_rows(const Frame& F, const int (&rows)[NR]) {
  const int lane = F.lane; f32x4 v[NR][4], xv[NR][4]; float rs[NR];
#pragma unroll
  for (int q = 0; q < NR; ++q) { const int r = rows[q]; const f32x4* xr = (const f32x4*)(F.x1() + (size_t)r * D) + lane;
#pragma unroll
    for (int j = 0; j < 4; ++j) xv[q][j] = xr[64 * j];
    if (r < MP) { const v2u* yr = (const v2u*)(F.mixb() + (size_t)r * D) + lane;
#pragma unroll
      for (int j = 0; j < 4; ++j) { const v2u w = yr[64 * j]; v[q][j] = (f32x4){bflo(w.x), bfhi(w.x), bflo(w.y), bfhi(w.y)}; } }
    else { const f32x4* yr = (const f32x4*)(F.mixp() + (size_t)(r - MP) * D) + lane;
#pragma unroll
      for (int j = 0; j < 4; ++j) { f32x4 a = yr[64 * j];
#pragma unroll
        for (int k = 1; k < 11; ++k) a += yr[(size_t)k * 256 * 256 + 64 * j];
        v[q][j] = a; } } }
#pragma unroll
  for (int q = 0; q < NR; ++q) { float s = 0.f;
#pragma unroll
    for (int j = 0; j < 4; ++j) s += (v[q][j].x * v[q][j].x + v[q][j].y * v[q][j].y) + (v[q][j].z * v[q][j].z + v[q][j].w * v[q][j].w);
    rs[q] = rsqrtf(wave_sum(s) * (1.f / D) + 1e-6f); }
#pragma unroll
  for (int q = 0; q < NR; ++q) { const int r = rows[q]; const float* modrow = F.mod() + (size_t)cond_row(r) * 6144; float* orow = y_row(F.P->out, r);
#pragma unroll
    for (int j = 0; j < 4; ++j) { const int col = 4 * (lane + 64 * j);
      const f32x4 gv = *(const f32x4*)(F.P->in.g_post_ffn + col), gt = *(const f32x4*)(modrow + 5120 + col);
      *(f32x4*)(orow + col) = xv[q][j] + gt * (v[q][j] * rs[q] * gv); } }
}
__device__ __forceinline__ void p12_all(const Frame& F) {
  const int gw = F.bid * NWAVES + F.wave, NGW = F.G * NWAVES;
  int r = gw;
  for (; r + NGW < MT; r += 2 * NGW) { const int rows[2] = {r, r + NGW}; p12_rows<2>(F, rows); }
  for (; r < MT; r += NGW) { const int rows[1] = {r}; p12_rows<1>(F, rows); }
}
template <int NR>
__device__ __forceinline__ void p3_rows(const Frame& F, const int (&rows)[NR]) {
  const int lane = F.lane, i = lane & 31;
  unsigned wq[NR][3]; v2u wl[NR]; unsigned short k1[NR], k2[NR]; f32x2 cs[NR];
#pragma unroll
  for (int q = 0; q < NR; ++q) { const bf16* zr = F.z() + (size_t)rows[q] * ZW;
#pragma unroll
    for (int j = 0; j < 3; ++j) wq[q][j] = *(const unsigned*)(zr + ZC_CQ + 2 * lane + 128 * j);
    wl[q] = *(const v2u*)(zr + ZC_CKV + 4 * lane); k1[q] = zr[ZC_KR + i]; k2[q] = zr[ZC_KR + 32 + i]; cs[q] = F.rope()[pos_idx(rows[q]) * 32 + i]; }
#pragma unroll
  for (int q = 0; q < NR; ++q) { const int r = rows[q];
    { float s = 0.f;
#pragma unroll
      for (int j = 0; j < 3; ++j) { const float a = bflo(wq[q][j]), b = bfhi(wq[q][j]); s += a * a + b * b; }
      const float rs = rsqrtf(wave_sum(s) * (1.f / 384.f) + 1e-6f);
#pragma unroll
      for (int j = 0; j < 3; ++j) { const int col = 2 * lane + 128 * j; const f32x2 g = *(const f32x2*)(F.P->in.g_mla_q + col);
        *(unsigned*)(F.cqn() + (size_t)r * 384 + col) = pk2(bflo(wq[q][j]) * rs * g.x, bfhi(wq[q][j]) * rs * g.y); } }
    { const v2u w = wl[q]; const f32x4 v = {bflo(w.x), bfhi(w.x), bflo(w.y), bfhi(w.y)};
      const float s = (v.x * v.x + v.y * v.y) + (v.z * v.z + v.w * v.w); const float rs = rsqrtf(wave_sum(s) * (1.f / 256.f) + 1e-6f);
      const f32x4 o = v * rs * *(const f32x4*)(F.P->in.g_mla_kv + 4 * lane);
      float* lo = r < MP ? F.P->out + nv::OUT_LATP + (size_t)r * 256 : F.P->out + nv::OUT_LATS + (size_t)(r - MP) * 256;
      *(f32x4*)(lo + 4 * lane) = o; v2u ob; ob.x = pk2(o.x, o.y); ob.y = pk2(o.z, o.w); *(v2u*)(F.latb() + (size_t)r * 256 + 4 * lane) = ob; }
    { const float x1 = bf2f(k1[q]), x2 = bf2f(k2[q]);
      const float o1 = x1 * cs[q].x - x2 * cs[q].y, o2 = x1 * cs[q].y + x2 * cs[q].x;
      float* ko = r < MP ? F.P->out + nv::OUT_KRP + (size_t)r * 64 : F.P->out + nv::OUT_KRS + (size_t)(r - MP) * 64;
      if (lane < 32) { const bf16 b1 = (bf16)f2bf(o1), b2 = (bf16)f2bf(o2); ko[i] = o1; ko[32 + i] = o2; F.krb()[(size_t)r * 64 + i] = b1; F.krb()[(size_t)r * 64 + 32 + i] = b2;
        if (r < MP) {
#pragma unroll
          for (int h = 0; h < 4; ++h) { bf16* kc = F.kcomb() + ((size_t)((r >> 11) * 4 + h) * T + (r & 2047)) * 200; kc[128 + i] = b1; kc[160 + i] = b2; } } } } }
}
__device__ __forceinline__ void p3_all_rows(const Frame& F) {
  const int gw = F.bid * NWAVES + F.wave, NGW = F.G * NWAVES;
  int r = gw;
  for (; r + 3 * NGW < MT; r += 4 * NGW) { const int rows[4] = {r, r + NGW, r + 2 * NGW, r + 3 * NGW}; p3_rows<4>(F, rows); }
  for (; r < MT; r += NGW) { const int rows[1] = {r}; p3_rows<1>(F, rows); }
}
__device__ __forceinline__ float log_sigmoid_f(float a) { return fminf(a, 0.f) - log1pf(expf(-fabsf(a))); }
__device__ __forceinline__ f32x16 mfma32(bf16x8 a, bf16x8 b, f32x16 c) { return __builtin_amdgcn_mfma_f32_32x32x16_bf16(a, b, c, 0, 0, 0); }
__device__ __forceinline__ int crow(int rho, int hh) { return (rho & 3) + 8 * (rho >> 2) + 4 * hh; }

__device__ __forceinline__ float fast_log_sigmoid(float a) { return fminf(a, 0.f) - __logf(1.f + __expf(-fabsf(a))); }
__device__ __forceinline__ void gla_prep_unit(const Frame& F, int b, int c) {
  LAS bf16* tile = (LAS bf16*)F.lds;
  LAS float* grs = (LAS float*)(F.lds + 64 * 1040);
  LAS float* tot = grs + 1024;
  constexpr int TP = 520;
  int tid = F.tid; asm volatile("" : "+v"(tid));
  const int col = tid & 255, th = tid >> 8; const int r0 = b * T + c * 64;
  __syncthreads();
  for (int i = tid; i < 1024; i += NTHR) grs[i] = bf2f(F.z()[(size_t)(r0 + (i >> 4)) * ZW + ZC_GR + (i & 15)]);
  { v4u x[8];
#pragma unroll
    for (int i = 0; i < 8; ++i) { const int ch = tid + NTHR * i; x[i] = *(const v4u*)(F.z() + (size_t)(r0 + (ch >> 6)) * ZW + (ch & 63) * 8); }
#pragma unroll
    for (int i = 0; i < 8; ++i) { const int ch = tid + NTHR * i; *(LAS v4u*)(tile + (ch >> 6) * TP + (ch & 63) * 8) = x[i]; } }
  __syncthreads();
  float w2[16];
#pragma unroll
  for (int j = 0; j < 16; ++j) w2[j] = F.P->in.w_gla_a2[j * 256 + col];
  const float bias = F.P->in.b_gla_a[col];
  float bl[32]; float run = 0.f;
#pragma unroll
  for (int tt = 0; tt < 32; ++tt) { const int t = th * 32 + tt; float x = bias;
#pragma unroll
    for (int j = 0; j < 16; ++j) x += grs[t * 16 + j] * w2[j];
    run += fast_log_sigmoid(x) * (1.f / 16.f); bl[tt] = run; }
  tot[th * 256 + col] = run;
  __syncthreads();
  const float base = th ? tot[col] : 0.f, blast = tot[col] + tot[256 + col];
  unsigned kl[16];
#pragma unroll
  for (int tt = 0; tt < 32; ++tt) { const float bt = bl[tt] + base; const int tl = th * 32 + tt; const size_t r = (size_t)(r0 + tl);
    const float q = bf2f(tile[tl * TP + col]), k = bf2f(tile[tl * TP + 256 + col]);
    const float eb = __expf(bt), enb = 1.f / eb;
    F.qd()[r * 256 + col] = (bf16)f2bf(q * 0.125f * eb); F.kd()[r * 256 + col] = (bf16)f2bf(k * enb);
    const unsigned kv = f2bf(k * __expf(blast - bt));
    if (tt & 1) kl[tt >> 1] |= kv << 16; else kl[tt >> 1] = kv; }
  { v4u* dst = (v4u*)(F.klt() + ((size_t)b * 256 + col) * T + c * 64 + th * 32);
#pragma unroll
    for (int i = 0; i < 4; ++i) dst[i] = (v4u){kl[4 * i], kl[4 * i + 1], kl[4 * i + 2], kl[4 * i + 3]}; }
  if (th == 0) F.dch()[((size_t)b * 32 + c) * 256 + col] = __expf(blast);
  __syncthreads();
  { v4u x[8];
#pragma unroll
    for (int i = 0; i < 8; ++i) { const int ch = tid + NTHR * i; x[i] = *(const v4u*)(F.z() + (size_t)(r0 + (ch >> 6)) * ZW + ZC_VA + (ch & 63) * 8); }
#pragma unroll
    for (int i = 0; i < 8; ++i) { const int ch = tid + NTHR * i; *(LAS v4u*)(tile + (ch >> 6) * TP + (ch & 63) * 8) = x[i]; } }
  __syncthreads();
  { v4u* dst = (v4u*)(F.vt() + ((size_t)b * 512 + tid) * T + c * 64);
#pragma unroll
    for (int g = 0; g < 8; ++g) { unsigned w[4];
#pragma unroll
      for (int i = 0; i < 4; ++i) w[i] = (unsigned)tile[(8 * g + 2 * i) * TP + tid] | ((unsigned)tile[(8 * g + 2 * i + 1) * TP + tid] << 16);
      dst[g] = (v4u){w[0], w[1], w[2], w[3]}; } }
}

__device__ __forceinline__ void gla_sample_unit(const Frame& F, int b, int h) {
  LAS float* L = (LAS float*)F.lds;
  LAS float* bc = L;
  LAS float* qd = L + 512;
  LAS float* kd = L + 1024;
  LAS float* kl = L + 1536;
  LAS float* dk = L + 2048;
  LAS float* att = L + 2112;
  LAS float* vv = L + 2176;
  LAS float* part = L + 3200;
  int tid = F.tid; asm volatile("" : "+v"(tid));
  const int r0 = MP + b * DT;
  __syncthreads();
  { const int t = tid >> 6, k = tid & 63; const bf16* zr = F.z() + (size_t)(r0 + t) * ZW; float x = F.P->in.b_gla_a[h * 64 + k];
#pragma unroll
    for (int j = 0; j < 16; ++j) x += bf2f(zr[ZC_GR + j]) * F.P->in.w_gla_a2[j * 256 + h * 64 + k];
    bc[t * 64 + k] = log_sigmoid_f(x) * (1.f / 16.f); }
  for (int i = tid; i < 1024; i += NTHR) vv[i] = bf2f(F.z()[(size_t)(r0 + (i >> 7)) * ZW + ZC_VA + h * 128 + (i & 127)]);
  __syncthreads();
  if (tid < 64) { float run = 0.f; for (int t = 0; t < 8; ++t) { run += bc[t * 64 + tid]; bc[t * 64 + tid] = run; } dk[tid] = expf(run); }
  __syncthreads();
  { const int t = tid >> 6, k = tid & 63; const bf16* zr = F.z() + (size_t)(r0 + t) * ZW; const float bt = bc[t * 64 + k], blast = bc[7 * 64 + k];
    const float q = bf2f(zr[ZC_QA + h * 64 + k]) * 0.125f, kk = bf2f(zr[ZC_KA + h * 64 + k]);
    qd[t * 64 + k] = q * expf(bt); kd[t * 64 + k] = kk * expf(-bt); kl[t * 64 + k] = kk * expf(blast - bt); }
  __syncthreads();
  if (tid < 64) { const int t = tid >> 3, s = tid & 7; float a = 0.f; for (int k = 0; k < 64; ++k) a += qd[t * 64 + k] * kd[s * 64 + k]; att[tid] = s <= t ? a : 0.f; }
  { const int v = tid & 127, kq = tid >> 7; float S0[16];
#pragma unroll
    for (int i = 0; i < 16; ++i) S0[i] = F.P->in.state_gla[(((size_t)b * 4 + h) * 64 + kq * 16 + i) * 128 + v];
#pragma unroll
    for (int t = 0; t < 8; ++t) { float o = 0.f;
#pragma unroll
      for (int i = 0; i < 16; ++i) o += qd[t * 64 + kq * 16 + i] * S0[i];
      part[(kq * 8 + t) * 128 + v] = o; }
#pragma unroll
    for (int i = 0; i < 16; ++i) { float sn = dk[kq * 16 + i] * S0[i];
#pragma unroll
      for (int s = 0; s < 8; ++s) sn += kl[s * 64 + kq * 16 + i] * vv[s * 128 + v];
      F.P->out[nv::OUT_GLAS + (((size_t)b * 4 + h) * 64 + kq * 16 + i) * 128 + v] = sn; } }
  __syncthreads();
  { const int t = F.wave, lane = F.lane; float o[2]; float ss = 0.f;
#pragma unroll
    for (int e = 0; e < 2; ++e) { const int v = lane + 64 * e; float a = part[(0 * 8 + t) * 128 + v] + part[(1 * 8 + t) * 128 + v] + part[(2 * 8 + t) * 128 + v] + part[(3 * 8 + t) * 128 + v];
      for (int s = 0; s <= t; ++s) a += att[t * 8 + s] * vv[s * 128 + v];
      o[e] = a; ss += a * a; }
    const float rs = rsqrtf(wave_sum(ss) * (1.f / 128.f) + 1e-6f);
#pragma unroll
    for (int e = 0; e < 2; ++e) { const int v = lane + 64 * e; const float ra = bf2f(F.z()[(size_t)(r0 + t) * ZW + ZC_RA + h * 128 + v]);
      F.mixin()[(size_t)(r0 + t) * D + h * 128 + v] = (bf16)f2bf(o[e] * rs * F.P->in.g_gla_out[v] * silu_f(ra)); } }
}

__device__ __forceinline__ void gla_passA_item(const Frame& F, int item) {
  const int vh = item & 1, c = (item >> 1) & 31, h = (item >> 6) & 3, b = item >> 8;
  const int lane = F.lane, r = lane & 31, hh = lane >> 5;
  f32x16 acc[2][2];
#pragma unroll
  for (int i = 0; i < 2; ++i)
#pragma unroll
    for (int j = 0; j < 2; ++j)
#pragma unroll
      for (int e = 0; e < 16; ++e) acc[i][j][e] = 0.f;
  const bf16* va = F.vt() + ((size_t)b * 512 + h * 128 + vh * 64 + r) * T + c * 64 + 8 * hh;
  const bf16* ka = F.klt() + ((size_t)b * 256 + h * 64 + r) * T + c * 64 + 8 * hh;
#pragma unroll
  for (int ks = 0; ks < 4; ++ks) { bf16x8 A[2], B[2];
#pragma unroll
    for (int i = 0; i < 2; ++i) { A[i] = *(const bf16x8*)(va + (size_t)i * 32 * T + 16 * ks); B[i] = *(const bf16x8*)(ka + (size_t)i * 32 * T + 16 * ks); }
#pragma unroll
    for (int i = 0; i < 2; ++i)
#pragma unroll
      for (int j = 0; j < 2; ++j) acc[i][j] = mfma32(A[i], B[j], acc[i][j]); }
  float* ub = F.ut() + (((size_t)b * 4 + h) * 32 + c) * 8192;
#pragma unroll
  for (int i = 0; i < 2; ++i)
#pragma unroll
    for (int j = 0; j < 2; ++j)
#pragma unroll
      for (int e = 0; e < 16; ++e) ub[(size_t)(vh * 64 + i * 32 + crow(e, hh)) * 64 + j * 32 + r] = acc[i][j][e];
}
__device__ __forceinline__ void gla_passB(const Frame& F) {
  const int gt = F.bid * NTHR + F.tid;
  if (gt >= 32 * 4096) return;
  const int bh = gt >> 12, pr = gt & 4095, v = pr >> 5, k2 = (pr & 31) * 2, b = bh >> 2, h = bh & 3;
  float s0 = 0.f, s1 = 0.f;
#pragma unroll 1
  for (int cb = 0; cb < 32; cb += 8) {
    f32x2 dd[8], uu[8];
#pragma unroll
    for (int i = 0; i < 8; ++i) { const int c = cb + i; dd[i] = *(const f32x2*)(F.dch() + ((size_t)b * 32 + c) * 256 + h * 64 + k2); uu[i] = *(const f32x2*)(F.ut() + (((size_t)bh * 32 + c) * 128 + v) * 64 + k2); }
#pragma unroll
    for (int i = 0; i < 8; ++i) { const int c = cb + i; *(unsigned*)(F.st() + (((size_t)bh * 32 + c) * 128 + v) * 64 + k2) = pk2(s0, s1);
      s0 = dd[i].x * s0 + uu[i].x; s1 = dd[i].y * s1 + uu[i].y; } }
  F.P->out[nv::OUT_GLAP + ((size_t)bh * 64 + k2) * 128 + v] = s0; F.P->out[nv::OUT_GLAP + ((size_t)bh * 64 + k2 + 1) * 128 + v] = s1;
}
__device__ __forceinline__ void gla_passC_item(const Frame& F, int item) {
  const int th = item & 1, c = (item >> 1) & 31, h = (item >> 6) & 3, b = item >> 8;
  const int lane = F.lane, r = lane & 31, hh = lane >> 5;
  const size_t row0 = (size_t)b * T + c * 64;
  bf16x8 Bq[4];
  { const bf16* qa = F.qd() + (row0 + th * 32 + r) * 256 + h * 64 + 8 * hh;
#pragma unroll
    for (int ks = 0; ks < 4; ++ks) Bq[ks] = *(const bf16x8*)(qa + 16 * ks); }
  f32x16 p[2];
#pragma unroll
  for (int st = 0; st < 2; ++st) {
#pragma unroll
    for (int e = 0; e < 16; ++e) p[st][e] = 0.f;
    const bf16* ka = F.kd() + (row0 + st * 32 + r) * 256 + h * 64 + 8 * hh;
#pragma unroll
    for (int ks = 0; ks < 4; ++ks) p[st] = mfma32(*(const bf16x8*)(ka + 16 * ks), Bq[ks], p[st]);
#pragma unroll
    for (int e = 0; e < 16; ++e) { const int s = st * 32 + crow(e, hh); if (s > th * 32 + r) p[st][e] = 0.f; } }
  f32x16 o[4];
#pragma unroll
  for (int vt = 0; vt < 4; ++vt)
#pragma unroll
    for (int e = 0; e < 16; ++e) o[vt][e] = 0.f;
  { const bf16* sa = F.st() + ((((size_t)b * 4 + h) * 32 + c) * 128 + r) * 64 + 8 * hh;
#pragma unroll
    for (int vt = 0; vt < 4; ++vt)
#pragma unroll
      for (int ks = 0; ks < 4; ++ks) o[vt] = mfma32(*(const bf16x8*)(sa + (size_t)vt * 32 * 64 + 16 * ks), Bq[ks], o[vt]); }
  { const bf16* va = F.vt() + ((size_t)b * 512 + h * 128 + r) * T + c * 64 + 4 * hh;
#pragma unroll
    for (int st = 0; st < 2; ++st)
#pragma unroll
      for (int ks = 0; ks < 2; ++ks) { v4u pb;
        pb.x = pk2(p[st][8 * ks + 0], p[st][8 * ks + 1]); pb.y = pk2(p[st][8 * ks + 2], p[st][8 * ks + 3]); pb.z = pk2(p[st][8 * ks + 4], p[st][8 * ks + 5]); pb.w = pk2(p[st][8 * ks + 6], p[st][8 * ks + 7]);
        const bf16x8 Bp = __builtin_bit_cast(bf16x8, pb);
#pragma unroll
        for (int vt = 0; vt < 4; ++vt) { const bf16* ap = va + (size_t)vt * 32 * T + st * 32 + 16 * ks;
          const v2u lo = *(const v2u*)ap, hi = *(const v2u*)(ap + 8); const v4u av = {lo.x, lo.y, hi.x, hi.y};
          o[vt] = mfma32(__builtin_bit_cast(bf16x8, av), Bp, o[vt]); } } }
  float ss = 0.f;
#pragma unroll
  for (int vt = 0; vt < 4; ++vt)
#pragma unroll
    for (int e = 0; e < 16; ++e) ss += o[vt][e] * o[vt][e];
  ss += __shfl_xor(ss, 32);
  const float rs = rsqrtf(ss * (1.f / 128.f) + 1e-6f);
  const size_t row = row0 + th * 32 + r;
#pragma unroll
  for (int vt = 0; vt < 4; ++vt)
#pragma unroll
    for (int g = 0; g < 4; ++g) { const int v = vt * 32 + 8 * g + 4 * hh;
      const v2u ra = *(const v2u*)(F.z() + row * ZW + ZC_RA + h * 128 + v); const f32x4 gg = *(const f32x4*)(F.P->in.g_gla_out + v);
      v2u w; w.x = pk2(o[vt][4 * g + 0] * rs * gg.x * silu_f(bflo(ra.x)), o[vt][4 * g + 1] * rs * gg.y * silu_f(bfhi(ra.x)));
      w.y = pk2(o[vt][4 * g + 2] * rs * gg.z * silu_f(bflo(ra.y)), o[vt][4 * g + 3] * rs * gg.w * silu_f(bfhi(ra.y)));
      *(v2u*)(F.mixin() + row * D + h * 128 + v) = w; }
}
typedef short v4i16_t __attribute__((ext_vector_type(4)));
__device__ __forceinline__ s16x4 lds_tr(LAS const unsigned char* p) { return __builtin_bit_cast(s16x4, __builtin_amdgcn_ds_read_tr16_b64_v4i16((LAS v4i16_t*)p)); }
__device__ __forceinline__ bf16x8 mk8(s16x4 lo, s16x4 hi) { return (bf16x8){lo[0], lo[1], lo[2], lo[3], hi[0], hi[1], hi[2], hi[3]}; }
__device__ __forceinline__ bf16x8 pack8(const f32x16& p, int o) { v4u w; w.x = pk2(p[o], p[o + 1]); w.y = pk2(p[o + 2], p[o + 3]); w.z = pk2(p[o + 4], p[o + 5]); w.w = pk2(p[o + 6], p[o + 7]); return __builtin_bit_cast(bf16x8, w); }
__device__ __forceinline__ float max16(const f32x16& p) { float a = fmaxf(fmaxf(p[0], p[1]), fmaxf(p[2], p[3])), b = fmaxf(fmaxf(p[4], p[5]), fmaxf(p[6], p[7])), c = fmaxf(fmaxf(p[8], p[9]), fmaxf(p[10], p[11])), d = fmaxf(fmaxf(p[12], p[13]), fmaxf(p[14], p[15])); return fmaxf(fmaxf(a, b), fmaxf(c, d)); }

constexpr int PA_KROW = 400;
constexpr int PA_KB = 64 * PA_KROW, PA_VB = 16384, PA_BUF = PA_KB + PA_VB;
__device__ __forceinline__ void pattn_unit(const Frame& F, int b, int h, int u, int abl = 0) {
  int tid = F.tid; asm volatile("" : "+v"(tid));
  const int lane = tid & 63, r = lane & 31, hh = lane >> 5, w = F.wave;
  const size_t row0 = (size_t)b * T; const int pos = w < 4 ? u + 8 * w : 63 - u - 8 * (w - 4); const int q = pos * 32 + r;
  bf16x8 qf[12];
  { const bf16* qp = F.qbuf() + (row0 + q) * QW + h * 192;
#pragma unroll
    for (int s = 0; s < 8; ++s) { const v4u x = *(const v4u*)(qp + 16 * s + 8 * hh); v4u y;
      y.x = pk2(bflo(x.x) * C2, bfhi(x.x) * C2); y.y = pk2(bflo(x.y) * C2, bfhi(x.y) * C2); y.z = pk2(bflo(x.z) * C2, bfhi(x.z) * C2); y.w = pk2(bflo(x.w) * C2, bfhi(x.w) * C2);
      qf[s] = __builtin_bit_cast(bf16x8, y); }
#pragma unroll
    for (int e = 0; e < 2; ++e) { const int i0 = 16 * e + 8 * hh; const v4u a = *(const v4u*)(qp + 128 + i0), c = *(const v4u*)(qp + 160 + i0);
      const f32x2* cs = F.rope() + (size_t)q * 32 + i0; unsigned o1[4], o2[4];
#pragma unroll
      for (int j = 0; j < 4; ++j) { const unsigned aw = a[j], cw = c[j]; const f32x2 c0 = cs[2 * j], c1 = cs[2 * j + 1];
        const float x1a = bflo(aw), x1b = bfhi(aw), x2a = bflo(cw), x2b = bfhi(cw);
        o1[j] = pk2((x1a * c0.x - x2a * c0.y) * C2, (x1b * c1.x - x2b * c1.y) * C2); o2[j] = pk2((x1a * c0.y + x2a * c0.x) * C2, (x1b * c1.y + x2b * c1.x) * C2); }
      qf[8 + e] = __builtin_bit_cast(bf16x8, ((v4u){o1[0], o1[1], o1[2], o1[3]})); qf[10 + e] = __builtin_bit_cast(bf16x8, ((v4u){o2[0], o2[1], o2[2], o2[3]})); } }
  f32x16 o[4];
#pragma unroll
  for (int dt = 0; dt < 4; ++dt)
#pragma unroll
    for (int e = 0; e < 16; ++e) o[dt][e] = 0.f;
  float m = -INFINITY, lsum = 0.f;
  const int nt = ((63 - u) >> 1) + 1, jdiag = pos >> 1;
  const unsigned char* ksrc = (const unsigned char*)(F.kcomb() + ((size_t)(b * 4 + h) * T) * 200) + lane * 16;
  const unsigned char* vsrc = (const unsigned char*)(F.vb() + row0 * 512 + h * 128) + (lane >> 2) * 1024 + (lane & 3) * 16;
#define PA_ISSUE(j_, slot_) do { LAS unsigned char* kb_ = F.lds + (slot_) * PA_BUF; \
    for (int c_ = w; c_ < 25; c_ += 8) __builtin_amdgcn_global_load_lds((const unsigned*)(ksrc + (size_t)(j_) * PA_KB + c_ * 1024), (LAS unsigned*)(kb_ + c_ * 1024), 16, 0, 0); \
    _Pragma("unroll") for (int i_ = 0; i_ < 2; ++i_) { const int c_ = w + 8 * i_; \
      __builtin_amdgcn_global_load_lds((const unsigned*)(vsrc + (size_t)(j_) * 65536 + (c_ & 3) * 16384 + (c_ >> 2) * 64), (LAS unsigned*)(kb_ + PA_KB + c_ * 1024), 16, 0, 0); } } while (0)
#define PA_WAITBAR(keep_) do { if (keep_) { if (w == 0) asm volatile("s_waitcnt vmcnt(6)" ::: "memory"); else asm volatile("s_waitcnt vmcnt(5)" ::: "memory"); } \
    else asm volatile("s_waitcnt vmcnt(0)" ::: "memory"); \
    asm volatile("s_waitcnt lgkmcnt(0)" ::: "memory"); __builtin_amdgcn_s_barrier(); asm volatile("" ::: "memory"); } while (0)
#define PA_BAR() do { asm volatile("s_waitcnt lgkmcnt(0)" ::: "memory"); __builtin_amdgcn_s_barrier(); asm volatile("" ::: "memory"); } while (0)
  const int trbase = ((lane >> 4) & 1) * 32 + (lane & 3) * 8 + (4 * hh + ((lane & 15) >> 2)) * 64;
  bf16x8 pb[4];
#define PA_S(j_, slot_) do { if ((j_) <= jdiag && !(abl & 5)) { \
      LAS const unsigned char* ka = F.lds + (slot_) * PA_BUF + r * PA_KROW + 16 * hh; \
      f32x16 p0, p1; \
      _Pragma("unroll") for (int e = 0; e < 16; ++e) { p0[e] = 0.f; p1[e] = 0.f; } \
      bf16x8 kf[2][4]; \
      PA_KLD(0); __builtin_amdgcn_sched_barrier(0); \
      PA_KLD(1); __builtin_amdgcn_sched_barrier(0); PA_KMM(0); __builtin_amdgcn_sched_barrier(0); \
      PA_KLD(2); __builtin_amdgcn_sched_barrier(0); PA_KMM(1); __builtin_amdgcn_sched_barrier(0); \
      PA_KLD(3); __builtin_amdgcn_sched_barrier(0); PA_KMM(2); __builtin_amdgcn_sched_barrier(0); \
      PA_KLD(4); __builtin_amdgcn_sched_barrier(0); PA_KMM(3); __builtin_amdgcn_sched_barrier(0); \
      PA_KLD(5); __builtin_amdgcn_sched_barrier(0); PA_KMM(4); __builtin_amdgcn_sched_barrier(0); \
      PA_KMM(5); \
      if ((j_) == jdiag) { _Pragma("unroll") for (int e = 0; e < 16; ++e) { const int kv = 64 * (j_) + crow(e, hh); if (kv > q) p0[e] = -INFINITY; if (kv + 32 > q) p1[e] = -INFINITY; } } \
      float tmax = fmaxf(max16(p0), max16(p1)); tmax = fmaxf(tmax, __shfl_xor(tmax, 32)); \
      const float mn = fmaxf(m, tmax), alpha = __builtin_amdgcn_exp2f(m - mn); m = mn; \
      float ps = 0.f; \
      _Pragma("unroll") for (int e = 0; e < 16; ++e) { p0[e] = __builtin_amdgcn_exp2f(p0[e] - mn); p1[e] = __builtin_amdgcn_exp2f(p1[e] - mn); ps += p0[e] + p1[e]; } \
      lsum = lsum * alpha + ps; \
      if (__any(alpha != 1.f)) { _Pragma("unroll") for (int dt = 0; dt < 4; ++dt) _Pragma("unroll") for (int e = 0; e < 16; ++e) o[dt][e] *= alpha; } \
      pb[0] = pack8(p0, 0); pb[1] = pack8(p0, 8); pb[2] = pack8(p1, 0); pb[3] = pack8(p1, 8); } } while (0)
#define PA_KLD(g_) do { _Pragma("unroll") for (int t_ = 0; t_ < 2; ++t_) { kf[(g_) & 1][2 * t_] = *(LAS const bf16x8*)(ka + 32 * (2 * (g_) + t_)); kf[(g_) & 1][2 * t_ + 1] = *(LAS const bf16x8*)(ka + 32 * PA_KROW + 32 * (2 * (g_) + t_)); } } while (0)
#define PA_KMM(g_) do { _Pragma("unroll") for (int t_ = 0; t_ < 2; ++t_) { p0 = mfma32(kf[(g_) & 1][2 * t_], qf[2 * (g_) + t_], p0); p1 = mfma32(kf[(g_) & 1][2 * t_ + 1], qf[2 * (g_) + t_], p1); } } while (0)
#define PA_TR(dst_, off_) asm volatile("ds_read_b64_tr_b16 %0, %1 offset:%c2" : "=&v"(dst_) : "v"(vaddr), "i"(off_) : "memory")
#define PA_VLD(g_) do { _Pragma("unroll") for (int dt = 0; dt < 4; ++dt) { PA_TR(vf[(g_) & 1][2 * dt], dt * 4096 + (g_) * 1024); PA_TR(vf[(g_) & 1][2 * dt + 1], dt * 4096 + (g_) * 1024 + 512); } } while (0)
#define PA_VMM(g_) do { _Pragma("unroll") for (int dt = 0; dt < 4; ++dt) o[dt] = mfma32(mk8(vf[(g_) & 1][2 * dt], vf[(g_) & 1][2 * dt + 1]), pb[g_], o[dt]); } while (0)
#define PA_LW() do { asm volatile("s_waitcnt lgkmcnt(0)" ::: "memory"); __builtin_amdgcn_sched_barrier(0); } while (0)
#define PA_PV(j_, slot_) do { if ((j_) <= jdiag && !(abl & 9)) { \
      const unsigned vaddr = (unsigned)(uintptr_t)(F.lds + (slot_) * PA_BUF + PA_KB) + (unsigned)trbase; s16x4 vf[2][8]; \
      PA_VLD(0); PA_LW(); \
      PA_VLD(1); __builtin_amdgcn_sched_barrier(0); PA_VMM(0); __builtin_amdgcn_sched_barrier(0); PA_LW(); \
      PA_VLD(2); __builtin_amdgcn_sched_barrier(0); PA_VMM(1); __builtin_amdgcn_sched_barrier(0); PA_LW(); \
      PA_VLD(3); __builtin_amdgcn_sched_barrier(0); PA_VMM(2); __builtin_amdgcn_sched_barrier(0); PA_LW(); \
      PA_VMM(3); } } while (0)
  __syncthreads();
  if (!(abl & 2)) { PA_ISSUE(0, 0); PA_ISSUE(1, 1); }
  PA_WAITBAR(true);
#define PA_STEP_L(j_, k_) do { PA_S(j_, k_); PA_BAR(); const bool more_ = ((j_) + 2 < nt) && !(abl & 2); if (more_) PA_ISSUE((j_) + 2, ((k_) + 2) % 3); PA_PV(j_, k_); PA_WAITBAR(more_); } while (0)
#define PA_STEP_U(j_, k_) do { if ((j_) > 0) PA_PV((j_) - 1, ((k_) + 2) % 3); PA_BAR(); const bool more_ = ((j_) + 2 < nt) && !(abl & 2); if (more_) PA_ISSUE((j_) + 2, ((k_) + 2) % 3); PA_S(j_, k_); PA_WAITBAR(more_); } while (0)
  if (w < 4) {
    for (int j = 0; j < nt; j += 3) { PA_STEP_L(j, 0); if (j + 1 < nt) PA_STEP_L(j + 1, 1); if (j + 2 < nt) PA_STEP_L(j + 2, 2); }
  } else {
    for (int j = 0; j < nt; j += 3) { PA_STEP_U(j, 0); if (j + 1 < nt) PA_STEP_U(j + 1, 1); if (j + 2 < nt) PA_STEP_U(j + 2, 2); }
    const int ls = (nt - 1) % 3;
    if (ls == 0) PA_PV(nt - 1, 0); else if (ls == 1) PA_PV(nt - 1, 1); else PA_PV(nt - 1, 2);
  }
#undef PA_STEP_L
#undef PA_STEP_U
#undef PA_ISSUE
#undef PA_WAITBAR
#undef PA_BAR
#undef PA_S
#undef PA_KLD
#undef PA_KMM
#undef PA_VLD
#undef PA_VMM
#undef PA_PV
#undef PA_TR
#undef PA_LW
  const float lt = lsum + __shfl_xor(lsum, 32); const float inv = 1.f / lt;
  float ss = 0.f;
#pragma unroll
  for (int dt = 0; dt < 4; ++dt)
#pragma unroll
    for (int e = 0; e < 16; ++e) { o[dt][e] *= inv; ss += o[dt][e] * o[dt][e]; }
  ss += __shfl_xor(ss, 32);
  const float rs = rsqrtf(ss * (1.f / 128.f) + 1e-6f);
  bf16* op = F.mixin() + (row0 + q) * D + 512 + h * 128;
#pragma unroll
  for (int dt = 0; dt < 4; ++dt)
#pragma unroll
    for (int g = 0; g < 4; ++g) { const int d = dt * 32 + 8 * g + 4 * hh; const f32x4 gg = *(const f32x4*)(F.P->in.g_mla_out + d);
      v2u wv; wv.x = pk2(o[dt][4 * g] * rs * gg.x, o[dt][4 * g + 1] * rs * gg.y); wv.y = pk2(o[dt][4 * g + 2] * rs * gg.z, o[dt][4 * g + 3] * rs * gg.w);
      *(v2u*)(op + d) = wv; }
}

constexpr int DA_KROW = 656;
constexpr int DA_Q = 32 * DA_KROW, DA_KB = 32 * DA_KROW, DA_VB = 16384, DA_BUF = DA_KB + DA_VB;
__device__ __forceinline__ int split_tile0(int s) { return (512 * s) / NSPLIT; }
__device__ __forceinline__ void dattn_unit(const Frame& F, int b, int sp, int abl = 0) {
  int tid = F.tid; asm volatile("" : "+v"(tid));
  const int lane = tid & 63, r = lane & 31, hh = lane >> 5, w = F.wave;
  LAS unsigned char* qs = F.lds; LAS unsigned char* bufs = F.lds + DA_Q;
  __syncthreads();
  { const int rr = tid >> 4, cg = tid & 15, t = rr >> 2, h = rr & 3; const bf16* qrow = F.qbuf() + (size_t)(MP + b * DT + t) * QW;
    const v4u* src = (const v4u*)(qrow + 768 + h * 256 + cg * 16); LAS v4u* dst = (LAS v4u*)(qs + rr * DA_KROW + cg * 32);
#pragma unroll
    for (int e = 0; e < 2; ++e) { const v4u x = src[e]; v4u y;
      y.x = pk2(bflo(x.x) * C2, bfhi(x.x) * C2); y.y = pk2(bflo(x.y) * C2, bfhi(x.y) * C2); y.z = pk2(bflo(x.z) * C2, bfhi(x.z) * C2); y.w = pk2(bflo(x.w) * C2, bfhi(x.w) * C2); dst[e] = y; }
    LAS bf16* qd = (LAS bf16*)(qs + rr * DA_KROW);
#pragma unroll
    for (int e = 0; e < 2; ++e) { const int i = 2 * cg + e; const float x1 = bf2f(qrow[h * 192 + 128 + i]), x2 = bf2f(qrow[h * 192 + 160 + i]); const f32x2 cs = F.rope()[(2048 + t) * 32 + i];
      qd[256 + i] = (bf16)f2bf((x1 * cs.x - x2 * cs.y) * C2); qd[288 + i] = (bf16)f2bf((x1 * cs.y + x2 * cs.x) * C2); } }
  const int t0 = split_tile0(sp), t1 = split_tile0(sp + 1); const bool has_new = (sp == NSPLIT - 1); const int nt = (t1 - t0) + (has_new ? 1 : 0);
  f32x4 la[4], ra, lb[4], rb;
#define DA_LOAD(L_, R_, ti_) do { const int tile_ = t0 + (ti_); const int page_ = F.P->in.page_table[b * NPG + (tile_ >> 2)]; const size_t prow_ = (size_t)page_ * 128 + (tile_ & 3) * 32; \
    _Pragma("unroll") for (int i_ = 0; i_ < 4; ++i_) { const int f_ = tid + NTHR * i_; L_[i_] = __builtin_nontemporal_load((const f32x4*)(F.P->in.cache_lat + (prow_ + (f_ >> 6)) * 256 + (f_ & 63) * 4)); } \
    R_ = __builtin_nontemporal_load((const f32x4*)(F.P->in.cache_kr + (prow_ + (tid >> 4)) * 64 + (tid & 15) * 4)); } while (0)
#define DA_STORE(L_, R_, buf_) do { LAS unsigned char* kb_ = bufs + (buf_) * DA_BUF; LAS unsigned char* vb_ = kb_ + DA_KB; \
    _Pragma("unroll") for (int i_ = 0; i_ < 4; ++i_) { const int f_ = tid + NTHR * i_, row_ = f_ >> 6, c4_ = f_ & 63; v2u wv_; wv_.x = pk2(L_[i_].x, L_[i_].y); wv_.y = pk2(L_[i_].z, L_[i_].w); \
      *(LAS v2u*)(kb_ + row_ * DA_KROW + c4_ * 8) = wv_; *(LAS v2u*)(vb_ + (c4_ >> 3) * 2048 + row_ * 64 + (c4_ & 7) * 8) = wv_; } \
    { const int row_ = tid >> 4, c4_ = tid & 15; v2u wv_; wv_.x = pk2(R_.x, R_.y); wv_.y = pk2(R_.z, R_.w); *(LAS v2u*)(kb_ + row_ * DA_KROW + 512 + c4_ * 8) = wv_; } } while (0)
#define DA_STORE_NEW(buf_) do { LAS unsigned char* kb_ = bufs + (buf_) * DA_BUF; LAS unsigned char* vb_ = kb_ + DA_KB; \
    _Pragma("unroll") for (int i_ = 0; i_ < 4; ++i_) { const int f_ = tid + NTHR * i_, row_ = f_ >> 6, c4_ = f_ & 63; v2u wv_ = {0u, 0u}; \
      if (row_ < DT) wv_ = *(const v2u*)(F.latb() + (size_t)(MP + b * DT + row_) * 256 + c4_ * 4); \
      *(LAS v2u*)(kb_ + row_ * DA_KROW + c4_ * 8) = wv_; *(LAS v2u*)(vb_ + (c4_ >> 3) * 2048 + row_ * 64 + (c4_ & 7) * 8) = wv_; } \
    { const int row_ = tid >> 4, c4_ = tid & 15; v2u wv_ = {0u, 0u}; if (row_ < DT) wv_ = *(const v2u*)(F.krb() + (size_t)(MP + b * DT + row_) * 64 + c4_ * 4); \
      *(LAS v2u*)(kb_ + row_ * DA_KROW + 512 + c4_ * 8) = wv_; } } while (0)
  const int npast = t1 - t0;
  f32x16 o;
#pragma unroll
  for (int e = 0; e < 16; ++e) o[e] = 0.f;
  float m = -INFINITY, lsum = 0.f;
  const int trbase = ((lane >> 4) & 1) * 32 + (lane & 3) * 8 + (4 * hh + ((lane & 15) >> 2)) * 64;
#define DA_COMPUTE(buf_, j_) do { \
      LAS const unsigned char* kb = bufs + (buf_) * DA_BUF; LAS const unsigned char* vbp = kb + DA_KB; \
      f32x16 p; \
      _Pragma("unroll") for (int e = 0; e < 16; ++e) p[e] = 0.f; \
      LAS const unsigned char* ka = kb + r * DA_KROW + 16 * hh; LAS const unsigned char* qa = qs + r * DA_KROW + 16 * hh; \
      _Pragma("unroll") for (int s = 0; s < 20; ++s) { p = mfma32(*(LAS const bf16x8*)(ka + 32 * s), *(LAS const bf16x8*)(qa + 32 * s), p); if ((s % 5) == 4) __builtin_amdgcn_sched_barrier(0); } \
      if ((j_) >= npast) { _Pragma("unroll") for (int e = 0; e < 16; ++e) { const int kv = crow(e, hh); if (kv > (r >> 2)) p[e] = -INFINITY; } } \
      float tmax = max16(p); tmax = fmaxf(tmax, __shfl_xor(tmax, 32)); \
      const float mn = fmaxf(m, tmax), alpha = __builtin_amdgcn_exp2f(m - mn); m = mn; \
      float ps = 0.f; \
      _Pragma("unroll") for (int e = 0; e < 16; ++e) { p[e] = __builtin_amdgcn_exp2f(p[e] - mn); ps += p[e]; } \
      lsum = lsum * alpha + ps; \
      _Pragma("unroll") for (int e = 0; e < 16; ++e) o[e] *= alpha; \
      _Pragma("unroll") for (int ks = 0; ks < 2; ++ks) { LAS const unsigned char* vp = vbp + w * 2048 + (16 * ks) * 64 + trbase; \
        o = mfma32(mk8(lds_tr(vp), lds_tr(vp + 512)), pack8(p, 8 * ks), o); } } while (0)
  DA_LOAD(la, ra, 0); DA_STORE(la, ra, 0);
  if (npast > 1) DA_LOAD(la, ra, 1);
  for (int j = 0; j < nt; j += 2) {
    __syncthreads();
    if (j + 2 < npast) DA_LOAD(lb, rb, j + 2);
    if (!(abl & 1)) DA_COMPUTE(0, j);
    if (abl & 2) { asm volatile("" :: "v"(la[0]), "v"(la[1]), "v"(la[2]), "v"(la[3]), "v"(ra)); } else
    if (j + 1 < npast) DA_STORE(la, ra, 1); else if (j + 1 < nt) DA_STORE_NEW(1);
    if (j + 1 >= nt) break;
    __syncthreads();
    if (j + 3 < npast) DA_LOAD(la, ra, j + 3);
    if (!(abl & 1)) DA_COMPUTE(1, j + 1);
    if (abl & 2) { asm volatile("" :: "v"(lb[0]), "v"(lb[1]), "v"(lb[2]), "v"(lb[3]), "v"(rb)); } else
    if (j + 2 < npast) DA_STORE(lb, rb, 0); else if (j + 2 < nt) DA_STORE_NEW(0);
  }
#undef DA_LOAD
#undef DA_STORE
#undef DA_STORE_NEW
#undef DA_COMPUTE
  float* po = F.dpo() + (((size_t)b * NSPLIT + sp) * 32 + r) * 256 + 32 * w;
#pragma unroll
  for (int g = 0; g < 4; ++g) *(f32x4*)(po + 8 * g + 4 * hh) = (f32x4){o[4 * g], o[4 * g + 1], o[4 * g + 2], o[4 * g + 3]};
  const float lt = lsum + __shfl_xor(lsum, 32);
  if (w == 0 && lane < 32) { float* pm = F.dpml() + ((size_t)b * NSPLIT + sp) * 64; pm[r] = m; pm[32 + r] = lt; }
}
__device__ __forceinline__ void dcombine_unit(const Frame& F, int b, int t) {
  LAS float* ol = (LAS float*)F.lds;
  LAS float* red = ol + 1024;
  const int tid = F.tid, h = tid >> 7, q = t * 4 + h;
  __syncthreads();
  { const int d2 = (tid & 127) * 2; float mm[NSPLIT], M = -INFINITY;
#pragma unroll
    for (int s = 0; s < NSPLIT; ++s) { mm[s] = F.dpml()[((size_t)b * NSPLIT + s) * 64 + q]; M = fmaxf(M, mm[s]); }
    float Lt = 0.f; f32x2 a = {0.f, 0.f};
#pragma unroll
    for (int s = 0; s < NSPLIT; ++s) { const float ws = __builtin_amdgcn_exp2f(mm[s] - M); Lt += ws * F.dpml()[((size_t)b * NSPLIT + s) * 64 + 32 + q];
      a += ws * *(const f32x2*)(F.dpo() + (((size_t)b * NSPLIT + s) * 32 + q) * 256 + d2); }
    const float inv = 1.f / Lt; ol[h * 256 + d2] = a.x * inv; ol[h * 256 + d2 + 1] = a.y * inv; }
  __syncthreads();
  { const int v = tid & 127; const v4u* wr = (const v4u*)(F.wkv_t() + (size_t)(512 + h * 128 + v) * 256); float acc = 0.f;
#pragma unroll
    for (int hb = 0; hb < 2; ++hb) { v4u wv[16];
#pragma unroll
      for (int i = 0; i < 16; ++i) wv[i] = wr[16 * hb + i];
#pragma unroll
      for (int i = 0; i < 16; ++i) { const LAS float* o8 = ol + h * 256 + (16 * hb + i) * 8;
        acc += o8[0] * bflo(wv[i].x) + o8[1] * bfhi(wv[i].x) + o8[2] * bflo(wv[i].y) + o8[3] * bfhi(wv[i].y) + o8[4] * bflo(wv[i].z) + o8[5] * bfhi(wv[i].z) + o8[6] * bflo(wv[i].w) + o8[7] * bfhi(wv[i].w); } }
    const float ws2 = wave_sum(acc * acc);
    if (F.lane == 0) red[F.wave] = ws2;
    __syncthreads();
    const float ss = red[2 * h] + red[2 * h + 1];
    const float rs = rsqrtf(ss * (1.f / 128.f) + 1e-6f);
    F.mixin()[(size_t)(MP + b * DT + t) * D + 512 + h * 128 + v] = (bf16)f2bf(acc * rs * F.P->in.g_mla_out[v]); }
}
struct StaticOrder {
  int nM, nN, nwg, G, c;
  __device__ void init(int nM_, int nN_, int G_, int c_) { nM = nM_; nN = nN_; nwg = nM * nN; G = G_; c = c_; }
  __device__ bool next(int i, pg8::Unit& u) const {
    const long L = (long)i * G + c; if (L >= nwg) return false;
    int wgid = (int)L; { const int q = nwg / 8, r = nwg % 8, xcd = wgid % 8, off = wgid / 8; wgid = (xcd < r ? xcd * (q + 1) : r * (q + 1) + (xcd - r) * q) + off; }
    const int nig = 8 * nN, gid = wgid / nig, fm = gid * 8, gsz = (nM - fm) < 8 ? (nM - fm) : 8;
    u.pm = fm + ((wgid % nig) % gsz); u.pn = (wgid % nig) / gsz; u.kk = 0; return true;
  }
  __device__ __forceinline__ void a_ready(const pg8::Unit&) const {}
  __device__ __forceinline__ void done(const pg8::Unit&) const {}
};
struct SchedQ {
  int G, c;
  __device__ bool next(int i, pg8::Unit& u) const {
    const int L = i * G + c; if (L >= 199) return false;
    if (L < 192) { u.pm = L / 3; u.pn = L % 3; } else { u.pm = 64; u.pn = L - 192; }
    u.kk = 0; return true;
  }
  __device__ __forceinline__ void a_ready(const pg8::Unit&) const {}
  __device__ __forceinline__ void done(const pg8::Unit&) const {}
};
struct EpiBf16 {
  static constexpr bool PERM = true, AFTER_DRAIN = false;
  bf16* O; int ldc; int split_cols; size_t split_stride;
  __device__ __forceinline__ void operator()(const pg8::f32x4 (&acc)[2][2][4][2], const pg8::Unit& u, int wr, int wc, int fr, int fq) const {
    const int row0 = u.pm * 256 + wr * 64 + fr; int colt = u.pn * 256; bf16* base = O;
    if (split_cols) { const int t = colt / split_cols; base += (size_t)t * split_stride; colt -= t * split_cols; }
    const int col0 = colt + wc * 32 + 8 * fq;
#pragma unroll
    for (int ai = 0; ai < 2; ++ai)
#pragma unroll
      for (int m = 0; m < 4; ++m) { bf16* rowp = base + (size_t)(row0 + ai * 128 + m * 16) * ldc + col0;
#pragma unroll
        for (int bj = 0; bj < 2; ++bj) { const pg8::f32x4 v0 = acc[ai][bj][m][0], v1 = acc[ai][bj][m][1];
          v4u w; w.x = pg8::cvt_pk_bf16(v0[0], v0[1]); w.y = pg8::cvt_pk_bf16(v0[2], v0[3]); w.z = pg8::cvt_pk_bf16(v1[0], v1[1]); w.w = pg8::cvt_pk_bf16(v1[2], v1[3]);
          *(v4u*)(rowp + bj * 128) = w; } }
  }
};
struct EpiKV {
  static constexpr bool PERM = true, AFTER_DRAIN = false;
  bf16* KC; bf16* VB;
  __device__ __forceinline__ void operator()(const pg8::f32x4 (&acc)[2][2][4][2], const pg8::Unit& u, int wr, int wc, int fr, int fq) const {
    const int row0 = u.pm * 256 + wr * 64 + fr; const int cin = wc * 32 + 8 * fq;
#pragma unroll
    for (int ai = 0; ai < 2; ++ai)
#pragma unroll
      for (int m = 0; m < 4; ++m) { const int row = row0 + ai * 128 + m * 16;
#pragma unroll
        for (int bj = 0; bj < 2; ++bj) { const pg8::f32x4 v0 = acc[ai][bj][m][0], v1 = acc[ai][bj][m][1];
          v4u w; w.x = pg8::cvt_pk_bf16(v0[0], v0[1]); w.y = pg8::cvt_pk_bf16(v0[2], v0[3]); w.z = pg8::cvt_pk_bf16(v1[0], v1[1]); w.w = pg8::cvt_pk_bf16(v1[2], v1[3]);
          if (u.pn < 2) *(v4u*)(KC + ((size_t)((row >> 11) * 4 + 2 * u.pn + bj) * T + (row & 2047)) * 200 + cin) = w;
          else *(v4u*)(VB + (size_t)row * 512 + (u.pn - 2) * 256 + bj * 128 + cin) = w; } }
  }
};
struct EpiUp {
  static constexpr bool PERM = true, AFTER_DRAIN = false;
  bf16* O; float* out;
  __device__ __forceinline__ void operator()(const pg8::f32x4 (&acc)[2][2][4][2], const pg8::Unit& u, int wr, int wc, int fr, int fq) const {
    const int row0 = u.pm * 256 + wr * 64 + fr; const int col0 = u.pn * 256 + wc * 32 + 8 * fq;
#pragma unroll
    for (int ai = 0; ai < 2; ++ai)
#pragma unroll
      for (int m = 0; m < 4; ++m) { const int row = row0 + ai * 128 + m * 16; bf16* rowp = O + (size_t)row * F2 + col0;
        float* cv = nullptr;
        if (row < MP) { const int t = row & 2047; if (t >= T - 2) cv = out + nv::OUT_CONVP + ((size_t)(row >> 11) * 2 + (t - (T - 2))) * F2 + col0; }
        else { const int t = (row - MP) & 7; if (t >= DT - 2) cv = out + nv::OUT_CONVS + ((size_t)((row - MP) >> 3) * 2 + (t - (DT - 2))) * F2 + col0; }
#pragma unroll
        for (int bj = 0; bj < 2; ++bj) { const pg8::f32x4 v0 = acc[ai][bj][m][0], v1 = acc[ai][bj][m][1];
          v4u w; w.x = pg8::cvt_pk_bf16(v0[0], v0[1]); w.y = pg8::cvt_pk_bf16(v0[2], v0[3]); w.z = pg8::cvt_pk_bf16(v1[0], v1[1]); w.w = pg8::cvt_pk_bf16(v1[2], v1[3]);
          *(v4u*)(rowp + bj * 128) = w;
          if (cv) { *(pg8::f32x4*)(cv + bj * 128) = v0; *(pg8::f32x4*)(cv + bj * 128 + 4) = v1; } } }
  }
};
struct EpiF32 {
  static constexpr bool PERM = false, AFTER_DRAIN = false;
  float* C; int ldc;
  __device__ __forceinline__ void operator()(const pg8::f32x4 (&acc)[2][2][4][2], const pg8::Unit& u, int wr, int wc, int fr, int fq) const {
    const int row0 = u.pm * 256 + wr * 64 + fr, col0 = u.pn * 256 + wc * 32 + 4 * fq;
#pragma unroll
    for (int ai = 0; ai < 2; ++ai)
#pragma unroll
      for (int m = 0; m < 4; ++m) { float* rowp = C + (size_t)(row0 + ai * 128 + m * 16) * ldc + col0;
#pragma unroll
        for (int bj = 0; bj < 2; ++bj)
#pragma unroll
          for (int n = 0; n < 2; ++n) *(pg8::f32x4*)(rowp + bj * 128 + n * 16) = acc[ai][bj][m][n]; }
  }
};

struct SchedPart {
  int n, G, c;
  __device__ bool next(int i, pg8::Unit& u) const { const int L = i * G + c; if (L >= n) return false; u.pm = 64; u.pn = L & 3; u.kk = L >> 2; return true; }
  __device__ __forceinline__ void a_ready(const pg8::Unit&) const {}
  __device__ __forceinline__ void done(const pg8::Unit&) const {}
};
struct EpiPart {
  static constexpr bool PERM = false, AFTER_DRAIN = false;
  float* P;
  __device__ __forceinline__ void operator()(const pg8::f32x4 (&acc)[2][2][4][2], const pg8::Unit& u, int wr, int wc, int fr, int fq) const {
    const int row0 = wr * 64 + fr, col0 = u.pn * 256 + wc * 32 + 4 * fq; float* base = P + (size_t)u.kk * 256 * 1024;
#pragma unroll
    for (int ai = 0; ai < 2; ++ai)
#pragma unroll
      for (int m = 0; m < 4; ++m) { float* rowp = base + (size_t)(row0 + ai * 128 + m * 16) * 1024 + col0;
#pragma unroll
        for (int bj = 0; bj < 2; ++bj)
#pragma unroll
          for (int n = 0; n < 2; ++n) *(pg8::f32x4*)(rowp + bj * 128 + n * 16) = acc[ai][bj][m][n]; }
  }
};

__device__ __forceinline__ float gelu_tanh_f(float x) {
  const float y2 = (-2.f * 0.7978845608028654f * 1.4426950408889634f) * (x + 0.044715f * x * x * x); return x * __builtin_amdgcn_rcpf(1.f + __builtin_amdgcn_exp2f(y2)); }
__device__ __forceinline__ void ld8bf(const bf16* p, float (&v)[8]) { const v4u x = *(const v4u*)p;
  v[0] = bflo(x.x); v[1] = bfhi(x.x); v[2] = bflo(x.y); v[3] = bfhi(x.y); v[4] = bflo(x.z); v[5] = bfhi(x.z); v[6] = bflo(x.w); v[7] = bfhi(x.w); }
__device__ __forceinline__ void ld8f(const float* p, float (&v)[8]) { const f32x4 a = *(const f32x4*)p, b = *(const f32x4*)(p + 4);
  v[0] = a.x; v[1] = a.y; v[2] = a.z; v[3] = a.w; v[4] = b.x; v[5] = b.y; v[6] = b.z; v[7] = b.w; }
constexpr int P10_ROWS = 45;
__device__ __forceinline__ void p10_convgelu(const Frame& F) {
  const int gt = F.bid * NTHR + F.tid; const int fg = gt % 352, chunk = gt / 352, f = fg * 8;
  const int rbeg = chunk * P10_ROWS; if (rbeg >= MT) return; const int rend = rbeg + P10_ROWS < MT ? rbeg + P10_ROWS : MT;
  float w[2][3][8], bias[2][8], um2[2][8], um1[2][8];
#pragma unroll
  for (int half = 0; half < 2; ++half) { const int col = f + half * FF; ld8f(F.P->in.b_ffn_conv + col, bias[half]);
#pragma unroll
    for (int j = 0; j < 3; ++j) ld8f(F.P->in.w_ffn_conv + (size_t)j * F2 + col, w[half][j]); }
  auto seq_t = [](int r) { return r >= MP ? (r - MP) & 7 : r & 2047; };
  { const int t = seq_t(rbeg);
#pragma unroll
    for (int half = 0; half < 2; ++half) { const int col = f + half * FF;
      if (t >= 2) { ld8bf(F.u() + (size_t)(rbeg - 2) * F2 + col, um2[half]); ld8bf(F.u() + (size_t)(rbeg - 1) * F2 + col, um1[half]); }
      else if (t == 1) { ld8bf(F.u() + (size_t)(rbeg - 1) * F2 + col, um1[half]);
        if (rbeg >= MP) ld8f(F.P->in.state_conv + ((size_t)((rbeg - MP) >> 3) * 2 + 1) * F2 + col, um2[half]);
        else {
#pragma unroll
          for (int e = 0; e < 8; ++e) um2[half][e] = 0.f; } }
      else {
#pragma unroll
        for (int e = 0; e < 8; ++e) { um2[half][e] = 0.f; um1[half][e] = 0.f; } } } }
#pragma unroll 5
  for (int r = rbeg; r < rend; ++r) {
    float uc[2][8], cur[2][8];
#pragma unroll
    for (int half = 0; half < 2; ++half) ld8bf(F.u() + (size_t)r * F2 + f + half * FF, cur[half]);
    if (seq_t(r) == 0) {
#pragma unroll
      for (int half = 0; half < 2; ++half) { const int col = f + half * FF;
        if (r >= MP) { const float* sc = F.P->in.state_conv + (size_t)((r - MP) >> 3) * 2 * F2 + col; ld8f(sc, um2[half]); ld8f(sc + F2, um1[half]); }
        else {
#pragma unroll
          for (int e = 0; e < 8; ++e) { um2[half][e] = 0.f; um1[half][e] = 0.f; } } } }
#pragma unroll
    for (int half = 0; half < 2; ++half)
#pragma unroll
      for (int e = 0; e < 8; ++e) { uc[half][e] = bias[half][e] + w[half][0][e] * um2[half][e] + w[half][1][e] * um1[half][e] + w[half][2][e] * cur[half][e]; um2[half][e] = um1[half][e]; um1[half][e] = cur[half][e]; }
    v4u o;
    o.x = pk2(uc[0][0] * gelu_tanh_f(uc[1][0]), uc[0][1] * gelu_tanh_f(uc[1][1])); o.y = pk2(uc[0][2] * gelu_tanh_f(uc[1][2]), uc[0][3] * gelu_tanh_f(uc[1][3]));
    o.z = pk2(uc[0][4] * gelu_tanh_f(uc[1][4]), uc[0][5] * gelu_tanh_f(uc[1][5])); o.w = pk2(uc[0][6] * gelu_tanh_f(uc[1][6]), uc[0][7] * gelu_tanh_f(uc[1][7]));
    *(v4u*)(F.hmid() + (size_t)r * FF + f) = o;
  }
}

constexpr int N_PHASES = 13;
__global__ void __launch_bounds__(NTHR, 2) mega(Params prm) {
  extern __shared__ __attribute__((aligned(16))) unsigned char lds_raw[];
  Frame F;
  F.lds = (LAS unsigned char*)lds_raw;
  F.tid = threadIdx.x; F.lane = F.tid & 63; F.wave = __builtin_amdgcn_readfirstlane(F.tid >> 6); F.G = gridDim.x; F.bid = blockIdx.x;
  F.P = &prm;
  unsigned char* ws = prm.ws;
  volatile LAS unsigned* MISC = (volatile LAS unsigned*)(F.lds + MISC_OFF);
  for (int i = F.tid; i < (LDS_BYTES - LDSCTL_OFF) / 4; i += NTHR) ((LAS unsigned*)(F.lds + LDSCTL_OFF))[i] = 0u;
  __syncthreads();
  const int lo = prm.ph_lo, hi = prm.ph_hi;
  XcdBarrier bar; bar.bar = (unsigned*)(ws + W_CTL) + CW_BAR; bar.x = 0; bar.st = nullptr;
  if (hi - lo > 1) bar = xcd_barrier_post((unsigned*)(ws + W_CTL) + CW_BAR, MISC + 8);
#ifndef PHMASK
#define PHMASK 0x1fff
#endif
#define IN(k) ((((PHMASK) >> (k)) & 1) && lo <= (k) && (k) < hi)
#ifdef PROBE_A
#define STAMP(k) do { if (F.bid == 0 && F.tid == 0) __hip_atomic_store((unsigned long long*)(ws + W_CTL) + 1024 + (k), (unsigned long long)__builtin_amdgcn_s_memrealtime(), __ATOMIC_RELAXED, __HIP_MEMORY_SCOPE_AGENT); } while (0)
#else
#define STAMP(k) do {} while (0)
#endif
#define SEAM(k) do { if (IN(k) && IN((k) + 1)) xcd_barrier(bar); STAMP((k) + 1); } while (0)
  const int gw = F.bid * NWAVES + F.wave, NGW = F.G * NWAVES;
  LAS unsigned char* ring = F.lds;

  STAMP(0);
  if (IN(0)) { p0_prologue(F); } SEAM(0);
  if (IN(1)) { p1_xn(F); } SEAM(1);
  if (IN(2)) {
    pg8::Gemm g{F.xn(), F.win_t(), 1024, 1024, 1024}; StaticOrder S; S.init(65, 9, F.G, F.bid);
    EpiBf16 E{F.z(), ZW, 0, 0};
    pg8::gemm_phase<EpiBf16, StaticOrder, true, true>(ring, g, S, E);
    p0_late_transposes(F);
  } SEAM(2);
  if (IN(3)) {
#if !defined(P3SUB) || P3SUB == 1
    for (int u = F.bid; u < 256; u += F.G) gla_prep_unit(F, u >> 5, u & 31);
#endif
#if !defined(P3SUB) || P3SUB == 2
    for (int u = F.bid; u < 128; u += F.G) gla_sample_unit(F, u >> 2, u & 3);
#endif
#if !defined(P3SUB) || P3SUB == 3
    p3_all_rows(F);
#endif
  } SEAM(3);
  if (IN(4)) {
#if !defined(SUB) || SUB == 1
    { pg8::Gemm g{F.cqn(), F.wq_t(), 384, 384, 384}; SchedQ S{F.G, F.bid}; EpiBf16 E{F.qbuf(), QW, 0, 0};
      pg8::gemm_phase<EpiBf16, SchedQ, true, true>(ring, g, S, E); }
#endif
#if !defined(SUB) || SUB == 2
    { pg8::Gemm g{F.latb(), F.wkv_t(), 256, 256, 256}; StaticOrder S; S.init(64, 4, F.G, F.bid); EpiKV E{F.kcomb(), F.vb()};
      pg8::gemm_phase<EpiKV, StaticOrder, true, true>(ring, g, S, E); }
#endif
#if !defined(SUB) || SUB == 3
    for (int it = gw; it < 2048; it += NGW) gla_passA_item(F, it);
#endif
  } SEAM(4);
  if (IN(5)) {
#if !defined(SUB) || SUB == 4
    gla_passB(F);
#endif
    const int sub = prm.pad & 3, abl = prm.pad >> 2;
#ifndef ONLY_D
    if (sub != 1) { for (int v = F.bid; v < 256; v += F.G) { const int x = v & 7, i = v >> 3, bh = x * 4 + (i >> 3); pattn_unit(F, bh >> 2, bh & 3, i & 7, abl); } }
#endif
#ifndef ONLY_P
    if (sub != 2) { gu32* head = (gu32*)(ws + W_CTL) + CW_Q5; constexpr int ND = DB * NSPLIT;
      for (;;) {
        __syncthreads();
        if (F.tid == 0) MISC[16] = __hip_atomic_fetch_add(head, 1u, RLX_AGENT);
        __syncthreads();
        const int idx = (int)MISC[16];
        if (idx >= ND) break;
        dattn_unit(F, idx / NSPLIT, idx % NSPLIT, abl);
      } }
#endif
  } SEAM(5);
  if (IN(6)) {
    for (int u = F.bid; u < DB * DT; u += F.G) dcombine_unit(F, u >> 3, u & 7);
    for (int it = gw; it < 2048; it += NGW) gla_passC_item(F, it);
  } SEAM(6);
  if (IN(7)) {
    { pg8::Gemm g{F.mixin(), F.wo_t(), 1024, 1024, 1024}; StaticOrder S; S.init(64, 4, F.G, F.bid); EpiBf16 E{F.mixb(), 1024, 0, 0};
      pg8::gemm_phase<EpiBf16, StaticOrder, true, true>(ring, g, S, E); }
    { pg8::Gemm g{F.mixin(), F.wo_t(), 1024, 1024, 256}; SchedPart S{16, F.G, F.bid}; EpiPart E{F.mixp()};
      pg8::gemm_phase<EpiPart, SchedPart, true, true>(ring, g, S, E); }
  } SEAM(7);
  if (IN(8)) { p8_all(F); } SEAM(8);
  if (IN(9)) {
    pg8::Gemm g{F.xn(), F.wup_t(), 1024, 1024, 1024}; StaticOrder S; S.init(65, 22, F.G, F.bid); EpiUp E{F.u(), F.P->out};
    pg8::gemm_phase<EpiUp, StaticOrder, true, true>(ring, g, S, E);
  } SEAM(9);
  if (IN(10)) { p10_convgelu(F); } SEAM(10);
  if (IN(11)) {
    { pg8::Gemm g{F.hmid(), F.wdn_t(), FF, FF, FF}; StaticOrder S; S.init(64, 4, F.G, F.bid); EpiBf16 E{F.mixb(), 1024, 0, 0};
      pg8::gemm_phase<EpiBf16, StaticOrder, true, true>(ring, g, S, E); }
    { pg8::Gemm g{F.hmid(), F.wdn_t(), FF, FF, 256}; SchedPart S{44, F.G, F.bid}; EpiPart E{F.mixp()};
      pg8::gemm_phase<EpiPart, SchedPart, true, true>(ring, g, S, E); }
  } SEAM(11);
  if (IN(12)) { p12_all(F); }
#undef IN
#undef SEAM
}
}
#ifndef DIAG
#define DIAG 1
#endif
#ifndef REPMASK
#define REPMASK 0
#endif
#ifndef PROBE_SUB
#define PROBE_SUB 0
#endif
#ifndef DIAG_PH
#define DIAG_PH 13
#endif
namespace dg {
constexpr int NCHK = 32;
struct Tol { float t[NCHK]; };
__global__ void k_cmp(const float* ref, long ref_ld, const void* tst, int tst_bf16, long tst_ld, int rows, int cols, float* acc) {
  __shared__ float red[16];
  float num = 0.f, den = 0.f; const long n = (long)rows * cols;
  for (long i = (long)blockIdx.x * blockDim.x + threadIdx.x; i < n; i += (long)gridDim.x * blockDim.x) { const long r = i / cols, c = i % cols;
    const float a = ref[r * ref_ld + c]; const float b = tst_bf16 ? fz::bf2f(((const unsigned short*)tst)[r * tst_ld + c]) : ((const float*)tst)[r * tst_ld + c];
    num += (a - b) * (a - b); den += a * a; }
  num = nv::block_sum(num, red); den = nv::block_sum(den, red);
  if (threadIdx.x == 0) { atomicAdd(acc, num); atomicAdd(acc + 1, den); }
}
__global__ void k_report(const float* acc, float* out, Tol tol, float* code) {
  __shared__ int sidx; __shared__ float serr;
  if (threadIdx.x == 0) { int idx = 0; float err = 0.f;
    for (int i = 1; i < NCHK; ++i) { const float num = acc[2 * i], den = acc[2 * i + 1]; if (den == 0.f && num == 0.f) continue; const float e = sqrtf(num / den); if (!(e <= tol.t[i])) { idx = i; err = e; break; } }
    sidx = idx; serr = err; }
  __syncthreads();
  const int idx = sidx; if (idx == 0) return;
  float e = serr; if (!(e >= 0.1f)) e = 0.1f; if (!(e <= 2.f)) e = 2.f; if (serr != serr) e = 2.f;
  for (long i = (long)blockIdx.x * blockDim.x + threadIdx.x; i < (long)nv::MP * nv::D; i += (long)gridDim.x * blockDim.x) { float v = out[i] * (1.f + e); if (i == 0) v += 8.f * idx; out[i] = v; }
  if (blockIdx.x == 0 && threadIdx.x == 0) { code[0] = (float)idx; code[1] = serr; }
}
}

extern "C" void kernel_launch(void* const* d_in, const int* in_sizes, int n_in, void* d_out, int out_size, void* d_ws, size_t ws_size, hipStream_t stream) {
  static int grid = 0;
  if (grid == 0) {
    int dev = 0, cus = 0;
    if (hipGetDevice(&dev) != hipSuccess || hipDeviceGetAttribute(&cus, hipDeviceAttributeMultiprocessorCount, dev) != hipSuccess) { grid = -1; return; }
    if (hipFuncSetAttribute((const void*)fz::mega, hipFuncAttributeMaxDynamicSharedMemorySize, fz::LDS_BYTES) != hipSuccess) { fprintf(stderr, "hipFuncSetAttribute failed\n"); grid = -1; return; }
    int per_cu = 0; (void)hipOccupancyMaxActiveBlocksPerMultiprocessor(&per_cu, (const void*)fz::mega, fz::NTHR, fz::LDS_BYTES); (void)hipGetLastError();
    grid = cus;
    if (per_cu < 1) fprintf(stderr, "occupancy query reports %d\n", per_cu);
  }
  if (grid < 0) return;
  nv::In in = nv::make_in(d_in);
  if ((size_t)out_size != nv::OUT_END) { fprintf(stderr, "bad out size\n"); return; }
#if DIAG
  nv::Ws w = nv::carve((float*)d_ws);
  unsigned char* fws = (unsigned char*)d_ws + ((w.end_floats * 4 + 255) & ~(size_t)255);
  float* out2 = (float*)(fws + fz::W_END); float* acc = out2 + ((nv::OUT_END + 63) & ~(size_t)63);
  const size_t need = (size_t)((unsigned char*)(acc + 256) - (unsigned char*)d_ws);
  if (need > ws_size) { fprintf(stderr, "ws too small: need %zu have %zu\n", need, ws_size); return; }
  (void)hipMemsetAsync(fws + fz::W_CTL, 0, fz::W_ROPE - fz::W_CTL, stream);
  (void)hipMemsetAsync(acc, 0, 256 * 4, stream);
  nv::run(stream, in, w, (float*)d_out);
  fz::Params p{}; p.in = in; p.out = out2; p.ws = fws; p.ph_lo = 0; p.ph_hi = DIAG_PH;
  void* args[] = {&p};
  hipError_t e = hipLaunchCooperativeKernel((const void*)fz::mega, dim3(grid), dim3(fz::NTHR), args, fz::LDS_BYTES, stream);
  if (e != hipSuccess) { fprintf(stderr, "coop launch failed: %s\n", hipGetErrorString(e)); return; }
  using namespace fz; using namespace nv;
  auto cmp = [&](int idx, int ph, const float* ref, long ref_ld, const void* tst, int isbf, long tst_ld, int rows, int cols) {
    if (DIAG_PH <= ph) return;
    hipLaunchKernelGGL(dg::k_cmp, dim3(512), dim3(256), 0, stream, ref, ref_ld, tst, isbf, tst_ld, rows, cols, acc + 2 * idx); };
  const float* dout = (const float*)d_out;
  bf16* Z = (bf16*)(fws + W_Z); bf16* XN = (bf16*)(fws + W_XN); bf16* MIXIN = (bf16*)(fws + W_MIXIN); bf16* QB = (bf16*)(fws + W_QBUF);
  cmp(1, 0, w.mod, 6144, fws + W_MOD, 0, 6144, 40, 6144);
  if (DIAG_PH <= 8) cmp(2, 1, w.h, 1024, XN, 1, 1024, MT, 1024);
  cmp(3, 2, w.z, INC, Z, 1, ZW, MT, 1536);
  cmp(3, 2, w.z + O_GR, INC, Z + ZC_GR, 1, ZW, MT, 16);
  cmp(3, 2, w.z + O_CQ, INC, Z + ZC_CQ, 1, ZW, MT, 384);
  cmp(3, 2, w.z + O_CKV, INC, Z + ZC_CKV, 1, ZW, MT, 256);
  cmp(3, 2, w.z + O_KR, INC, Z + ZC_KR, 1, ZW, MT, 64);
  cmp(4, 3, w.cqn, 384, fws + W_CQN, 1, 384, MT, 384);
  cmp(5, 3, w.kcat, 320, fws + W_LATB, 1, 256, MT, 256);
  cmp(6, 3, w.kcat + 256, 320, fws + W_KRB, 1, 64, MT, 64);
  cmp(7, 3, dout + OUT_LATP, 256, out2 + OUT_LATP, 0, 256, MP, 256);
  cmp(8, 3, dout + OUT_KRP, 64, out2 + OUT_KRP, 0, 64, MP, 64);
  cmp(9, 3, dout + OUT_LATS, 256, out2 + OUT_LATS, 0, 256, MS, 256);
  cmp(10, 3, dout + OUT_KRS, 64, out2 + OUT_KRS, 0, 64, MS, 64);
  cmp(11, 3, w.mixin + (size_t)MP * 1024, 1024, MIXIN + (size_t)MP * 1024, 1, 1024, MS, 512);
  cmp(12, 3, dout + OUT_GLAS, 128, out2 + OUT_GLAS, 0, 128, DB * 4 * 64, 128);
  cmp(13, 4, w.qb, 768, QB, 1, QW, MT, 768);
  for (int h = 0; h < 4; ++h) cmp(14, 4, w.qcat + (size_t)MP * 1280 + h * 320, 1280, QB + (size_t)MP * QW + 768 + h * 256, 1, QW, MS, 256);
  cmp(15, 5, dout + OUT_GLAP, 128, out2 + OUT_GLAP, 0, 128, NB * 4 * 64, 128);
  cmp(16, 5, w.mixin + 512, 1024, MIXIN + 512, 1, 1024, MP, 512);
  cmp(17, 6, w.mixin + (size_t)MP * 1024 + 512, 1024, MIXIN + (size_t)MP * 1024 + 512, 1, 1024, MS, 512);
  cmp(18, 6, w.mixin, 1024, MIXIN, 1, 1024, MP, 512);
  if (DIAG_PH <= 11) cmp(19, 7, w.mix, 1024, fws + W_MIX, 1, 1024, MP, 1024);
  cmp(20, 8, w.x1, 1024, fws + W_X1, 0, 1024, MT, 1024);
  cmp(21, 8, w.h2, 1024, XN, 1, 1024, MT, 1024);
  cmp(22, 9, w.u, F2, fws + W_U, 1, F2, MT, F2);
  cmp(23, 9, dout + OUT_CONVP, F2, out2 + OUT_CONVP, 0, F2, NB * 2, F2);
  cmp(24, 9, dout + OUT_CONVS, F2, out2 + OUT_CONVS, 0, F2, DB * 2, F2);
  cmp(25, 10, w.hmid, FF, fws + W_HMID, 1, FF, MT, FF);
  cmp(26, 11, w.y, 1024, fws + W_MIX, 1, 1024, MP, 1024);
  cmp(27, 12, dout + OUT_YP, 1024, out2 + OUT_YP, 0, 1024, MP, 1024);
  cmp(28, 12, dout + OUT_YS, 1024, out2 + OUT_YS, 0, 1024, MS, 1024);
  dg::Tol tol; for (int i = 0; i < dg::NCHK; ++i) tol.t[i] = 0.02f; tol.t[1] = 1e-3f; tol.t[27] = 0.01f; tol.t[28] = 0.01f;
  hipLaunchKernelGGL(dg::k_report, dim3(512), dim3(256), 0, stream, (const float*)acc, (float*)d_out, tol, acc + 128);
#else
  (void)hipMemsetAsync((unsigned char*)d_ws + fz::W_CTL, 0, fz::W_ROPE - fz::W_CTL, stream);
  fz::Params p{}; p.in = in; p.out = (float*)d_out; p.ws = (unsigned char*)d_ws; p.ph_lo = 0; p.ph_hi = fz::N_PHASES; p.repmask = REPMASK;
  void* args[] = {&p};
  hipError_t e = hipLaunchCooperativeKernel((const void*)fz::mega, dim3(grid), dim3(fz::NTHR), args, fz::LDS_BYTES, stream);
  if (e != hipSuccess) fprintf(stderr, "coop launch failed: %s\n", hipGetErrorString(e));
  for (int k = 0; k < fz::N_PHASES; ++k) if ((REPMASK >> k) & 1) {
    (void)hipMemsetAsync((unsigned char*)d_ws + fz::W_CTL, 0, 4096, stream);
    fz::Params q = p; q.ph_lo = k; q.ph_hi = k + 1; q.pad = PROBE_SUB; void* a2[] = {&q};
    (void)hipLaunchCooperativeKernel((const void*)fz::mega, dim3(grid), dim3(fz::NTHR), a2, fz::LDS_BYTES, stream); }
#endif
}
```
